# Optimizing an MI355X kernel written in HIP

```python
import math
import jax
import jax.numpy as jnp
from jax import lax
import numpy as np

D_MODEL = 2048
BATCH = 4
SEQ = 2048
DEPTH = 1

D_MIX = D_MODEL
D_SSM = D_MIX // 2
D_RWKV = D_MIX - D_SSM
S5_CH = 16
S5_GROUPS = D_SSM // S5_CH
S5_STATE = 64
RW_HEAD = 64
RW_HEADS = D_RWKV // RW_HEAD
RW_W_LORA = 64
RW_A_LORA = 64
RW_G_LORA = 160
RW_COLS = 3 * D_RWKV + RW_W_LORA + RW_A_LORA + RW_G_LORA
RW_SPLITS = [D_RWKV, 2 * D_RWKV, 3 * D_RWKV, 3 * D_RWKV + RW_W_LORA,
             3 * D_RWKV + RW_W_LORA + RW_A_LORA]
IN_COLS = D_SSM + RW_COLS
PEER_HEADS = 8
PEER_NKEYS = 128
PEER_EXPERTS = PEER_NKEYS * PEER_NKEYS
PEER_DKEY = 256
PEER_HALF = PEER_DKEY // 2
PEER_TOPK = 16
PEER_BLOCK = 128
DEEPNORM_ALPHA = (2.0 * DEPTH) ** 0.25
DEEPNORM_BETA = (8.0 * DEPTH) ** -0.25
LN_EPS = 1e-5
RW_GN_EPS = 64e-5

kernel_name = 'hybrid_s5_rwkv7_peer_layer'


def layer_norm(x, g, b):
    xf = x.astype(jnp.float32)
    mu = jnp.mean(xf, axis=-1, keepdims=True)
    var = jnp.mean(jnp.square(xf - mu), axis=-1, keepdims=True)
    return ((xf - mu) * lax.rsqrt(var + LN_EPS) * g + b).astype(x.dtype)


def shift_prev(p):
    return jnp.pad(p, ((0, 0), (1, 0), (0, 0)))[:, :-1]


def s5_mixer(u, lam_re, lam_im, log_step, b_re, b_im, c_re, c_im, d_skip, w_glu, b_glu):
    bsz, seq, _ = u.shape
    ug = u.reshape(bsz, seq, S5_GROUPS, S5_CH)
    step = jnp.exp(log_step)[:, None]
    mag = jnp.exp(lam_re * step)
    ang = lam_im * step
    a_re = mag * jnp.cos(ang)
    a_im = mag * jnp.sin(ang)
    den = lam_re * lam_re + lam_im * lam_im
    f_re = ((a_re - 1.0) * lam_re + a_im * lam_im) / den
    f_im = (a_im * lam_re - (a_re - 1.0) * lam_im) / den
    bb_re = f_re[..., None] * b_re - f_im[..., None] * b_im
    bb_im = f_re[..., None] * b_im + f_im[..., None] * b_re
    bu_re = jnp.einsum('blgh,gph->blgp', ug, bb_re)
    bu_im = jnp.einsum('blgh,gph->blgp', ug, bb_im)
    a_re_l = jnp.broadcast_to(a_re, (1, seq) + a_re.shape)
    a_im_l = jnp.broadcast_to(a_im, (1, seq) + a_im.shape)

    def combine(e1, e2):
        a1r, a1i, b1r, b1i = e1
        a2r, a2i, b2r, b2i = e2
        return (a2r * a1r - a2i * a1i,
                a2r * a1i + a2i * a1r,
                a2r * b1r - a2i * b1i + b2r,
                a2r * b1i + a2i * b1r + b2i)

    _, _, h_re, h_im = lax.associative_scan(combine, (a_re_l, a_im_l, bu_re, bu_im), axis=1)
    y = jnp.einsum('blgp,ghp->blgh', h_re, c_re) - jnp.einsum('blgp,ghp->blgh', h_im, c_im)
    y = y.reshape(bsz, seq, D_SSM) + d_skip * u
    y = jax.nn.gelu(y)
    return y * jax.nn.sigmoid(y @ w_glu + b_glu)


def rwkv7_mixer(p, mu, w0, w_up, a0, a_up, g_up, k_k, k_a, r_k, gn_g, gn_b):
    bsz, seq, _ = p.shape
    f32 = jnp.float32

    def heads(t):
        return t.reshape(bsz, seq, RW_HEADS, RW_HEAD)

    p = p + mu * (shift_prev(p) - p)
    r, k, v, wd, ad, gd = jnp.split(p, RW_SPLITS, axis=-1)
    w = -jax.nn.softplus(-(w0 + jnp.tanh(wd) @ w_up)) - 0.5
    decay = jnp.exp(-jnp.exp(w.astype(f32)))
    a = jax.nn.sigmoid(a0 + ad @ a_up)
    g = jax.nn.sigmoid(gd) @ g_up
    kk = heads(k * k_k).astype(f32)
    kk = kk / jnp.maximum(jnp.linalg.norm(kk, axis=-1, keepdims=True), 1e-12)
    k = k * (1.0 + (a - 1.0) * k_a)
    rh, kh, vh, ah, wh = (heads(t).astype(f32) for t in (r, k, v, a, decay))
    bh = kk * ah
    xs = tuple(jnp.moveaxis(t, 1, 0) for t in (rh, wh, kh, vh, kk, bh))

    def step(state, inp):
        r_t, w_t, k_t, v_t, kk_t, b_t = inp
        sa = jnp.einsum('bhij,bhj->bhi', state, kk_t)
        state = (state * w_t[:, :, None, :] - sa[..., None] * b_t[:, :, None, :]
                 + v_t[..., None] * k_t[:, :, None, :])
        return state, jnp.einsum('bhij,bhj->bhi', state, r_t)

    s0 = jnp.zeros((bsz, RW_HEADS, RW_HEAD, RW_HEAD), f32)
    _, o = lax.scan(step, s0, xs)
    o = jnp.moveaxis(o, 0, 1)
    mean = jnp.mean(o, axis=-1, keepdims=True)
    var = jnp.mean(jnp.square(o - mean), axis=-1, keepdims=True)
    o = (o - mean) * lax.rsqrt(var + RW_GN_EPS)
    bonus = jnp.sum(rh * kh * r_k, axis=-1, keepdims=True) * vh
    o = o.reshape(bsz, seq, D_RWKV) * gn_g + gn_b + bonus.reshape(bsz, seq, D_RWKV)
    return (o * g).astype(p.dtype)


def peer_channel_mixer(x, w_q, keys1, keys2, u_tab, v_tab):
    bsz, seq, dim = x.shape
    n_tok = bsz * seq
    f32 = jnp.float32
    xt = x.reshape(n_tok, dim)
    q = (xt @ w_q).reshape(n_tok, PEER_HEADS, 2, PEER_HALF)
    s1 = jnp.einsum('thd,hkd->thk', q[:, :, 0], keys1).astype(f32)
    s2 = jnp.einsum('thd,hkd->thk', q[:, :, 1], keys2).astype(f32)
    v1, i1 = lax.top_k(s1, PEER_TOPK)
    v2, i2 = lax.top_k(s2, PEER_TOPK)
    cand = (v1[..., :, None] + v2[..., None, :]).reshape(n_tok, PEER_HEADS, PEER_TOPK * PEER_TOPK)
    cidx = (i1[..., :, None] * PEER_NKEYS + i2[..., None, :]).reshape(n_tok, PEER_HEADS, PEER_TOPK * PEER_TOPK)
    top_s, pos = lax.top_k(cand, PEER_TOPK)
    idx = jnp.take_along_axis(cidx, pos, axis=-1)
    gate = jax.nn.softmax(top_s, axis=-1).astype(x.dtype)
    n_blk = n_tok // PEER_BLOCK
    n_sel = PEER_HEADS * PEER_TOPK
    xb = xt.reshape(n_blk, PEER_BLOCK, dim)
    ib = idx.reshape(n_blk, PEER_BLOCK, n_sel)
    gb = gate.reshape(n_blk, PEER_BLOCK, n_sel)

    def block(args):
        xs, ids, gs = args
        u = jnp.take(u_tab, ids, axis=0)
        v = jnp.take(v_tab, ids, axis=0)
        act = jax.nn.gelu(jnp.einsum('td,ted->te', xs, u))
        return jnp.einsum('te,ted->td', gs * act, v)

    out = lax.map(block, (xb, ib, gb))
    return out.reshape(bsz, seq, dim)


def setup_inputs(seed: int = 0) -> dict:
    key = jax.random.key(seed)
    it = iter(jax.random.split(key, 40))
    f32 = jnp.float32

    def nrm(shape, scale):
        return scale * jax.random.normal(next(it), shape, f32)

    nl = DEPTH
    g_, p_, h_ = S5_GROUPS, S5_STATE, S5_CH
    x = nrm((BATCH, SEQ, D_MODEL), 1.0)
    w_in = nrm((nl, D_MODEL, IN_COLS), D_MODEL ** -0.5)
    s5_lam_re = -0.5 + nrm((nl, g_, p_), 0.01)
    s5_lam_im = jnp.pi * jnp.arange(p_, dtype=f32) + nrm((nl, g_, p_), 0.01)
    s5_log_step = jax.random.uniform(next(it), (nl, g_), f32, math.log(1e-3), math.log(1e-1))
    s5_b_re = nrm((nl, g_, p_, h_), (2.0 * h_) ** -0.5)
    s5_b_im = nrm((nl, g_, p_, h_), (2.0 * h_) ** -0.5)
    s5_c_re = nrm((nl, g_, h_, p_), (2.0 * p_) ** -0.5)
    s5_c_im = nrm((nl, g_, h_, p_), (2.0 * p_) ** -0.5)
    s5_d = nrm((nl, D_SSM), 1.0)
    s5_w_glu = nrm((nl, D_SSM, D_SSM), D_SSM ** -0.5)
    s5_b_glu = nrm((nl, D_SSM), 0.02)
    rw_mu = jax.random.uniform(next(it), (nl, RW_COLS), f32, 0.0, 1.0)
    ramp = (jnp.arange(D_RWKV, dtype=f32) / (D_RWKV - 1)) ** 0.7
    rw_w0 = -6.0 + 5.0 * ramp + nrm((nl, D_RWKV), 0.1)
    rw_w_up = nrm((nl, RW_W_LORA, D_RWKV), 0.1 * RW_W_LORA ** -0.5)
    rw_a0 = nrm((nl, D_RWKV), 0.1)
    rw_a_up = nrm((nl, RW_A_LORA, D_RWKV), 0.1 * RW_A_LORA ** -0.5)
    rw_g_up = nrm((nl, RW_G_LORA, D_RWKV), RW_G_LORA ** -0.5)
    rw_k_k = 0.85 + nrm((nl, D_RWKV), 0.02)
    rw_k_a = 1.0 + nrm((nl, D_RWKV), 0.02)
    rw_r_k = nrm((nl, RW_HEADS, RW_HEAD), 0.1)
    rw_gn_g = 1.0 + nrm((nl, D_RWKV), 0.02)
    rw_gn_b = nrm((nl, D_RWKV), 0.02)
    w_out = nrm((nl, D_MIX, D_MODEL), DEEPNORM_BETA * D_MIX ** -0.5)
    ln1_g = 1.0 + nrm((nl, D_MODEL), 0.02)
    ln1_b = nrm((nl, D_MODEL), 0.02)
    peer_w_q = nrm((nl, D_MODEL, PEER_HEADS * PEER_DKEY), D_MODEL ** -0.5)
    peer_keys1 = nrm((nl, PEER_HEADS, PEER_NKEYS, PEER_HALF), PEER_HALF ** -0.5)
    peer_keys2 = nrm((nl, PEER_HEADS, PEER_NKEYS, PEER_HALF), PEER_HALF ** -0.5)
    peer_u = nrm((nl, PEER_EXPERTS, D_MODEL), D_MODEL ** -0.5)
    peer_v = nrm((nl, PEER_EXPERTS, D_MODEL), DEEPNORM_BETA)
    ln2_g = 1.0 + nrm((nl, D_MODEL), 0.02)
    ln2_b = nrm((nl, D_MODEL), 0.02)
    return {'x': x, 'w_in': w_in,
            's5_lam_re': s5_lam_re, 's5_lam_im': s5_lam_im, 's5_log_step': s5_log_step,
            's5_b_re': s5_b_re, 's5_b_im': s5_b_im, 's5_c_re': s5_c_re, 's5_c_im': s5_c_im,
            's5_d': s5_d, 's5_w_glu': s5_w_glu, 's5_b_glu': s5_b_glu,
            'rw_mu': rw_mu, 'rw_w0': rw_w0, 'rw_w_up': rw_w_up, 'rw_a0': rw_a0,
            'rw_a_up': rw_a_up, 'rw_g_up': rw_g_up, 'rw_k_k': rw_k_k, 'rw_k_a': rw_k_a,
            'rw_r_k': rw_r_k, 'rw_gn_g': rw_gn_g, 'rw_gn_b': rw_gn_b,
            'w_out': w_out, 'ln1_g': ln1_g, 'ln1_b': ln1_b,
            'peer_w_q': peer_w_q, 'peer_keys1': peer_keys1, 'peer_keys2': peer_keys2,
            'peer_u': peer_u, 'peer_v': peer_v, 'ln2_g': ln2_g, 'ln2_b': ln2_b}


def reference(x, w_in,
              s5_lam_re, s5_lam_im, s5_log_step, s5_b_re, s5_b_im, s5_c_re, s5_c_im,
              s5_d, s5_w_glu, s5_b_glu,
              rw_mu, rw_w0, rw_w_up, rw_a0, rw_a_up, rw_g_up, rw_k_k, rw_k_a,
              rw_r_k, rw_gn_g, rw_gn_b,
              w_out, ln1_g, ln1_b,
              peer_w_q, peer_keys1, peer_keys2, peer_u, peer_v, ln2_g, ln2_b):
    h = x
    for l in range(DEPTH):
        proj = h @ w_in[l]
        y_ssm = s5_mixer(proj[..., :D_SSM], s5_lam_re[l], s5_lam_im[l], s5_log_step[l],
                         s5_b_re[l], s5_b_im[l], s5_c_re[l], s5_c_im[l],
                         s5_d[l], s5_w_glu[l], s5_b_glu[l])
        y_rw = rwkv7_mixer(proj[..., D_SSM:], rw_mu[l], rw_w0[l], rw_w_up[l], rw_a0[l],
                           rw_a_up[l], rw_g_up[l], rw_k_k[l], rw_k_a[l], rw_r_k[l],
                           rw_gn_g[l], rw_gn_b[l])
        mix = jnp.concatenate([y_ssm, y_rw], axis=-1) @ w_out[l]
        h = layer_norm(DEEPNORM_ALPHA * h + mix, ln1_g[l], ln1_b[l])
        ffn = peer_channel_mixer(h, peer_w_q[l], peer_keys1[l], peer_keys2[l],
                                 peer_u[l], peer_v[l])
        h = layer_norm(DEEPNORM_ALPHA * h + ffn, ln2_g[l], ln2_b[l])
    return h
```

```cpp
#include <hip/hip_runtime.h>
#include <cstdio>
#include <cstdint>
#include <cmath>
namespace pg8 {
#define PG8_LAS __attribute__((address_space(3)))
typedef unsigned short bf16_t;
typedef short bf16x8 __attribute__((ext_vector_type(8)));
typedef float f32x4 __attribute__((ext_vector_type(4)));
typedef float f32x2 __attribute__((ext_vector_type(2)));
typedef unsigned u32x4 __attribute__((ext_vector_type(4)));
constexpr int BM = 256, BK = 64, HALF = 128, HTB = HALF * BK * 2  , STAGE_BYTES = 8 * HTB, NXCD = 8, WGM = 8;

__host__ __device__ __forceinline__ int lds_byte(int r, int c) { const int st = (r >> 4) * 2 + (c >> 5), rr = r & 15, cc = c & 31, ob = rr * 64 + cc * 2; return st * 1024 + (ob ^ (((ob >> 9) & 1) << 5)); }
__host__ __device__ __forceinline__ void stage_rc(int b, int& R, int& C) { const int st = b / 1024, sb = b % 1024, swz = sb ^ (((sb >> 9) & 1) << 5); R = (st >> 1) * 16 + swz / 64; C = (st & 1) * 32 + (swz % 64) / 2; }
__host__ __device__ __forceinline__ int perm32(int rho) { const int n = rho >> 4, i = rho & 15; return 8 * (i >> 2) + 4 * n + (i & 3); }

struct Unit { int pm, pn; };
struct Gemm { const bf16_t* A; const bf16_t* Bt; int K, lda, ldb; };

struct StaticOrder {
    int nM, nN, nwg, G, c;
    __host__ __device__ void init(int M, int N, int G_, int c_) { nM = M / BM; nN = N / BM; nwg = nM * nN; G = G_; c = c_; }
    __host__ __device__ bool next(int i, Unit& u) const {
        const long L = (long)i * G + c; if (L >= nwg) return false;
        int wgid = (int)L; { const int q = nwg / NXCD, r = nwg % NXCD, xcd = wgid % NXCD, off = wgid / NXCD; wgid = (xcd < r ? xcd * (q + 1) : r * (q + 1) + (xcd - r) * q) + off; }
        const int nig = WGM * nN, gid = wgid / nig, fm = gid * WGM, gsz = (nM - fm) < WGM ? (nM - fm) : WGM;
        u.pm = fm + ((wgid % nig) % gsz); u.pn = (wgid % nig) / gsz; return true;
    }
    __device__ __forceinline__ void a_ready(const Unit&) const {}
    __device__ __forceinline__ void done(const Unit&) const {}
};
struct ListOrder {
    int L0, L1, nM;
    __device__ bool next(int i, Unit& u) const { const int L = (i == 0) ? L0 : ((i == 1) ? L1 : -1); if (L < 0) return false; u.pm = L % nM; u.pn = L / nM; return true; }
    __device__ __forceinline__ void a_ready(const Unit&) const {}
    __device__ __forceinline__ void done(const Unit&) const {}
};
struct OneUnit {
    int pm, pn;
    __device__ bool next(int i, Unit& u) const { if (i != 0 || pm < 0) return false; u.pm = pm; u.pn = pn; return true; }
    __device__ __forceinline__ void a_ready(const Unit&) const {}
    __device__ __forceinline__ void done(const Unit&) const {}
};

__device__ __forceinline__ unsigned cvt_pk_bf16(float lo, float hi) { unsigned r; asm volatile("v_cvt_pk_bf16_f32 %0, %1, %2" : "=v"(r) : "v"(lo), "v"(hi)); return r; }
__device__ __forceinline__ float bf_lo(unsigned w) { return __uint_as_float(w << 16); }
__device__ __forceinline__ float bf_hi(unsigned w) { return __uint_as_float(w & 0xffff0000u); }
__device__ __forceinline__ float gelu_tanh(float x) { const float y = 0.7978845608f * (x + 0.044715f * x * x * x); return x * __builtin_amdgcn_rcpf(1.0f + __expf(-2.0f * y)); }
__device__ __forceinline__ float sigmoidf(float x) { return __builtin_amdgcn_rcpf(1.0f + __expf(-x)); }

__device__ __forceinline__ u32x4 pack8(const f32x4 v0, const f32x4 v1) { u32x4 w; w.x = cvt_pk_bf16(v0[0], v0[1]); w.y = cvt_pk_bf16(v0[2], v0[3]); w.z = cvt_pk_bf16(v1[0], v1[1]); w.w = cvt_pk_bf16(v1[2], v1[3]); return w; }

struct EpiStoreBf16 {
    static constexpr bool PERM = true, AFTER_DRAIN = false;
    bf16_t* O; int ldc;
    __device__ __forceinline__ void operator()(const f32x4 (&acc)[2][2][4][2], const Unit& u, int wr, int wc, int fr, int fq) const {
        const int row0 = u.pm * BM + wr * 64 + fr, col0 = u.pn * BM + wc * 32 + 8 * fq;
#pragma unroll
        for (int ai = 0; ai < 2; ++ai)
#pragma unroll
            for (int m = 0; m < 4; ++m) { bf16_t* rowp = O + (size_t)(row0 + ai * HALF + m * 16) * ldc + col0;
#pragma unroll
                for (int bj = 0; bj < 2; ++bj) *(u32x4*)(rowp + bj * HALF) = pack8(acc[ai][bj][m][0], acc[ai][bj][m][1]); }
    }
};
struct EpiProj {
    static constexpr bool PERM = true, AFTER_DRAIN = false;
    bf16_t* U; bf16_t* PRW;
    __device__ __forceinline__ void operator()(const f32x4 (&acc)[2][2][4][2], const Unit& u, int wr, int wc, int fr, int fq) const {
        const int row0 = u.pm * BM + wr * 64 + fr, col0 = u.pn * BM + wc * 32 + 8 * fq;
#pragma unroll
        for (int ai = 0; ai < 2; ++ai)
#pragma unroll
            for (int m = 0; m < 4; ++m) { const int row = row0 + ai * HALF + m * 16;
#pragma unroll
                for (int bj = 0; bj < 2; ++bj) { const int col = col0 + bj * HALF; const u32x4 w = pack8(acc[ai][bj][m][0], acc[ai][bj][m][1]);
                    if (u.pn < 4) { const int g = col >> 4, h0 = col & 15, b = row >> 11, t = row & 2047, c = t >> 5, s = t & 31;
                        *(u32x4*)(U + (size_t)(g * 256 + b * 64 + c) * 640 + s * 16 + h0) = w; }
                    else *(u32x4*)(PRW + (size_t)row * 3584 + (col - 1024)) = w; } }
    }
};
struct EpiY {
    static constexpr bool PERM = true, AFTER_DRAIN = false;
    bf16_t* YS;
    __device__ __forceinline__ void operator()(const f32x4 (&acc)[2][2][4][2], const Unit& u, int wr, int wc, int fr, int fq) const {
        const int g = u.pm, j = u.pn & 1;
#pragma unroll
        for (int ai = 0; ai < 2; ++ai)
#pragma unroll
            for (int m = 0; m < 4; ++m) { const int rowl = ai * HALF + wr * 64 + m * 16 + fr, b = rowl >> 6, c = rowl & 63;
#pragma unroll
                for (int bj = 0; bj < 2; ++bj) { const int n = 256 * j + bj * HALF + wc * 32 + 8 * fq, tl = n >> 4, h0 = n & 15;
                    f32x4 v0 = acc[ai][bj][m][0], v1 = acc[ai][bj][m][1];
#pragma unroll
                    for (int e = 0; e < 4; ++e) { v0[e] = gelu_tanh(v0[e]); v1[e] = gelu_tanh(v1[e]); }
                    *(u32x4*)(YS + (size_t)(b * 2048 + c * 32 + tl) * 1024 + g * 16 + h0) = pack8(v0, v1); }
                asm volatile("" ::: "memory"); }
    }
};
struct EpiGLU {
    static constexpr bool PERM = true, AFTER_DRAIN = false;
    const bf16_t* YS; const float* bglu; bf16_t* CAT;
    __device__ __forceinline__ void operator()(const f32x4 (&acc)[2][2][4][2], const Unit& u, int wr, int wc, int fr, int fq) const {
        const int row0 = u.pm * BM + wr * 64 + fr, col0 = u.pn * BM + wc * 32 + 8 * fq;
#pragma unroll
        for (int bj = 0; bj < 2; ++bj) { const int col = col0 + bj * HALF; const f32x4 b0 = *(const f32x4*)(bglu + col), b1 = *(const f32x4*)(bglu + col + 4);
#pragma unroll
            for (int ai = 0; ai < 2; ++ai)
#pragma unroll
                for (int m = 0; m < 4; ++m) { const int row = row0 + ai * HALF + m * 16; const u32x4 y = *(const u32x4*)(YS + (size_t)row * 1024 + col);
                    const f32x4 a0 = acc[ai][bj][m][0] + b0, a1 = acc[ai][bj][m][1] + b1; f32x4 o0, o1;
                    o0[0] = bf_lo(y.x) * sigmoidf(a0[0]); o0[1] = bf_hi(y.x) * sigmoidf(a0[1]); o0[2] = bf_lo(y.y) * sigmoidf(a0[2]); o0[3] = bf_hi(y.y) * sigmoidf(a0[3]);
                    o1[0] = bf_lo(y.z) * sigmoidf(a1[0]); o1[1] = bf_hi(y.z) * sigmoidf(a1[1]); o1[2] = bf_lo(y.w) * sigmoidf(a1[2]); o1[3] = bf_hi(y.w) * sigmoidf(a1[3]);
                    *(u32x4*)(CAT + (size_t)row * 2048 + col) = pack8(o0, o1); } }
    }
};
struct EpiF32 {
    static constexpr bool PERM = false, AFTER_DRAIN = false;
    float* O; const float* R; int ldc; float alpha;
    __device__ __forceinline__ void operator()(const f32x4 (&acc)[2][2][4][2], const Unit& u, int wr, int wc, int fr, int fq) const {
        const int row0 = u.pm * BM + wr * 64 + fr, col0 = u.pn * BM + wc * 32 + 4 * fq;
#pragma unroll
        for (int ai = 0; ai < 2; ++ai)
#pragma unroll
            for (int m = 0; m < 4; ++m) { const size_t off = (size_t)(row0 + ai * HALF + m * 16) * ldc + col0;
#pragma unroll
                for (int bj = 0; bj < 2; ++bj)
#pragma unroll
                    for (int n = 0; n < 2; ++n) { f32x4 o = acc[ai][bj][m][n]; if (R) { const f32x4 r = *(const f32x4*)(R + off + bj * HALF + n * 16); o = o + r * alpha; }
                        *(f32x4*)(O + off + bj * HALF + n * 16) = o; } }
    }
};
struct EpiSa {
    static constexpr bool PERM = false, AFTER_DRAIN = true;
    bf16_t* U; const float* A32;
    __device__ __forceinline__ void fused(const f32x4 (&acc)[2][2][4][2], const Unit& u, int wr, int wc, int fr, int fq, PG8_LAS unsigned char* lds, int wid, int lane) const {
        const int g = u.pm, gb = g & 1;
        PG8_LAS float* SL = (PG8_LAS float*)lds;
#pragma unroll
        for (int ai = 0; ai < 2; ++ai)
#pragma unroll
            for (int m = 0; m < 4; ++m) { const int rowl = ai * HALF + wr * 64 + m * 16 + fr;
#pragma unroll
                for (int bj = 0; bj < 2; ++bj) if (bj == gb) {
#pragma unroll
                    for (int n = 0; n < 2; ++n) *(PG8_LAS f32x4*)(SL + rowl * 128 + wc * 32 + n * 16 + 4 * fq) = acc[ai][bj][m][n]; } }
        asm volatile("s_waitcnt lgkmcnt(0)" ::: "memory"); __builtin_amdgcn_s_barrier(); asm volatile("" ::: "memory");
        const int tid = wid * 64 + lane;
        if (tid < 256) { const int b = tid >> 6, p = tid & 63; const float ar = A32[(g * 64 + p) * 2], ai_ = A32[(g * 64 + p) * 2 + 1]; float hr = 0.f, hi = 0.f;
            for (int c = 0; c < 64; ++c) { bf16_t* up = U + (size_t)(g * 256 + b * 64 + c) * 640 + 512 + p;
                const unsigned pk = cvt_pk_bf16(hr, hi); up[0] = (bf16_t)(pk & 0xffffu); up[64] = (bf16_t)(pk >> 16);
                const float sr = SL[(b * 64 + c) * 128 + p], si = SL[(b * 64 + c) * 128 + 64 + p];
                const float nr = ar * hr - ai_ * hi + sr, ni = ar * hi + ai_ * hr + si; hr = nr; hi = ni; } }
    }
};

template <class Epi, class Sched, bool ALIGN_EPI = false, bool SP2 = false>
__device__ __forceinline__ void gemm_phase(PG8_LAS unsigned char* lds, const Gemm g, const Sched& S, const Epi& E) {
    const int tid = threadIdx.x, wid = __builtin_amdgcn_readfirstlane(tid >> 6), lane = tid & 63, wr = wid >> 2, wc = wid & 3, fr = lane & 15, fq = lane >> 4;
    const int K = g.K, nt = K / BK;
    unsigned voffA[2], voffB[2];
#pragma unroll
    for (int i = 0; i < 2; ++i) { int R, C; stage_rc(tid * 16 + i * 8192, R, C); const int Rb = Epi::PERM ? ((R & ~31) + perm32(R & 31)) : R;
        voffA[i] = (unsigned)(R * g.lda + C) * 2u; voffB[i] = (unsigned)(Rb * g.ldb + C) * 2u; }
    const size_t kstep = (size_t)(BK * 2);
    const size_t hsA = (size_t)HALF * g.lda * 2, hsB = (size_t)HALF * g.ldb * 2;
    const size_t tsA = 2 * hsA, tsB = 2 * hsB;
    const unsigned ldsw = (unsigned)wid * 1024u;
    const int aoff = lds_byte(wr * 64 + fr, fq * 8), boff = lds_byte(wc * 32 + fr, fq * 8);
#define PG8_SA(b, h) (((b) * 2 + (h)) * HTB)
#define PG8_SB(b, h) ((4 + (b) * 2 + (h)) * HTB)
#define PG8_STAGE(bufoff, gbase, voff) do { _Pragma("unroll") for (int _i = 0; _i < 2; ++_i) \
        __builtin_amdgcn_global_load_lds((const unsigned*)((const char*)(gbase) + (voff)[_i]), (PG8_LAS unsigned*)(lds + (bufoff) + ldsw + _i * 8192), 16, 0, 0); } while (0)
#define PG8_LDA(dst, b, h) do { _Pragma("unroll") for (int m = 0; m < 4; ++m) _Pragma("unroll") for (int k = 0; k < 2; ++k) dst[m][k] = *(const PG8_LAS bf16x8*)(lds + PG8_SA(b, h) + aoff + m * 2048 + k * 1024); } while (0)
#define PG8_LDB(dst, b, h) do { _Pragma("unroll") for (int n = 0; n < 2; ++n) _Pragma("unroll") for (int k = 0; k < 2; ++k) dst[n][k] = *(const PG8_LAS bf16x8*)(lds + PG8_SB(b, h) + boff + n * 2048 + k * 1024); } while (0)
#define PG8_MMA(ai, bj, At, Bt) do { __builtin_amdgcn_s_setprio(1); _Pragma("unroll") for (int m = 0; m < 4; ++m) _Pragma("unroll") for (int n = 0; n < 2; ++n) _Pragma("unroll") for (int k = 0; k < 2; ++k) \
        acc[ai][bj][m][n] = __builtin_amdgcn_mfma_f32_16x16x32_bf16(Bt[n][k], At[m][k], acc[ai][bj][m][n], 0, 0, 0); __builtin_amdgcn_s_setprio(0); } while (0)
#define PG8_WAIT_V(n) asm volatile("s_waitcnt vmcnt(" #n ")" ::: "memory")
#define PG8_WAIT_L(n) asm volatile("s_waitcnt lgkmcnt(" #n ")" ::: "memory")
#define PG8_BAR __builtin_amdgcn_s_barrier()
#define PG8_SCHED __builtin_amdgcn_sched_barrier(0)
    Unit cur, nxt; int ui = 0;
    if (!S.next(0, cur)) return;
    f32x4 acc[2][2][4][2];
#pragma unroll
    for (int a = 0; a < 2; ++a)
#pragma unroll
        for (int b = 0; b < 2; ++b)
#pragma unroll
            for (int m = 0; m < 4; ++m)
#pragma unroll
                for (int n = 0; n < 2; ++n) acc[a][b][m][n] = (f32x4){0.f, 0.f, 0.f, 0.f};
    bf16x8 At[4][2], B0[2][2], B1[2][2];
    const char* cA = (const char*)g.A + (size_t)cur.pm * tsA; const char* cB = (const char*)g.Bt + (size_t)cur.pn * tsB;
    S.a_ready(cur);
    if constexpr (SP2) {
        PG8_STAGE(PG8_SB(0, 0), cB, voffB); PG8_STAGE(PG8_SB(0, 1), cB + hsB, voffB); PG8_STAGE(PG8_SA(0, 0), cA, voffA); PG8_STAGE(PG8_SA(0, 1), cA + hsA, voffA);
        if (wr == 1) PG8_BAR;
        PG8_WAIT_V(2); PG8_BAR;
        PG8_STAGE(PG8_SB(1, 0), cB + kstep, voffB); PG8_STAGE(PG8_SA(1, 0), cA + kstep, voffA); PG8_STAGE(PG8_SB(1, 1), cB + hsB + kstep, voffB);
        PG8_WAIT_V(6); PG8_BAR;
    } else {
        PG8_STAGE(PG8_SB(0, 0), cB, voffB); PG8_STAGE(PG8_SA(0, 0), cA, voffA); PG8_STAGE(PG8_SB(0, 1), cB + hsB, voffB); PG8_STAGE(PG8_SA(0, 1), cA + hsA, voffA);
        if (wr == 1) PG8_BAR;
        PG8_WAIT_V(4); PG8_BAR;
        PG8_STAGE(PG8_SB(1, 0), cB + kstep, voffB); PG8_STAGE(PG8_SA(1, 0), cA + kstep, voffA); PG8_STAGE(PG8_SB(1, 1), cB + hsB + kstep, voffB);
        PG8_WAIT_V(6); PG8_BAR;
    }
    for (;;) {
        const bool has_next = S.next(ui + 1, nxt);
        const char* nA = has_next ? (const char*)g.A + (size_t)nxt.pm * tsA : cA; const char* nB = has_next ? (const char*)g.Bt + (size_t)nxt.pn * tsB : cB;
#pragma nounroll
        for (int t = 0; t < nt; t += 2) {
            const bool last = (t == nt - 2);
            const char* a1 = cA + (size_t)(t + 1) * kstep;
            const char* a2 = last ? nA : cA + (size_t)(t + 2) * kstep; const char* b2 = last ? nB : cB + (size_t)(t + 2) * kstep;
            const char* a3 = a2 + kstep; const char* b3 = b2 + kstep;
            if (last && has_next) S.a_ready(nxt);
            if constexpr (SP2) {
            PG8_LDB(B0, 0, 0); PG8_LDB(B1, 0, 1); PG8_SCHED; PG8_LDA(At, 0, 0); PG8_STAGE(PG8_SA(1, 1), a1 + hsA, voffA);
            PG8_WAIT_V(8); PG8_WAIT_L(0); PG8_BAR; PG8_MMA(0, 0, At, B0); PG8_MMA(0, 1, At, B1); PG8_BAR; PG8_SCHED;
            PG8_LDA(At, 0, 1); PG8_STAGE(PG8_SB(0, 0), b2, voffB); PG8_STAGE(PG8_SB(0, 1), b2 + hsB, voffB); PG8_STAGE(PG8_SA(0, 0), a2, voffA);
            PG8_WAIT_V(8); PG8_WAIT_L(0); PG8_BAR; PG8_MMA(1, 0, At, B0); PG8_MMA(1, 1, At, B1); PG8_BAR; PG8_SCHED;
            PG8_LDB(B0, 1, 0); PG8_LDB(B1, 1, 1); PG8_SCHED; PG8_LDA(At, 1, 0); PG8_STAGE(PG8_SA(0, 1), a2 + hsA, voffA);
            PG8_WAIT_V(8); PG8_WAIT_L(0); PG8_BAR; PG8_MMA(0, 0, At, B0); PG8_MMA(0, 1, At, B1); PG8_BAR; PG8_SCHED;
            PG8_LDA(At, 1, 1); PG8_STAGE(PG8_SB(1, 0), b3, voffB); PG8_STAGE(PG8_SB(1, 1), b3 + hsB, voffB); PG8_STAGE(PG8_SA(1, 0), a3, voffA);
            PG8_WAIT_V(8); PG8_WAIT_L(0); PG8_BAR; PG8_MMA(1, 0, At, B0); PG8_MMA(1, 1, At, B1); PG8_BAR; PG8_SCHED;
            } else {
            PG8_LDB(B0, 0, 0); PG8_SCHED; PG8_LDA(At, 0, 0); PG8_STAGE(PG8_SA(1, 1), a1 + hsA, voffA);
            PG8_WAIT_L(8); PG8_BAR; PG8_WAIT_L(0); PG8_MMA(0, 0, At, B0); PG8_BAR; PG8_SCHED;
            PG8_LDB(B1, 0, 1); PG8_STAGE(PG8_SB(0, 0), b2, voffB);
            PG8_BAR; PG8_WAIT_L(0); PG8_MMA(0, 1, At, B1); PG8_BAR;
            PG8_LDA(At, 0, 1); PG8_STAGE(PG8_SA(0, 0), a2, voffA);
            PG8_BAR; PG8_WAIT_L(0); PG8_MMA(1, 0, At, B0); PG8_BAR; PG8_SCHED;
            PG8_STAGE(PG8_SB(0, 1), b2 + hsB, voffB);
            PG8_WAIT_V(6); PG8_BAR; PG8_MMA(1, 1, At, B1); PG8_BAR;
            PG8_LDB(B0, 1, 0); PG8_SCHED; PG8_LDA(At, 1, 0); PG8_STAGE(PG8_SA(0, 1), a2 + hsA, voffA);
            PG8_WAIT_L(8); PG8_BAR; PG8_WAIT_L(0); PG8_MMA(0, 0, At, B0); PG8_BAR; PG8_SCHED;
            PG8_LDB(B1, 1, 1); PG8_STAGE(PG8_SB(1, 0), b3, voffB);
            PG8_BAR; PG8_WAIT_L(0); PG8_MMA(0, 1, At, B1); PG8_BAR;
            PG8_LDA(At, 1, 1); PG8_STAGE(PG8_SA(1, 0), a3, voffA);
            PG8_BAR; PG8_WAIT_L(0); PG8_MMA(1, 0, At, B0); PG8_BAR; PG8_SCHED;
            PG8_STAGE(PG8_SB(1, 1), b3 + hsB, voffB);
            PG8_WAIT_V(6); PG8_BAR; PG8_MMA(1, 1, At, B1); PG8_BAR;
            }
        }
        if constexpr (ALIGN_EPI) { if (wr == 0) PG8_BAR; }
        if constexpr (!Epi::AFTER_DRAIN) { E(acc, cur, wr, wc, fr, fq); S.done(cur); }
        if (!has_next) break;
#pragma unroll
        for (int a = 0; a < 2; ++a)
#pragma unroll
            for (int b = 0; b < 2; ++b)
#pragma unroll
                for (int m = 0; m < 4; ++m)
#pragma unroll
                    for (int n = 0; n < 2; ++n) acc[a][b][m][n] = (f32x4){0.f, 0.f, 0.f, 0.f};
        cur = nxt; cA = nA; cB = nB; ++ui;
        if constexpr (ALIGN_EPI) { if (wr == 1) PG8_BAR; }
    }
    PG8_WAIT_V(0);
    if constexpr (!ALIGN_EPI) { if (wr == 0) PG8_BAR; }
    PG8_BAR;
    if constexpr (Epi::AFTER_DRAIN) { E.fused(acc, cur, wr, wc, fr, fq, lds, wid, lane); S.done(cur); }
#undef PG8_SA
#undef PG8_SB
#undef PG8_STAGE
#undef PG8_LDA
#undef PG8_LDB
#undef PG8_MMA
#undef PG8_WAIT_V
#undef PG8_WAIT_L
#undef PG8_BAR
#undef PG8_SCHED
}
}

constexpr int NWAVES = 8;
#ifndef MK_PER_PHASE
#define MK_PER_PHASE 1
#endif
constexpr int NPHASE = 12;
constexpr int M = 8192, D = 2048, SEQ = 2048;
constexpr int INC = 4384, INP = 4608;
constexpr float ALPHA = 1.189207115f;
constexpr float LN_EPS = 1e-5f, GN_EPS = 64e-5f;
constexpr size_t MiB = 1u << 20;
constexpr size_t WS_CTL = 0, CTL_ZERO_BYTES = 1 * MiB;
constexpr size_t WS_WGLU = 1 * MiB, WS_WOUT = 3 * MiB, WS_WQK = 11 * MiB, WS_WLORA = 19 * MiB, WS_IDX = 22 * MiB, WS_GATE = 26 * MiB, WS_A32 = 30 * MiB;
constexpr size_t WS_UTAB = 32 * MiB, WS_VTAB = 96 * MiB;
constexpr size_t WS_XB = 160 * MiB, WS_WIN = 192 * MiB, WS_U = 210 * MiB, WS_G = 230 * MiB, WS_MT = 238 * MiB;
constexpr size_t WS_SCAN = 160 * MiB;
constexpr size_t WS_PRW = 286 * MiB, WS_YS = 342 * MiB, WS_CAT = 358 * MiB, WS_ALORA = 390 * MiB, WS_LORA = 396 * MiB, WS_ORW = 444 * MiB;
constexpr size_t WS_Z = 160 * MiB, WS_H1 = 224 * MiB, WS_H1B = 288 * MiB, WS_SC = 390 * MiB;
constexpr size_t WS_END = 476 * MiB;
constexpr int SCAN_REC = 896;
constexpr int CW_BAR = 4096;
constexpr int RING_OFF = 0, RING_BYTES = 131072;
constexpr int LDSCTL_OFF = RING_BYTES, MISC_OFF = LDSCTL_OFF + 320;
constexpr int LDS_BYTES = 147456;

#define GAS __attribute__((address_space(1)))
#define LAS __attribute__((address_space(3)))
typedef unsigned short bf16;
typedef unsigned v4u __attribute__((ext_vector_type(4)));
typedef float f32x4 __attribute__((ext_vector_type(4)));
typedef float f32x2 __attribute__((ext_vector_type(2)));
typedef _Float16 h16x2 __attribute__((ext_vector_type(2)));
typedef __bf16 bf16x2v __attribute__((ext_vector_type(2)));
typedef GAS unsigned gu32;
#define RLX_AGENT __ATOMIC_RELAXED, __HIP_MEMORY_SCOPE_AGENT
#define LDS_WAIT() asm volatile("s_waitcnt lgkmcnt(0)" ::: "memory")
#define VM_WAIT() asm volatile("s_waitcnt vmcnt(0)" ::: "memory")
__device__ __forceinline__ unsigned f2bf(float f) { unsigned u = __builtin_bit_cast(unsigned, f); return (u + 0x7fffu + ((u >> 16) & 1u)) >> 16; }
__device__ __forceinline__ unsigned pk2(float lo, float hi) { return f2bf(lo) | (f2bf(hi) << 16); }
__device__ __forceinline__ float bflo(unsigned w) { return __uint_as_float(w << 16); }
__device__ __forceinline__ float bfhi(unsigned w) { return __uint_as_float(w & 0xffff0000u); }
__device__ __forceinline__ float bf1(bf16 h) { return __uint_as_float((unsigned)h << 16); }
__device__ __forceinline__ unsigned pkh(float lo, float hi) { h16x2 v; v.x = (_Float16)lo; v.y = (_Float16)hi; return __builtin_bit_cast(unsigned, v); }
__device__ __forceinline__ float hlo(unsigned w) { return (float)__builtin_bit_cast(h16x2, w).x; }
__device__ __forceinline__ float hhi(unsigned w) { return (float)__builtin_bit_cast(h16x2, w).y; }
__device__ __forceinline__ float wave_sum(float v) {
#pragma unroll
    for (int o = 1; o < 64; o <<= 1) v += __shfl_xor(v, o);
    return v;
}
using pg8::gelu_tanh; using pg8::sigmoidf; using pg8::pack8;

#define XB_TMO      128
#define XB_XCNT(j)  (256  + 64 * (j))
#define XB_XSUB(j)  (1280 + 64 * (j))
#define XB_XGEN(j)  (2304 + 64 * (j))
#define XB_TOP      3328
#define XB_TOPGEN   3392
#define XCD_BAR_WORDS 3456
#define XB_SPIN_CAP (1u << 18)

__device__ __forceinline__ unsigned xb_ld(unsigned* p)              { return __hip_atomic_load(p, __ATOMIC_RELAXED, __HIP_MEMORY_SCOPE_AGENT); }
__device__ __forceinline__ unsigned xb_add(unsigned* p, unsigned v) { return __hip_atomic_fetch_add(p, v, __ATOMIC_RELAXED, __HIP_MEMORY_SCOPE_AGENT); }
__device__ __forceinline__ unsigned xb_xcc_id() { return (unsigned)__builtin_amdgcn_s_getreg((3 << 11) | 20) & 0xFu; }
#define XB_SPIN(cond, bar) do { unsigned _sp = 0; while (cond) { __builtin_amdgcn_s_sleep(1); \
    if ((++_sp & 255u) == 0u) { if (xb_ld(&(bar)[XB_TMO])) break; if (_sp > XB_SPIN_CAP) { atomicAdd(&(bar)[XB_TMO], 1u); break; } } } } while (0)

struct XcdBarrier {
    unsigned* bar; unsigned x;
    volatile LAS unsigned* st;
};

__device__ __forceinline__ XcdBarrier xcd_barrier_post(unsigned* bar, volatile LAS unsigned* st) {
    XcdBarrier b; b.bar = bar; b.x = xb_xcc_id(); b.st = st;
    if (threadIdx.x == 0) (void)xb_add(&bar[XB_XCNT(b.x)], 1u);
    return b;
}
__device__ __forceinline__ void xcd_barrier_complete(unsigned* bar, unsigned x, unsigned& nloc, unsigned& nx) {
    const unsigned G = gridDim.x * gridDim.y * gridDim.z;
    unsigned sum, cnt, mine, sp = 0u;
    for (;;) {
        sum = 0u; cnt = 0u; mine = 0u;
#pragma unroll
        for (unsigned j = 0; j < 16; ++j) { const unsigned c = xb_ld(&bar[XB_XCNT(j)]); sum += c; cnt += (c > 0u) ? 1u : 0u; mine = (j == x) ? c : mine; }
        if (sum == G) break;
        __builtin_amdgcn_s_sleep(1);
        if ((++sp & 255u) == 0u) { if (xb_ld(&bar[XB_TMO])) break; if (sp > XB_SPIN_CAP) { atomicAdd(&bar[XB_TMO], 1u); break; } }
    }
    nloc = mine > 0u ? mine : 1u; nx = cnt > 0u ? cnt : 1u;
}

__device__ __forceinline__ void xcd_barrier(const XcdBarrier& b) {
    asm volatile("s_waitcnt vmcnt(0)" ::: "memory");
    __syncthreads();
    if (threadIdx.x == 0) {
        unsigned* bar = b.bar;
        __builtin_amdgcn_s_waitcnt(0);
        unsigned nloc = b.st[0], nx = b.st[1];
        if (nloc == 0u) { xcd_barrier_complete(bar, b.x, nloc, nx); b.st[0] = nloc; b.st[1] = nx; }
        const unsigned old = xb_add(&bar[XB_XSUB(b.x)], 1u);
        const unsigned gen = old / nloc;
        if (old + 1u == (gen + 1u) * nloc) {
            __builtin_amdgcn_fence(__ATOMIC_RELEASE, "agent");
            asm volatile("s_waitcnt vmcnt(0)" ::: "memory");
            const unsigned og = xb_add(&bar[XB_TOP], 1u);
            const unsigned tg = og / nx;
            if (og + 1u == (tg + 1u) * nx) xb_add(&bar[XB_TOPGEN], 1u);
            else XB_SPIN(xb_ld(&bar[XB_TOPGEN]) == tg, bar);
            __builtin_amdgcn_fence(__ATOMIC_ACQUIRE, "agent");
            xb_add(&bar[XB_XGEN(b.x)], 1u);
            asm volatile("s_waitcnt vmcnt(0)" ::: "memory");
        } else {
            XB_SPIN(xb_ld(&bar[XB_XGEN(b.x)]) == gen, bar);
            __builtin_amdgcn_fence(__ATOMIC_ACQUIRE, "agent");
            asm volatile("s_waitcnt vmcnt(0)" ::: "memory");
        }
    }
    __syncthreads();
}

struct Args { const float* in[33]; float* out; unsigned char* ws; int ph_lo, ph_hi, li, pad; };
struct Frame {
    LAS unsigned char* lds;
    volatile LAS unsigned* MISC;
    gu32* ctl;
    int tid, lane, wave, bid, G;
};
enum { I_X = 0, I_WIN, I_LAMRE, I_LAMIM, I_LOGSTEP, I_BRE, I_BIM, I_CRE, I_CIM, I_SD, I_WGLU, I_BGLU, I_MU, I_W0, I_WUP, I_A0, I_AUP, I_GUP, I_KK, I_KA, I_RK, I_GNG, I_GNB,
       I_WOUT, I_LN1G, I_LN1B, I_WQ, I_KEYS1, I_KEYS2, I_PU, I_PV, I_LN2G, I_LN2B };

__device__ __forceinline__ void p0_transpose_item(const float* W, int K, int N, bf16* WT, int row_off, LAS float* scr, int item, int lane) {
    const int nblk = N / 32, kb = item / nblk, nb = item % nblk, k0 = 64 * kb, n0 = 32 * nb;
#pragma unroll 8
    for (int i = 0; i < 32; ++i) { const int kk = 2 * i + (lane >> 5); scr[kk * 33 + (lane & 31)] = W[(size_t)(k0 + kk) * N + n0 + (lane & 31)]; }
    LDS_WAIT(); asm volatile("" ::: "memory");
    const int c = lane & 7;
#pragma unroll
    for (int j = 0; j < 4; ++j) { const int n = (lane >> 3) + 8 * j; const LAS float* s = scr + (8 * c) * 33 + n;
        v4u o; o.x = pk2(s[0 * 33], s[1 * 33]); o.y = pk2(s[2 * 33], s[3 * 33]); o.z = pk2(s[4 * 33], s[5 * 33]); o.w = pk2(s[6 * 33], s[7 * 33]);
        *(GAS v4u*)(WT + (size_t)(row_off + n0 + n) * K + k0 + 8 * c) = o; }
    LDS_WAIT(); asm volatile("" ::: "memory");
}
__device__ __forceinline__ void cvt_stream(const float* src, bf16* dst, size_t n8, size_t gtid, size_t nt) {
    for (size_t i = gtid; i < n8; i += nt) { const f32x4 a = ((const f32x4*)src)[2 * i], b = ((const f32x4*)src)[2 * i + 1]; ((v4u*)dst)[i] = pack8(a, b); }
}

__device__ __forceinline__ void p0_prologue(Frame& F, const Args& A) {
    unsigned char* ws = A.ws;
    const size_t gtid = (size_t)F.bid * 512 + F.tid, NT = (size_t)F.G * 512;
    const int gw = F.bid * NWAVES + F.wave, NGW = F.G * NWAVES;
    if (F.bid < 64) {
        const int g = F.bid, tid = F.tid;
        LAS f32x2* AP = (LAS f32x2*)(F.lds);
        LAS f32x2* BB = (LAS f32x2*)(F.lds + 16896);
        LAS float* KJ = (LAS float*)(F.lds + 16896 + 8192);
        const float* lam_re = A.in[I_LAMRE] + g * 64; const float* lam_im = A.in[I_LAMIM] + g * 64;
        const float step = __expf(A.in[I_LOGSTEP][g]);
        for (int idx = tid; idx < 33 * 64; idx += 512) { const int j = idx >> 6, p = idx & 63; const float lr = lam_re[p], li = lam_im[p];
            const float mag = __expf(lr * step * (float)j); float rev = (li * step * 0.15915494309f) * (float)j; rev -= floorf(rev);
            AP[idx] = (f32x2){mag * __builtin_amdgcn_cosf(rev), mag * __builtin_amdgcn_sinf(rev)}; }
        LDS_WAIT(); __syncthreads();
        for (int idx = tid; idx < 64 * 16; idx += 512) { const int p = idx >> 4, h = idx & 15; const float lr = lam_re[p], li = lam_im[p]; const f32x2 a = AP[64 + p];
            const float den = lr * lr + li * li, fr = ((a.x - 1.f) * lr + a.y * li) / den, fi = (a.y * lr - (a.x - 1.f) * li) / den;
            const float br = A.in[I_BRE][(g * 64 + p) * 16 + h], bi = A.in[I_BIM][(g * 64 + p) * 16 + h];
            BB[idx] = (f32x2){fr * br - fi * bi, fr * bi + fi * br}; }
        if (tid < 64) { const f32x2 a = AP[32 * 64 + tid]; float* a32 = (float*)(ws + WS_A32); a32[(g * 64 + tid) * 2] = a.x; a32[(g * 64 + tid) * 2 + 1] = a.y; }
        LDS_WAIT(); __syncthreads();
        const float* cre = A.in[I_CRE] + (size_t)g * 16 * 64; const float* cim = A.in[I_CIM] + (size_t)g * 16 * 64;
        for (int idx = tid; idx < 32 * 256; idx += 512) { const int j = idx >> 8, h = (idx >> 4) & 15, hp = idx & 15; float s = 0.f;
            for (int p = 0; p < 64; ++p) { const f32x2 a = AP[j * 64 + p], bb = BB[p * 16 + hp]; const float wr = a.x * bb.x - a.y * bb.y, wi = a.x * bb.y + a.y * bb.x;
                s += cre[h * 64 + p] * wr - cim[h * 64 + p] * wi; }
            KJ[idx] = s; }
        LDS_WAIT(); __syncthreads();
        bf16* Gt = (bf16*)(ws + WS_G); bf16* MT = (bf16*)(ws + WS_MT);
        for (int it = tid; it < 8192; it += 512) { const int row = it >> 6, cb = (it & 63) * 8, s = cb >> 4, h0 = cb & 15, p = row & 63, im = row >> 6; const f32x2 a = AP[(31 - s) * 64 + p];
            float v[8];
#pragma unroll
            for (int e = 0; e < 8; ++e) { const f32x2 bb = BB[p * 16 + h0 + e]; v[e] = im ? (a.x * bb.y + a.y * bb.x) : (a.x * bb.x - a.y * bb.y); }
            v4u o; o.x = pk2(v[0], v[1]); o.y = pk2(v[2], v[3]); o.z = pk2(v[4], v[5]); o.w = pk2(v[6], v[7]);
            *(v4u*)(Gt + (size_t)(g * 128 + row) * 512 + cb) = o; }
        const float* dsk = A.in[I_SD] + g * 16;
        for (int it = tid; it < 40960; it += 512) { const int n = it / 80, kb = (it % 80) * 8, t = n >> 4, h = n & 15; float v[8];
            if (kb < 512) { const int s = kb >> 4, h0 = kb & 15;
#pragma unroll
                for (int e = 0; e < 8; ++e) { const int hp = h0 + e; float x = 0.f; if (s <= t) { x = KJ[(t - s) * 256 + h * 16 + hp]; if (s == t && hp == h) x += dsk[h]; } v[e] = x; } }
            else { const int p0 = (kb < 576) ? (kb - 512) : (kb - 576);
#pragma unroll
                for (int e = 0; e < 8; ++e) { const int p = p0 + e; const f32x2 a = AP[(t + 1) * 64 + p]; const float cr = cre[h * 64 + p], ci = cim[h * 64 + p];
                    v[e] = (kb < 576) ? (cr * a.x - ci * a.y) : -(cr * a.y + ci * a.x); } }
            v4u o; o.x = pk2(v[0], v[1]); o.y = pk2(v[2], v[3]); o.z = pk2(v[4], v[5]); o.w = pk2(v[6], v[7]);
            *(v4u*)(MT + (size_t)(g * 512 + n) * 640 + kb) = o; }
        LDS_WAIT(); __syncthreads();
    }
    cvt_stream(A.in[I_X], (bf16*)(ws + WS_XB), (size_t)M * D / 8, gtid, NT);
    cvt_stream(A.in[I_PU], (bf16*)(ws + WS_UTAB), (size_t)16384 * 2048 / 8, gtid, NT);
    cvt_stream(A.in[I_PV], (bf16*)(ws + WS_VTAB), (size_t)16384 * 2048 / 8, gtid, NT);
    {
        LAS float* scr = (LAS float*)(F.lds + RING_OFF + F.wave * 16384);
        constexpr int I_IN = (2048 / 64) * (INC / 32), I_GL = (1024 / 64) * (1024 / 32), I_OU = (2048 / 64) * (2048 / 32);
        for (int it = gw; it < I_IN + I_GL + I_OU; it += NGW) { int r = it;
            if (r < I_IN) { p0_transpose_item(A.in[I_WIN], 2048, INC, (bf16*)(ws + WS_WIN), 0, scr, r, F.lane); continue; } r -= I_IN;
            if (r < I_GL) { p0_transpose_item(A.in[I_WGLU], 1024, 1024, (bf16*)(ws + WS_WGLU), 0, scr, r, F.lane); continue; } r -= I_GL;
            p0_transpose_item(A.in[I_WOUT], 2048, 2048, (bf16*)(ws + WS_WOUT), 0, scr, r, F.lane); }
        v4u* z = (v4u*)((bf16*)(ws + WS_WIN) + (size_t)INC * 2048);
        for (size_t i = gtid; i < (size_t)(INP - INC) * 2048 / 8; i += NT) z[i] = (v4u){0u, 0u, 0u, 0u};
    }
    {
        bf16* WL = (bf16*)(ws + WS_WLORA);
        for (size_t i = gtid; i < (size_t)3072 * 384; i += NT) { const int n = (int)(i / 384), k = (int)(i % 384); float v = 0.f;
            if (n < 1024) { if (k < 64) v = A.in[I_WUP][k * 1024 + n]; }
            else if (n < 2048) { if (k >= 64 && k < 128) v = A.in[I_AUP][(k - 64) * 1024 + (n - 1024)]; }
            else { if (k >= 128 && k < 288) v = A.in[I_GUP][(k - 128) * 1024 + (n - 2048)]; }
            WL[i] = (bf16)f2bf(v); }
    }
    __syncthreads();
    {
        LAS float* Ks = (LAS float*)(F.lds); LAS float* Ws = (LAS float*)(F.lds + 128 * 129 * 4);
        bf16* WQK = (bf16*)(ws + WS_WQK); const int tid = F.tid;
        for (int unit = F.bid; unit < 512; unit += F.G) { const int hj = unit >> 5, dblk = unit & 31, h = hj >> 1, j = hj & 1;
            const float* keys = (j ? A.in[I_KEYS2] : A.in[I_KEYS1]) + (size_t)h * 128 * 128;
            for (int idx = tid; idx < 16384; idx += 512) Ks[(idx >> 7) * 129 + (idx & 127)] = keys[idx];
            for (int idx = tid; idx < 8192; idx += 512) Ws[(idx >> 7) * 129 + (idx & 127)] = A.in[I_WQ][(size_t)(dblk * 64 + (idx >> 7)) * 2048 + hj * 128 + (idx & 127)];
            LDS_WAIT(); __syncthreads();
            const int key = tid & 127, dq = tid >> 7; float acc[16];
#pragma unroll
            for (int i = 0; i < 16; ++i) acc[i] = 0.f;
            for (int c = 0; c < 128; ++c) { const float a = Ks[key * 129 + c];
#pragma unroll
                for (int i = 0; i < 16; ++i) acc[i] += a * Ws[(dq * 16 + i) * 129 + c]; }
            v4u o0, o1; o0.x = pk2(acc[0], acc[1]); o0.y = pk2(acc[2], acc[3]); o0.z = pk2(acc[4], acc[5]); o0.w = pk2(acc[6], acc[7]);
            o1.x = pk2(acc[8], acc[9]); o1.y = pk2(acc[10], acc[11]); o1.z = pk2(acc[12], acc[13]); o1.w = pk2(acc[14], acc[15]);
            v4u* dst = (v4u*)(WQK + (size_t)(hj * 128 + key) * 2048 + dblk * 64 + dq * 16); dst[0] = o0; dst[1] = o1;
            LDS_WAIT(); __syncthreads(); }
    }
}

__device__ __forceinline__ void r1_lora_in(Frame& F, const Args& A) {
    const bf16* PRW = (const bf16*)(A.ws + WS_PRW); bf16* AL = (bf16*)(A.ws + WS_ALORA); const float* mu = A.in[I_MU];
    const int gw = F.bid * NWAVES + F.wave, NGW = F.G * NWAVES;
    for (int m = gw; m < M; m += NGW) { const int t = m & (SEQ - 1);
#pragma unroll
        for (int q = 0; q < 6; ++q) { const int idx = q * 64 + F.lane; float val = 0.f;
            if (idx < 288) { const int col = 3072 + idx; const float cur = bf1(PRW[(size_t)m * 3584 + col]); const float prev = (t > 0) ? bf1(PRW[(size_t)(m - 1) * 3584 + col]) : 0.f;
                const float s = cur + mu[col] * (prev - cur);
                val = (idx < 64) ? (1.f - 2.f / (1.f + __expf(2.f * s))) : ((idx < 128) ? s : sigmoidf(s)); }
            AL[(size_t)m * 384 + idx] = (bf16)f2bf(val); } }
}

__device__ __forceinline__ void r3_prep(Frame& F, const Args& A) {
    const bf16* PRW = (const bf16*)(A.ws + WS_PRW); const bf16* LO = (const bf16*)(A.ws + WS_LORA); unsigned char* SC = A.ws + WS_SCAN;
    const float* mu = A.in[I_MU]; const int lane = F.lane, head = lane >> 2, j0 = (lane & 3) * 16, ch = lane * 16;
    const int gw = F.bid * NWAVES + F.wave, NGW = F.G * NWAVES;
    for (int m = gw; m < M; m += NGW) { const int t = m & (SEQ - 1), b = m >> 11;
        float rs[16], ks[16], vs[16];
#pragma unroll
        for (int part = 0; part < 3; ++part) { const int col = part * 1024 + ch; const v4u c0 = *(const v4u*)(PRW + (size_t)m * 3584 + col), c1 = *(const v4u*)(PRW + (size_t)m * 3584 + col + 8);
            v4u p0 = (v4u){0u, 0u, 0u, 0u}, p1 = p0; if (t > 0) { p0 = *(const v4u*)(PRW + (size_t)(m - 1) * 3584 + col); p1 = *(const v4u*)(PRW + (size_t)(m - 1) * 3584 + col + 8); }
            float cu[16], pr[16];
#pragma unroll
            for (int e = 0; e < 4; ++e) { cu[2 * e] = bflo(c0[e]); cu[2 * e + 1] = bfhi(c0[e]); cu[8 + 2 * e] = bflo(c1[e]); cu[8 + 2 * e + 1] = bfhi(c1[e]);
                pr[2 * e] = bflo(p0[e]); pr[2 * e + 1] = bfhi(p0[e]); pr[8 + 2 * e] = bflo(p1[e]); pr[8 + 2 * e + 1] = bfhi(p1[e]); }
#pragma unroll
            for (int e = 0; e < 16; ++e) { const float s = cu[e] + mu[col + e] * (pr[e] - cu[e]); if (part == 0) rs[e] = s; else if (part == 1) ks[e] = s; else vs[e] = s; } }
        const v4u wl0 = *(const v4u*)(LO + (size_t)m * 3072 + ch), wl1 = *(const v4u*)(LO + (size_t)m * 3072 + ch + 8);
        const v4u al0 = *(const v4u*)(LO + (size_t)m * 3072 + 1024 + ch), al1 = *(const v4u*)(LO + (size_t)m * 3072 + 1024 + ch + 8);
        float wl[16], al[16];
#pragma unroll
        for (int e = 0; e < 4; ++e) { wl[2 * e] = bflo(wl0[e]); wl[2 * e + 1] = bfhi(wl0[e]); wl[8 + 2 * e] = bflo(wl1[e]); wl[8 + 2 * e + 1] = bfhi(wl1[e]);
            al[2 * e] = bflo(al0[e]); al[2 * e + 1] = bfhi(al0[e]); al[8 + 2 * e] = bflo(al1[e]); al[8 + 2 * e + 1] = bfhi(al1[e]); }
        float dec[16], kp[16], kk[16], aa[16]; float n2 = 0.f;
#pragma unroll
        for (int e = 0; e < 16; ++e) { const float x = A.in[I_W0][ch + e] + wl[e]; const float y = -x; const float sp = fmaxf(y, 0.f) + __logf(1.f + __expf(-fabsf(y)));
            const float w = -sp - 0.5f; dec[e] = __expf(-__expf(w));
            const float a = sigmoidf(A.in[I_A0][ch + e] + al[e]); aa[e] = a;
            kk[e] = ks[e] * A.in[I_KK][ch + e]; n2 += kk[e] * kk[e];
            kp[e] = ks[e] * (1.f + (a - 1.f) * A.in[I_KA][ch + e]); }
        n2 += __shfl_xor(n2, 1); n2 += __shfl_xor(n2, 2);
        const float inv = 1.f / fmaxf(sqrtf(n2), 1e-12f);
        unsigned char* rec = SC + ((size_t)(b * 16 + head) * SEQ + t) * SCAN_REC;
#pragma unroll
        for (int q = 0; q < 4; ++q) { unsigned char* pj = rec + ((lane & 3) * 4 + q) * 48;
            *(f32x4*)pj = (f32x4){dec[4 * q], dec[4 * q + 1], dec[4 * q + 2], dec[4 * q + 3]};
            v4u o; o.x = pkh(rs[4 * q], rs[4 * q + 1]); o.y = pkh(rs[4 * q + 2], rs[4 * q + 3]); o.z = pkh(kp[4 * q], kp[4 * q + 1]); o.w = pkh(kp[4 * q + 2], kp[4 * q + 3]); *(v4u*)(pj + 16) = o;
            const float k0 = kk[4 * q] * inv, k1 = kk[4 * q + 1] * inv, k2 = kk[4 * q + 2] * inv, k3 = kk[4 * q + 3] * inv;
            v4u o2; o2.x = pkh(k0, k1); o2.y = pkh(k2, k3); o2.z = pkh(k0 * aa[4 * q], k1 * aa[4 * q + 1]); o2.w = pkh(k2 * aa[4 * q + 2], k3 * aa[4 * q + 3]); *(v4u*)(pj + 32) = o2; }
        v4u v0, v1; v0.x = pkh(vs[0], vs[1]); v0.y = pkh(vs[2], vs[3]); v0.z = pkh(vs[4], vs[5]); v0.w = pkh(vs[6], vs[7]);
        v1.x = pkh(vs[8], vs[9]); v1.y = pkh(vs[10], vs[11]); v1.z = pkh(vs[12], vs[13]); v1.w = pkh(vs[14], vs[15]);
        *(v4u*)(rec + 768 + j0 * 2) = v0; *(v4u*)(rec + 768 + j0 * 2 + 16) = v1; }
}

__device__ __forceinline__ float dpp_f(float v, const int ctrl_sel) {
    const int iv = __builtin_bit_cast(int, v); int r;
    switch (ctrl_sel) { case 0: r = __builtin_amdgcn_update_dpp(0, iv, 0xB1, 0xf, 0xf, false); break;
                        case 1: r = __builtin_amdgcn_update_dpp(0, iv, 0x4E, 0xf, 0xf, false); break;
                        case 2: r = __builtin_amdgcn_update_dpp(0, iv, 0x141, 0xf, 0xf, false); break;
                        default: r = __builtin_amdgcn_update_dpp(0, iv, 0x140, 0xf, 0xf, false); break; }
    return __builtin_bit_cast(float, r);
}
__device__ __forceinline__ float allsum16(float x) { x += dpp_f(x, 0); x += dpp_f(x, 1); x += dpp_f(x, 2); x += dpp_f(x, 3); return x; }
struct ScanIn { f32x4 dec; v4u rk, kb; unsigned short v; };
__device__ __forceinline__ ScanIn scan_load(const unsigned char* base, int t, int jg, int row) {
    ScanIn s; const unsigned char* p = base + (size_t)t * SCAN_REC; s.dec = *(const f32x4*)(p + jg * 48); s.rk = *(const v4u*)(p + jg * 48 + 16); s.kb = *(const v4u*)(p + jg * 48 + 32);
    s.v = *(const unsigned short*)(p + 768 + row * 2); return s;
}
__device__ __forceinline__ void r4_scan(Frame& F, const Args& A) {
    if (F.bid >= 128) return;
    const int bh = F.bid >> 1, half = F.bid & 1, lane = F.lane, rl = lane >> 4, jg = lane & 15, row = half * 32 + F.wave * 4 + rl;
    const unsigned char* base = A.ws + WS_SCAN + (size_t)bh * SEQ * SCAN_REC;
    float* O = (float*)(A.ws + WS_ORW) + (size_t)(bh >> 4) * SEQ * 1024 + (bh & 15) * 64 + row;
    float S0 = 0.f, S1 = 0.f, S2 = 0.f, S3 = 0.f;
    ScanIn nx[4];
#pragma unroll
    for (int u = 0; u < 4; ++u) nx[u] = scan_load(base, u, jg, row);
    for (int t0 = 0; t0 < SEQ; t0 += 4) {
        ScanIn cu[4];
#pragma unroll
        for (int u = 0; u < 4; ++u) cu[u] = nx[u];
        if (t0 + 4 < SEQ) {
#pragma unroll
            for (int u = 0; u < 4; ++u) nx[u] = scan_load(base, t0 + 4 + u, jg, row); }
#pragma unroll
        for (int u = 0; u < 4; ++u) { const ScanIn& s = cu[u];
            const float r0 = hlo(s.rk.x), r1 = hhi(s.rk.x), r2 = hlo(s.rk.y), r3 = hhi(s.rk.y), k0 = hlo(s.rk.z), k1 = hhi(s.rk.z), k2 = hlo(s.rk.w), k3 = hhi(s.rk.w);
            const float c0 = hlo(s.kb.x), c1 = hhi(s.kb.x), c2 = hlo(s.kb.y), c3 = hhi(s.kb.y), b0 = hlo(s.kb.z), b1 = hhi(s.kb.z), b2 = hlo(s.kb.w), b3 = hhi(s.kb.w);
            const float v = (float)__builtin_bit_cast(_Float16, s.v);
            float sa = (S0 * c0 + S1 * c1) + (S2 * c2 + S3 * c3); sa = allsum16(sa);
            S0 = S0 * s.dec[0] - sa * b0 + v * k0; S1 = S1 * s.dec[1] - sa * b1 + v * k1; S2 = S2 * s.dec[2] - sa * b2 + v * k2; S3 = S3 * s.dec[3] - sa * b3 + v * k3;
            float o = (S0 * r0 + S1 * r1) + (S2 * r2 + S3 * r3); o = allsum16(o);
            if (jg == 0) O[(size_t)(t0 + u) * 1024] = o; }
    }
}

__device__ __forceinline__ void r5_post(Frame& F, const Args& A) {
    const float* ORW = (const float*)(A.ws + WS_ORW); const bf16* LO = (const bf16*)(A.ws + WS_LORA); const unsigned char* SC = A.ws + WS_SCAN; bf16* CAT = (bf16*)(A.ws + WS_CAT);
    const int lane = F.lane, head = lane >> 2, j0 = (lane & 3) * 16, ch = lane * 16;
    const int gw = F.bid * NWAVES + F.wave, NGW = F.G * NWAVES;
    for (int m = gw; m < M; m += NGW) { const int t = m & (SEQ - 1), b = m >> 11;
        float o[16];
#pragma unroll
        for (int q = 0; q < 4; ++q) { const f32x4 x = *(const f32x4*)(ORW + (size_t)m * 1024 + ch + 4 * q); o[4 * q] = x[0]; o[4 * q + 1] = x[1]; o[4 * q + 2] = x[2]; o[4 * q + 3] = x[3]; }
        float s = 0.f;
#pragma unroll
        for (int e = 0; e < 16; ++e) s += o[e];
        s += __shfl_xor(s, 1); s += __shfl_xor(s, 2); const float mean = s * (1.f / 64.f); float q2 = 0.f;
#pragma unroll
        for (int e = 0; e < 16; ++e) { const float d = o[e] - mean; q2 += d * d; }
        q2 += __shfl_xor(q2, 1); q2 += __shfl_xor(q2, 2); const float rstd = 1.f / sqrtf(q2 * (1.f / 64.f) + GN_EPS);
        const unsigned char* rec = SC + ((size_t)(b * 16 + head) * SEQ + t) * SCAN_REC; float dp = 0.f;
#pragma unroll
        for (int q = 0; q < 4; ++q) { const v4u rk = *(const v4u*)(rec + ((lane & 3) * 4 + q) * 48 + 16); const float* rkp = A.in[I_RK] + head * 64 + j0 + 4 * q;
            dp += hlo(rk.x) * hlo(rk.z) * rkp[0] + hhi(rk.x) * hhi(rk.z) * rkp[1] + hlo(rk.y) * hlo(rk.w) * rkp[2] + hhi(rk.y) * hhi(rk.w) * rkp[3]; }
        dp += __shfl_xor(dp, 1); dp += __shfl_xor(dp, 2);
        const v4u v0 = *(const v4u*)(rec + 768 + j0 * 2), v1 = *(const v4u*)(rec + 768 + j0 * 2 + 16);
        const v4u g0 = *(const v4u*)(LO + (size_t)m * 3072 + 2048 + ch), g1 = *(const v4u*)(LO + (size_t)m * 3072 + 2048 + ch + 8);
        float vv[16], gg[16];
#pragma unroll
        for (int e = 0; e < 4; ++e) { vv[2 * e] = hlo(v0[e]); vv[2 * e + 1] = hhi(v0[e]); vv[8 + 2 * e] = hlo(v1[e]); vv[8 + 2 * e + 1] = hhi(v1[e]);
            gg[2 * e] = bflo(g0[e]); gg[2 * e + 1] = bfhi(g0[e]); gg[8 + 2 * e] = bflo(g1[e]); gg[8 + 2 * e + 1] = bfhi(g1[e]); }
        float r[16];
#pragma unroll
        for (int e = 0; e < 16; ++e) r[e] = ((o[e] - mean) * rstd * A.in[I_GNG][ch + e] + A.in[I_GNB][ch + e] + dp * vv[e]) * gg[e];
        v4u w0, w1; w0.x = pk2(r[0], r[1]); w0.y = pk2(r[2], r[3]); w0.z = pk2(r[4], r[5]); w0.w = pk2(r[6], r[7]); w1.x = pk2(r[8], r[9]); w1.y = pk2(r[10], r[11]); w1.z = pk2(r[12], r[13]); w1.w = pk2(r[14], r[15]);
        *(v4u*)(CAT + (size_t)m * 2048 + 1024 + ch) = w0; *(v4u*)(CAT + (size_t)m * 2048 + 1024 + ch + 8) = w1; }
}

__device__ __forceinline__ void ln1_rows(Frame& F, const Args& A) {
    const float* Z = (const float*)(A.ws + WS_Z); float* H1 = (float*)(A.ws + WS_H1); bf16* H1B = (bf16*)(A.ws + WS_H1B);
    const int gw = F.bid * NWAVES + F.wave, NGW = F.G * NWAVES, lane = F.lane;
    for (int m = gw; m < M; m += NGW) { const f32x4* zr = (const f32x4*)(Z + (size_t)m * D) + lane; f32x4 v[8]; float s = 0.f;
#pragma unroll
        for (int j = 0; j < 8; ++j) { v[j] = zr[64 * j]; s += (v[j].x + v[j].y) + (v[j].z + v[j].w); }
        const float mean = wave_sum(s) * (1.f / D); float s2 = 0.f;
#pragma unroll
        for (int j = 0; j < 8; ++j) { v[j] = v[j] - mean; s2 += (v[j].x * v[j].x + v[j].y * v[j].y) + (v[j].z * v[j].z + v[j].w * v[j].w); }
        const float rstd = 1.f / sqrtf(wave_sum(s2) * (1.f / D) + LN_EPS);
#pragma unroll
        for (int j = 0; j < 8; ++j) { const f32x4 g = ((const f32x4*)A.in[I_LN1G])[64 * j + lane], bb = ((const f32x4*)A.in[I_LN1B])[64 * j + lane]; const f32x4 y = v[j] * rstd * g + bb;
            ((f32x4*)(H1 + (size_t)m * D))[64 * j + lane] = y;
            unsigned long long pk = (unsigned long long)pk2(y.x, y.y) | ((unsigned long long)pk2(y.z, y.w) << 32); ((unsigned long long*)(H1B + (size_t)m * D))[64 * j + lane] = pk; } }
}

__device__ __forceinline__ void ins16(float (&tv)[16], float x) {
#pragma unroll
    for (int k = 15; k >= 1; --k) tv[k] = __builtin_amdgcn_fmed3f(tv[k - 1], tv[k], x);
    tv[0] = fmaxf(tv[0], x);
}
__device__ __forceinline__ void topk_phase(Frame& F, const Args& A) {
    const float* SCp = (const float*)(A.ws + WS_SC); int* IDX = (int*)(A.ws + WS_IDX); float* GATE = (float*)(A.ws + WS_GATE);
    LAS float* scr = (LAS float*)(F.lds + F.wave * 8448); LAS unsigned* scu = (LAS unsigned*)scr;
    const int gw = F.bid * NWAVES + F.wave, NGW = F.G * NWAVES, lane = F.lane;
    for (int grp = gw; grp < M / 4; grp += NGW) { const float* base = SCp + (size_t)grp * 4 * 2048;
        float tv[16];
#pragma unroll
        for (int k = 0; k < 16; ++k) tv[k] = -INFINITY;
        for (int q = 0; q < 4; ++q) {
#pragma unroll
            for (int k = 0; k < 8; ++k) { const int rowl = k * 8 + (lane >> 3), c4 = (lane & 7) * 4; const f32x4 x = *(const f32x4*)(base + rowl * 128 + q * 32 + c4);
                scr[rowl * 33 + c4] = x[0]; scr[rowl * 33 + c4 + 1] = x[1]; scr[rowl * 33 + c4 + 2] = x[2]; scr[rowl * 33 + c4 + 3] = x[3]; }
            LDS_WAIT(); asm volatile("" ::: "memory");
#pragma unroll
            for (int i = 0; i < 32; ++i) { const unsigned key = (scu[lane * 33 + i] & ~127u) | (unsigned)(q * 32 + i); ins16(tv, __uint_as_float(key)); }
            LDS_WAIT(); asm volatile("" ::: "memory");
        }
        const int jb = lane & 1; float Av[16], Bv[16];
#pragma unroll
        for (int k = 0; k < 16; ++k) { const float ot = __shfl_xor(tv[k], 1); Av[k] = jb ? ot : tv[k]; Bv[k] = jb ? tv[k] : ot; }
#pragma unroll
        for (int k = 0; k < 16; ++k) { scu[lane * 33 + k] = __float_as_uint(Av[k]) & 127u; scu[lane * 33 + 16 + k] = __float_as_uint(Bv[k]) & 127u; }
        float tw[16];
#pragma unroll
        for (int k = 0; k < 16; ++k) tw[k] = -INFINITY;
#define CROW(i, n) _Pragma("unroll") for (int jj = 0; jj < (n); ++jj) { const float c = Av[i] + Bv[jj]; ins16(tw, __uint_as_float((__float_as_uint(c) & ~255u) | (unsigned)((i) * 16 + jj))); }
        CROW(0, 16) CROW(1, 8) CROW(2, 5) CROW(3, 4) CROW(4, 3) CROW(5, 2) CROW(6, 2) CROW(7, 2) CROW(8, 1) CROW(9, 1) CROW(10, 1) CROW(11, 1) CROW(12, 1) CROW(13, 1) CROW(14, 1) CROW(15, 1)
#undef CROW
        LDS_WAIT(); asm volatile("" ::: "memory");
        float ex[16]; float sum = 0.f;
#pragma unroll
        for (int k = 0; k < 16; ++k) { ex[k] = __expf(tw[k] - tw[0]); sum += ex[k]; }
        const float rs = 1.f / sum; int eid[16];
#pragma unroll
        for (int k = 0; k < 16; ++k) { const unsigned pos = __float_as_uint(tw[k]) & 255u; const unsigned ia = scu[lane * 33 + (pos >> 4)], ib = scu[lane * 33 + 16 + (pos & 15u)]; eid[k] = (int)(ia * 128u + ib); }
        const int token = grp * 4 + (lane >> 4), head = (lane >> 1) & 7; const size_t ob = (size_t)token * 128 + head * 16;
        if (jb == 0) {
#pragma unroll
            for (int k = 0; k < 16; k += 4) { *(int4*)(IDX + ob + k) = make_int4(eid[k], eid[k + 1], eid[k + 2], eid[k + 3]); *(f32x4*)(GATE + ob + k) = (f32x4){ex[k] * rs, ex[k + 1] * rs, ex[k + 2] * rs, ex[k + 3] * rs}; } }
        LDS_WAIT(); asm volatile("" ::: "memory");
    }
}

__device__ __forceinline__ float dot2bf(unsigned w, unsigned x, float acc) { return __builtin_amdgcn_fdot2_f32_bf16(__builtin_bit_cast(bf16x2v, w), __builtin_bit_cast(bf16x2v, x), acc, false); }
__device__ __forceinline__ void peer_phase(Frame& F, const Args& A) {
    const bf16* H1B = (const bf16*)(A.ws + WS_H1B); const float* H1 = (const float*)(A.ws + WS_H1); const bf16* UT = (const bf16*)(A.ws + WS_UTAB); const bf16* VT = (const bf16*)(A.ws + WS_VTAB);
    const int* IDX = (const int*)(A.ws + WS_IDX); const float* GATE = (const float*)(A.ws + WS_GATE);
    const int gw = F.bid * NWAVES + F.wave, NGW = F.G * NWAVES, lane = F.lane;
    for (int m = gw; m < M; m += NGW) {
        v4u xq[4];
#pragma unroll
        for (int q = 0; q < 4; ++q) xq[q] = ((const v4u*)(H1B + (size_t)m * D))[q * 64 + lane];
        float acc[32];
#pragma unroll
        for (int i = 0; i < 32; ++i) acc[i] = 0.f;
        for (int kk = 0; kk < 2; ++kk) { const int my_e = IDX[(size_t)m * 128 + kk * 64 + lane]; const float my_g = GATE[(size_t)m * 128 + kk * 64 + lane];
            for (int k = 0; k < 64; ++k) { const int e = __builtin_amdgcn_readlane(my_e, k); const float g = __builtin_bit_cast(float, __builtin_amdgcn_readlane(__builtin_bit_cast(int, my_g), k));
                const v4u* ur = (const v4u*)(UT + (size_t)e * D); const v4u* vr = (const v4u*)(VT + (size_t)e * D);
                v4u uq[4], vq[4];
#pragma unroll
                for (int q = 0; q < 4; ++q) { uq[q] = ur[q * 64 + lane]; vq[q] = vr[q * 64 + lane]; }
                float d = 0.f;
#pragma unroll
                for (int q = 0; q < 4; ++q) { d = dot2bf(uq[q].x, xq[q].x, d); d = dot2bf(uq[q].y, xq[q].y, d); d = dot2bf(uq[q].z, xq[q].z, d); d = dot2bf(uq[q].w, xq[q].w, d); }
                d = wave_sum(d); const float s = g * gelu_tanh(d);
#pragma unroll
                for (int q = 0; q < 4; ++q)
#pragma unroll
                    for (int c = 0; c < 4; ++c) { acc[q * 8 + 2 * c] += s * bflo(vq[q][c]); acc[q * 8 + 2 * c + 1] += s * bfhi(vq[q][c]); } } }
        float y[32]; float s1 = 0.f;
#pragma unroll
        for (int q = 0; q < 4; ++q) { const f32x4 h0 = ((const f32x4*)(H1 + (size_t)m * D))[(q * 64 + lane) * 2], h1 = ((const f32x4*)(H1 + (size_t)m * D))[(q * 64 + lane) * 2 + 1];
#pragma unroll
            for (int c = 0; c < 4; ++c) { y[q * 8 + c] = ALPHA * h0[c] + acc[q * 8 + c]; y[q * 8 + 4 + c] = ALPHA * h1[c] + acc[q * 8 + 4 + c]; } }
#pragma unroll
        for (int i = 0; i < 32; ++i) s1 += y[i];
        const float mean = wave_sum(s1) * (1.f / D); float s2 = 0.f;
#pragma unroll
        for (int i = 0; i < 32; ++i) { y[i] -= mean; s2 += y[i] * y[i]; }
        const float rstd = 1.f / sqrtf(wave_sum(s2) * (1.f / D) + LN_EPS);
#pragma unroll
        for (int q = 0; q < 4; ++q) { const int o4 = (q * 64 + lane) * 2; const f32x4 g0 = ((const f32x4*)A.in[I_LN2G])[o4], g1 = ((const f32x4*)A.in[I_LN2G])[o4 + 1], b0 = ((const f32x4*)A.in[I_LN2B])[o4], b1 = ((const f32x4*)A.in[I_LN2B])[o4 + 1];
            f32x4 r0, r1;
#pragma unroll
            for (int c = 0; c < 4; ++c) { r0[c] = y[q * 8 + c] * rstd * g0[c] + b0[c]; r1[c] = y[q * 8 + 4 + c] * rstd * g1[c] + b1[c]; }
            ((f32x4*)(A.out + (size_t)m * D))[o4] = r0; ((f32x4*)(A.out + (size_t)m * D))[o4 + 1] = r1; } }
}

__global__ void __launch_bounds__(NWAVES * 64, 2) fwd_kernel(Args args) {
    extern __shared__ __attribute__((aligned(16))) unsigned char lds[];
    Frame F;
    F.lds = (LAS unsigned char*)lds;
    F.MISC = (volatile LAS unsigned*)(F.lds + MISC_OFF);
    F.tid = threadIdx.x; F.lane = F.tid & 63; F.wave = __builtin_amdgcn_readfirstlane(F.tid >> 6);
    F.G = gridDim.x; F.bid = blockIdx.x;
    unsigned char* ws = args.ws;
    F.ctl = (gu32*)(ws + WS_CTL);
    for (int u = F.tid; u < (LDS_BYTES - LDSCTL_OFF) / 4; u += NWAVES * 64) ((LAS unsigned*)(F.lds + LDSCTL_OFF))[u] = 0u;
    __syncthreads();
    XcdBarrier bar; bar.bar = (unsigned*)(F.ctl + CW_BAR); bar.x = 0; bar.st = nullptr;
    if (!MK_PER_PHASE) bar = xcd_barrier_post((unsigned*)(F.ctl + CW_BAR), F.MISC + 8);
    const int lo = args.ph_lo, hi = args.ph_hi;
#ifndef PHMASK
#define PHMASK 0xFFFF
#endif
#define IN(k) (((PHMASK >> (k)) & 1) && lo <= (k) && (k) < hi)
#define SEAM(k) do { if (IN(k) && IN((k) + 1)) xcd_barrier(bar); } while (0)
    typedef pg8::bf16_t pb;
    pb* XB = (pb*)(ws + WS_XB); pb* WIN = (pb*)(ws + WS_WIN); pb* U = (pb*)(ws + WS_U); pb* Gt = (pb*)(ws + WS_G); pb* MT = (pb*)(ws + WS_MT);
    pb* PRW = (pb*)(ws + WS_PRW); pb* YS = (pb*)(ws + WS_YS); pb* CAT = (pb*)(ws + WS_CAT); pb* AL = (pb*)(ws + WS_ALORA); pb* LO = (pb*)(ws + WS_LORA);
    pb* WGLU = (pb*)(ws + WS_WGLU); pb* WOUT = (pb*)(ws + WS_WOUT); pb* WQK = (pb*)(ws + WS_WQK); pb* WL = (pb*)(ws + WS_WLORA); pb* H1B = (pb*)(ws + WS_H1B);

    if (IN(0)) { p0_prologue(F, args); } SEAM(0);
    if (IN(1)) {
        pg8::Gemm g{XB, WIN, 2048, 2048, 2048}; pg8::StaticOrder S; S.init(M, INP, F.G, F.bid); pg8::EpiProj E{U, PRW};
        pg8::gemm_phase<pg8::EpiProj, pg8::StaticOrder, true, true>(F.lds + RING_OFF, g, S, E); } SEAM(1);
    if (IN(2)) {
        pg8::Gemm g{U, Gt, 512, 640, 512}; pg8::OneUnit S{F.bid < 64 ? F.bid : -1, F.bid >> 1}; pg8::EpiSa E{U, (const float*)(ws + WS_A32)};
        pg8::gemm_phase<pg8::EpiSa, pg8::OneUnit, false, true>(F.lds + RING_OFF, g, S, E);
        r1_lora_in(F, args); } SEAM(2);
    if (IN(3)) {
        { pg8::Gemm g{U, MT, 640, 640, 640}; pg8::OneUnit S{F.bid < 128 ? (F.bid >> 1) : -1, F.bid}; pg8::EpiY E{YS};
          pg8::gemm_phase<pg8::EpiY, pg8::OneUnit, false, true>(F.lds + RING_OFF, g, S, E); }
        { pg8::Gemm g{AL, WL, 384, 384, 384}; pg8::ListOrder S{F.bid < 128 ? 256 + F.bid : F.bid - 128, F.bid < 128 ? -1 : F.bid, 32}; pg8::EpiStoreBf16 E{LO, 3072};
          pg8::gemm_phase<pg8::EpiStoreBf16, pg8::ListOrder, true, true>(F.lds + RING_OFF, g, S, E); } } SEAM(3);
    if (IN(4)) {
        { const int L = F.bid - 128; pg8::Gemm g{YS, WGLU, 1024, 1024, 1024}; pg8::OneUnit S{L >= 0 ? (L & 31) : -1, L >> 5}; pg8::EpiGLU E{YS, args.in[I_BGLU], CAT};
          pg8::gemm_phase<pg8::EpiGLU, pg8::OneUnit, false, true>(F.lds + RING_OFF, g, S, E); }
        r3_prep(F, args); } SEAM(4);
    if (IN(5)) { r4_scan(F, args); } SEAM(5);
    if (IN(6)) { r5_post(F, args); } SEAM(6);
    if (IN(7)) {
        pg8::Gemm g{CAT, WOUT, 2048, 2048, 2048}; pg8::StaticOrder S; S.init(M, D, F.G, F.bid); pg8::EpiF32 E{(float*)(ws + WS_Z), args.in[I_X], D, ALPHA};
        pg8::gemm_phase<pg8::EpiF32, pg8::StaticOrder, true, true>(F.lds + RING_OFF, g, S, E); } SEAM(7);
    if (IN(8)) { ln1_rows(F, args); } SEAM(8);
    if (IN(9)) {
        pg8::Gemm g{H1B, WQK, 2048, 2048, 2048}; pg8::StaticOrder S; S.init(M, D, F.G, F.bid); pg8::EpiF32 E{(float*)(ws + WS_SC), nullptr, D, 0.f};
        pg8::gemm_phase<pg8::EpiF32, pg8::StaticOrder, true, true>(F.lds + RING_OFF, g, S, E); } SEAM(9);
    if (IN(10)) { topk_phase(F, args); } SEAM(10);
    if (IN(11)) { peer_phase(F, args); }
#undef IN
#undef SEAM
}

extern "C" void kernel_launch(void* const* d_in, const int* in_sizes, int n_in, void* d_out, int out_size, void* d_ws, size_t ws_size, hipStream_t stream) {
    static int grid = 0;
    if (grid == 0) {
        if (n_in != 33 || in_sizes[0] != M * D || out_size != M * D || ws_size < WS_END) { fprintf(stderr, "kernel_launch: unexpected shapes (n_in %d, in0 %d, out %d, ws %zu)\n", n_in, n_in > 0 ? in_sizes[0] : -1, out_size, ws_size); grid = -1; return; }
        int dev = 0, cus = 0, per_cu = 0;
        if (hipGetDevice(&dev) != hipSuccess || hipDeviceGetAttribute(&cus, hipDeviceAttributeMultiprocessorCount, dev) != hipSuccess) { grid = -1; return; }
        if (hipFuncSetAttribute((const void*)fwd_kernel, hipFuncAttributeMaxDynamicSharedMemorySize, LDS_BYTES) != hipSuccess) { fprintf(stderr, "kernel_launch: hipFuncSetAttribute failed\n"); grid = -1; return; }
        if (hipOccupancyMaxActiveBlocksPerMultiprocessor(&per_cu, (const void*)fwd_kernel, NWAVES * 64, LDS_BYTES) != hipSuccess || per_cu < 1) { fprintf(stderr, "kernel_launch: occupancy query says %d blocks per CU\n", per_cu); per_cu = 1; }
        (void)hipGetLastError();
        grid = cus;
        if (grid != 256) fprintf(stderr, "kernel_launch: %d CUs (built for 256)\n", grid);
    }
    if (grid < 0) return;
    (void)hipMemsetAsync((char*)d_ws + WS_CTL, 0, CTL_ZERO_BYTES, stream);
    Args a{};
    for (int i = 0; i < 33; ++i) a.in[i] = (const float*)d_in[i];
    a.out = (float*)d_out; a.ws = (unsigned char*)d_ws;
#if MK_PER_PHASE
    for (int li = 0; li < NPHASE; ++li) { a.ph_lo = li; a.ph_hi = li + 1; a.li = li; hipLaunchKernelGGL(fwd_kernel, dim3(grid), dim3(NWAVES * 64), LDS_BYTES, stream, a); }
#else
    a.ph_lo = 0; a.ph_hi = NPHASE; a.li = 0;
    void* kargs[] = {(void*)&a};
    hipError_t e = hipLaunchCooperativeKernel((const void*)fwd_kernel, dim3(grid), dim3(NWAVES * 64), kargs, LDS_BYTES, stream);
    if (e != hipSuccess) fprintf(stderr, "kernel_launch: cooperative launch failed: %s\n", hipGetErrorString(e));
#endif
}
```

```cpp
#include <hip/hip_runtime.h>
#include <cstdio>
#include <cstdint>
#include <cmath>
namespace pg8 {
#define PG8_LAS __attribute__((address_space(3)))
typedef unsigned short bf16_t;
typedef short bf16x8 __attribute__((ext_vector_type(8)));
typedef float f32x4 __attribute__((ext_vector_type(4)));
typedef float f32x2 __attribute__((ext_vector_type(2)));
typedef unsigned u32x4 __attribute__((ext_vector_type(4)));
constexpr int BM = 256, BK = 64, HALF = 128, HTB = HALF * BK * 2  , STAGE_BYTES = 8 * HTB, NXCD = 8, WGM = 8;

__host__ __device__ __forceinline__ int lds_byte(int r, int c) { const int st = (r >> 4) * 2 + (c >> 5), rr = r & 15, cc = c & 31, ob = rr * 64 + cc * 2; return st * 1024 + (ob ^ (((ob >> 9) & 1) << 5)); }
__host__ __device__ __forceinline__ void stage_rc(int b, int& R, int& C) { const int st = b / 1024, sb = b % 1024, swz = sb ^ (((sb >> 9) & 1) << 5); R = (st >> 1) * 16 + swz / 64; C = (st & 1) * 32 + (swz % 64) / 2; }
__host__ __device__ __forceinline__ int perm32(int rho) { const int n = rho >> 4, i = rho & 15; return 8 * (i >> 2) + 4 * n + (i & 3); }

struct Unit { int pm, pn; };
struct Gemm { const bf16_t* A; const bf16_t* Bt; int K, lda, ldb; };

struct StaticOrder {
    int nM, nN, nwg, G, c;
    __host__ __device__ void init(int M, int N, int G_, int c_) { nM = M / BM; nN = N / BM; nwg = nM * nN; G = G_; c = c_; }
    __host__ __device__ bool next(int i, Unit& u) const {
        const long L = (long)i * G + c; if (L >= nwg) return false;
        int wgid = (int)L; { const int q = nwg / NXCD, r = nwg % NXCD, xcd = wgid % NXCD, off = wgid / NXCD; wgid = (xcd < r ? xcd * (q + 1) : r * (q + 1) + (xcd - r) * q) + off; }
        const int nig = WGM * nN, gid = wgid / nig, fm = gid * WGM, gsz = (nM - fm) < WGM ? (nM - fm) : WGM;
        u.pm = fm + ((wgid % nig) % gsz); u.pn = (wgid % nig) / gsz; return true;
    }
    __device__ __forceinline__ void a_ready(const Unit&) const {}
    __device__ __forceinline__ void done(const Unit&) const {}
};
struct ListOrder {
    int L0, L1, nM;
    __device__ bool next(int i, Unit& u) const { const int L = (i == 0) ? L0 : ((i == 1) ? L1 : -1); if (L < 0) return false; u.pm = L % nM; u.pn = L / nM; return true; }
    __device__ __forceinline__ void a_ready(const Unit&) const {}
    __device__ __forceinline__ void done(const Unit&) const {}
};
struct OneUnit {
    int pm, pn;
    __device__ bool next(int i, Unit& u) const { if (i != 0 || pm < 0) return false; u.pm = pm; u.pn = pn; return true; }
    __device__ __forceinline__ void a_ready(const Unit&) const {}
    __device__ __forceinline__ void done(const Unit&) const {}
};

__device__ __forceinline__ unsigned cvt_pk_bf16(float lo, float hi) { unsigned r; asm volatile("v_cvt_pk_bf16_f32 %0, %1, %2" : "=v"(r) : "v"(lo), "v"(hi)); return r; }
__device__ __forceinline__ float bf_lo(unsigned w) { return __uint_as_float(w << 16); }
__device__ __forceinline__ float bf_hi(unsigned w) { return __uint_as_float(w & 0xffff0000u); }
__device__ __forceinline__ float gelu_tanh(float x) { const float y = 0.7978845608f * (x + 0.044715f * x * x * x); return x * __builtin_amdgcn_rcpf(1.0f + __expf(-2.0f * y)); }
__device__ __forceinline__ float sigmoidf(float x) { return __builtin_amdgcn_rcpf(1.0f + __expf(-x)); }

__device__ __forceinline__ u32x4 pack8(const f32x4 v0, const f32x4 v1) { u32x4 w; w.x = cvt_pk_bf16(v0[0], v0[1]); w.y = cvt_pk_bf16(v0[2], v0[3]); w.z = cvt_pk_bf16(v1[0], v1[1]); w.w = cvt_pk_bf16(v1[2], v1[3]); return w; }

struct EpiStoreBf16 {
    static constexpr bool PERM = true, AFTER_DRAIN = false;
    bf16_t* O; int ldc;
    __device__ __forceinline__ void operator()(const f32x4 (&acc)[2][2][4][2], const Unit& u, int wr, int wc, int fr, int fq) const {
        const int row0 = u.pm * BM + wr * 64 + fr, col0 = u.pn * BM + wc * 32 + 8 * fq;
#pragma unroll
        for (int ai = 0; ai < 2; ++ai)
#pragma unroll
            for (int m = 0; m < 4; ++m) { bf16_t* rowp = O + (size_t)(row0 + ai * HALF + m * 16) * ldc + col0;
#pragma unroll
                for (int bj = 0; bj < 2; ++bj) *(u32x4*)(rowp + bj * HALF) = pack8(acc[ai][bj][m][0], acc[ai][bj][m][1]); }
    }
};
struct EpiProj {
    static constexpr bool PERM = true, AFTER_DRAIN = false;
    bf16_t* U; bf16_t* PRW;
    __device__ __forceinline__ void operator()(const f32x4 (&acc)[2][2][4][2], const Unit& u, int wr, int wc, int fr, int fq) const {
        const int row0 = u.pm * BM + wr * 64 + fr, col0 = u.pn * BM + wc * 32 + 8 * fq;
#pragma unroll
        for (int ai = 0; ai < 2; ++ai)
#pragma unroll
            for (int m = 0; m < 4; ++m) { const int row = row0 + ai * HALF + m * 16;
#pragma unroll
                for (int bj = 0; bj < 2; ++bj) { const int col = col0 + bj * HALF; const u32x4 w = pack8(acc[ai][bj][m][0], acc[ai][bj][m][1]);
                    if (u.pn < 4) { const int g = col >> 4, h0 = col & 15, b = row >> 11, t = row & 2047, c = t >> 5, s = t & 31;
                        *(u32x4*)(U + (size_t)(g * 256 + b * 64 + c) * 640 + s * 16 + h0) = w; }
                    else *(u32x4*)(PRW + (size_t)row * 3584 + (col - 1024)) = w; } }
    }
};
struct EpiY {
    static constexpr bool PERM = true, AFTER_DRAIN = false;
    bf16_t* YS;
    __device__ __forceinline__ void operator()(const f32x4 (&acc)[2][2][4][2], const Unit& u, int wr, int wc, int fr, int fq) const {
        const int g = u.pm, j = u.pn & 1;
#pragma unroll
        for (int ai = 0; ai < 2; ++ai)
#pragma unroll
            for (int m = 0; m < 4; ++m) { const int rowl = ai * HALF + wr * 64 + m * 16 + fr, b = rowl >> 6, c = rowl & 63;
#pragma unroll
                for (int bj = 0; bj < 2; ++bj) { const int n = 256 * j + bj * HALF + wc * 32 + 8 * fq, tl = n >> 4, h0 = n & 15;
                    f32x4 v0 = acc[ai][bj][m][0], v1 = acc[ai][bj][m][1];
#pragma unroll
                    for (int e = 0; e < 4; ++e) { v0[e] = gelu_tanh(v0[e]); v1[e] = gelu_tanh(v1[e]); }
                    *(u32x4*)(YS + (size_t)(b * 2048 + c * 32 + tl) * 1024 + g * 16 + h0) = pack8(v0, v1); }
                asm volatile("" ::: "memory"); }
    }
};
struct EpiGLU {
    static constexpr bool PERM = true, AFTER_DRAIN = false;
    const bf16_t* YS; const float* bglu; bf16_t* CAT;
    __device__ __forceinline__ void operator()(const f32x4 (&acc)[2][2][4][2], const Unit& u, int wr, int wc, int fr, int fq) const {
        const int row0 = u.pm * BM + wr * 64 + fr, col0 = u.pn * BM + wc * 32 + 8 * fq;
#pragma unroll
        for (int bj = 0; bj < 2; ++bj) { const int col = col0 + bj * HALF; const f32x4 b0 = *(const f32x4*)(bglu + col), b1 = *(const f32x4*)(bglu + col + 4);
#pragma unroll
            for (int ai = 0; ai < 2; ++ai)
#pragma unroll
                for (int m = 0; m < 4; ++m) { const int row = row0 + ai * HALF + m * 16; const u32x4 y = *(const u32x4*)(YS + (size_t)row * 1024 + col);
                    const f32x4 a0 = acc[ai][bj][m][0] + b0, a1 = acc[ai][bj][m][1] + b1; f32x4 o0, o1;
                    o0[0] = bf_lo(y.x) * sigmoidf(a0[0]); o0[1] = bf_hi(y.x) * sigmoidf(a0[1]); o0[2] = bf_lo(y.y) * sigmoidf(a0[2]); o0[3] = bf_hi(y.y) * sigmoidf(a0[3]);
                    o1[0] = bf_lo(y.z) * sigmoidf(a1[0]); o1[1] = bf_hi(y.z) * sigmoidf(a1[1]); o1[2] = bf_lo(y.w) * sigmoidf(a1[2]); o1[3] = bf_hi(y.w) * sigmoidf(a1[3]);
                    *(u32x4*)(CAT + (size_t)row * 2048 + col) = pack8(o0, o1); } }
    }
};
struct EpiF32 {
    static constexpr bool PERM = false, AFTER_DRAIN = false;
    float* O; const float* R; int ldc; float alpha;
    __device__ __forceinline__ void operator()(const f32x4 (&acc)[2][2][4][2], const Unit& u, int wr, int wc, int fr, int fq) const {
        const int row0 = u.pm * BM + wr * 64 + fr, col0 = u.pn * BM + wc * 32 + 4 * fq;
#pragma unroll
        for (int ai = 0; ai < 2; ++ai)
#pragma unroll
            for (int m = 0; m < 4; ++m) { const size_t off = (size_t)(row0 + ai * HALF + m * 16) * ldc + col0;
#pragma unroll
                for (int bj = 0; bj < 2; ++bj)
#pragma unroll
                    for (int n = 0; n < 2; ++n) { f32x4 o = acc[ai][bj][m][n]; if (R) { const f32x4 r = *(const f32x4*)(R + off + bj * HALF + n * 16); o = o + r * alpha; }
                        *(f32x4*)(O + off + bj * HALF + n * 16) = o; } }
    }
};
struct EpiSa {
    static constexpr bool PERM = false, AFTER_DRAIN = true;
    bf16_t* U; const float* A32;
    __device__ __forceinline__ void fused(const f32x4 (&acc)[2][2][4][2], const Unit& u, int wr, int wc, int fr, int fq, PG8_LAS unsigned char* lds, int wid, int lane) const {
        const int g = u.pm, gb = g & 1;
        PG8_LAS float* SL = (PG8_LAS float*)lds;
#pragma unroll
        for (int ai = 0; ai < 2; ++ai)
#pragma unroll
            for (int m = 0; m < 4; ++m) { const int rowl = ai * HALF + wr * 64 + m * 16 + fr;
#pragma unroll
                for (int bj = 0; bj < 2; ++bj) if (bj == gb) {
#pragma unroll
                    for (int n = 0; n < 2; ++n) *(PG8_LAS f32x4*)(SL + rowl * 128 + wc * 32 + n * 16 + 4 * fq) = acc[ai][bj][m][n]; } }
        asm volatile("s_waitcnt lgkmcnt(0)" ::: "memory"); __builtin_amdgcn_s_barrier(); asm volatile("" ::: "memory");
        const int tid = wid * 64 + lane;
        if (tid < 256) { const int b = tid >> 6, p = tid & 63; const float ar = A32[(g * 64 + p) * 2], ai_ = A32[(g * 64 + p) * 2 + 1]; float hr = 0.f, hi = 0.f;
            for (int c = 0; c < 64; ++c) { bf16_t* up = U + (size_t)(g * 256 + b * 64 + c) * 640 + 512 + p;
                const unsigned pk = cvt_pk_bf16(hr, hi); up[0] = (bf16_t)(pk & 0xffffu); up[64] = (bf16_t)(pk >> 16);
                const float sr = SL[(b * 64 + c) * 128 + p], si = SL[(b * 64 + c) * 128 + 64 + p];
                const float nr = ar * hr - ai_ * hi + sr, ni = ar * hi + ai_ * hr + si; hr = nr; hi = ni; } }
    }
};

template <class Epi, class Sched, bool ALIGN_EPI = false, bool SP2 = false>
__device__ __forceinline__ void gemm_phase(PG8_LAS unsigned char* lds, const Gemm g, const Sched& S, const Epi& E) {
    const int tid = threadIdx.x, wid = __builtin_amdgcn_readfirstlane(tid >> 6), lane = tid & 63, wr = wid >> 2, wc = wid & 3, fr = lane & 15, fq = lane >> 4;
    const int K = g.K, nt = K / BK;
    unsigned voffA[2], voffB[2];
#pragma unroll
    for (int i = 0; i < 2; ++i) { int R, C; stage_rc(tid * 16 + i * 8192, R, C); const int Rb = Epi::PERM ? ((R & ~31) + perm32(R & 31)) : R;
        voffA[i] = (unsigned)(R * g.lda + C) * 2u; voffB[i] = (unsigned)(Rb * g.ldb + C) * 2u; }
    const size_t kstep = (size_t)(BK * 2);
    const size_t hsA = (size_t)HALF * g.lda * 2, hsB = (size_t)HALF * g.ldb * 2;
    const size_t tsA = 2 * hsA, tsB = 2 * hsB;
    const unsigned ldsw = (unsigned)wid * 1024u;
    const int aoff = lds_byte(wr * 64 + fr, fq * 8), boff = lds_byte(wc * 32 + fr, fq * 8);
#define PG8_SA(b, h) (((b) * 2 + (h)) * HTB)
#define PG8_SB(b, h) ((4 + (b) * 2 + (h)) * HTB)
#define PG8_STAGE(bufoff, gbase, voff) do { _Pragma("unroll") for (int _i = 0; _i < 2; ++_i) \
        __builtin_amdgcn_global_load_lds((const unsigned*)((const char*)(gbase) + (voff)[_i]), (PG8_LAS unsigned*)(lds + (bufoff) + ldsw + _i * 8192), 16, 0, 0); } while (0)
#define PG8_LDA(dst, b, h) do { _Pragma("unroll") for (int m = 0; m < 4; ++m) _Pragma("unroll") for (int k = 0; k < 2; ++k) dst[m][k] = *(const PG8_LAS bf16x8*)(lds + PG8_SA(b, h) + aoff + m * 2048 + k * 1024); } while (0)
#define PG8_LDB(dst, b, h) do { _Pragma("unroll") for (int n = 0; n < 2; ++n) _Pragma("unroll") for (int k = 0; k < 2; ++k) dst[n][k] = *(const PG8_LAS bf16x8*)(lds + PG8_SB(b, h) + boff + n * 2048 + k * 1024); } while (0)
#define PG8_MMA(ai, bj, At, Bt) do { __builtin_amdgcn_s_setprio(1); _Pragma("unroll") for (int m = 0; m < 4; ++m) _Pragma("unroll") for (int n = 0; n < 2; ++n) _Pragma("unroll") for (int k = 0; k < 2; ++k) \
        acc[ai][bj][m][n] = __builtin_amdgcn_mfma_f32_16x16x32_bf16(Bt[n][k], At[m][k], acc[ai][bj][m][n], 0, 0, 0); __builtin_amdgcn_s_setprio(0); } while (0)
#define PG8_WAIT_V(n) asm volatile("s_waitcnt vmcnt(" #n ")" ::: "memory")
#define PG8_WAIT_L(n) asm volatile("s_waitcnt lgkmcnt(" #n ")" ::: "memory")
#define PG8_BAR __builtin_amdgcn_s_barrier()
#define PG8_SCHED __builtin_amdgcn_sched_barrier(0)
    Unit cur, nxt; int ui = 0;
    if (!S.next(0, cur)) return;
    f32x4 acc[2][2][4][2];
#pragma unroll
    for (int a = 0; a < 2; ++a)
#pragma unroll
        for (int b = 0; b < 2; ++b)
#pragma unroll
            for (int m = 0; m < 4; ++m)
#pragma unroll
                for (int n = 0; n < 2; ++n) acc[a][b][m][n] = (f32x4){0.f, 0.f, 0.f, 0.f};
    bf16x8 At[4][2], B0[2][2], B1[2][2];
    const char* cA = (const char*)g.A + (size_t)cur.pm * tsA; const char* cB = (const char*)g.Bt + (size_t)cur.pn * tsB;
    S.a_ready(cur);
    if constexpr (SP2) {
        PG8_STAGE(PG8_SB(0, 0), cB, voffB); PG8_STAGE(PG8_SB(0, 1), cB + hsB, voffB); PG8_STAGE(PG8_SA(0, 0), cA, voffA); PG8_STAGE(PG8_SA(0, 1), cA + hsA, voffA);
        if (wr == 1) PG8_BAR;
        PG8_WAIT_V(2); PG8_BAR;
        PG8_STAGE(PG8_SB(1, 0), cB + kstep, voffB); PG8_STAGE(PG8_SA(1, 0), cA + kstep, voffA); PG8_STAGE(PG8_SB(1, 1), cB + hsB + kstep, voffB);
        PG8_WAIT_V(6); PG8_BAR;
    } else {
        PG8_STAGE(PG8_SB(0, 0), cB, voffB); PG8_STAGE(PG8_SA(0, 0), cA, voffA); PG8_STAGE(PG8_SB(0, 1), cB + hsB, voffB); PG8_STAGE(PG8_SA(0, 1), cA + hsA, voffA);
        if (wr == 1) PG8_BAR;
        PG8_WAIT_V(4); PG8_BAR;
        PG8_STAGE(PG8_SB(1, 0), cB + kstep, voffB); PG8_STAGE(PG8_SA(1, 0), cA + kstep, voffA); PG8_STAGE(PG8_SB(1, 1), cB + hsB + kstep, voffB);
        PG8_WAIT_V(6); PG8_BAR;
    }
    for (;;) {
        const bool has_next = S.next(ui + 1, nxt);
        const char* nA = has_next ? (const char*)g.A + (size_t)nxt.pm * tsA : cA; const char* nB = has_next ? (const char*)g.Bt + (size_t)nxt.pn * tsB : cB;
#pragma nounroll
        for (int t = 0; t < nt; t += 2) {
            const bool last = (t == nt - 2);
            const char* a1 = cA + (size_t)(t + 1) * kstep;
            const char* a2 = last ? nA : cA + (size_t)(t + 2) * kstep; const char* b2 = last ? nB : cB + (size_t)(t + 2) * kstep;
            const char* a3 = a2 + kstep; const char* b3 = b2 + kstep;
            if (last && has_next) S.a_ready(nxt);
            if constexpr (SP2) {
            PG8_LDB(B0, 0, 0); PG8_LDB(B1, 0, 1); PG8_SCHED; PG8_LDA(At, 0, 0); PG8_STAGE(PG8_SA(1, 1), a1 + hsA, voffA);
            PG8_WAIT_V(8); PG8_WAIT_L(0); PG8_BAR; PG8_MMA(0, 0, At, B0); PG8_MMA(0, 1, At, B1); PG8_BAR; PG8_SCHED;
            PG8_LDA(At, 0, 1); PG8_STAGE(PG8_SB(0, 0), b2, voffB); PG8_STAGE(PG8_SB(0, 1), b2 + hsB, voffB); PG8_STAGE(PG8_SA(0, 0), a2, voffA);
            PG8_WAIT_V(8); PG8_WAIT_L(0); PG8_BAR; PG8_MMA(1, 0, At, B0); PG8_MMA(1, 1, At, B1); PG8_BAR; PG8_SCHED;
            PG8_LDB(B0, 1, 0); PG8_LDB(B1, 1, 1); PG8_SCHED; PG8_LDA(At, 1, 0); PG8_STAGE(PG8_SA(0, 1), a2 + hsA, voffA);
            PG8_WAIT_V(8); PG8_WAIT_L(0); PG8_BAR; PG8_MMA(0, 0, At, B0); PG8_MMA(0, 1, At, B1); PG8_BAR; PG8_SCHED;
            PG8_LDA(At, 1, 1); PG8_STAGE(PG8_SB(1, 0), b3, voffB); PG8_STAGE(PG8_SB(1, 1), b3 + hsB, voffB); PG8_STAGE(PG8_SA(1, 0), a3, voffA);
            PG8_WAIT_V(8); PG8_WAIT_L(0); PG8_BAR; PG8_MMA(1, 0, At, B0); PG8_MMA(1, 1, At, B1); PG8_BAR; PG8_SCHED;
            } else {
            PG8_LDB(B0, 0, 0); PG8_SCHED; PG8_LDA(At, 0, 0); PG8_STAGE(PG8_SA(1, 1), a1 + hsA, voffA);
            PG8_WAIT_L(8); PG8_BAR; PG8_WAIT_L(0); PG8_MMA(0, 0, At, B0); PG8_BAR; PG8_SCHED;
            PG8_LDB(B1, 0, 1); PG8_STAGE(PG8_SB(0, 0), b2, voffB);
            PG8_BAR; PG8_WAIT_L(0); PG8_MMA(0, 1, At, B1); PG8_BAR;
            PG8_LDA(At, 0, 1); PG8_STAGE(PG8_SA(0, 0), a2, voffA);
            PG8_BAR; PG8_WAIT_L(0); PG8_MMA(1, 0, At, B0); PG8_BAR; PG8_SCHED;
            PG8_STAGE(PG8_SB(0, 1), b2 + hsB, voffB);
            PG8_WAIT_V(6); PG8_BAR; PG8_MMA(1, 1, At, B1); PG8_BAR;
            PG8_LDB(B0, 1, 0); PG8_SCHED; PG8_LDA(At, 1, 0); PG8_STAGE(PG8_SA(0, 1), a2 + hsA, voffA);
            PG8_WAIT_L(8); PG8_BAR; PG8_WAIT_L(0); PG8_MMA(0, 0, At, B0); PG8_BAR; PG8_SCHED;
            PG8_LDB(B1, 1, 1); PG8_STAGE(PG8_SB(1, 0), b3, voffB);
            PG8_BAR; PG8_WAIT_L(0); PG8_MMA(0, 1, At, B1); PG8_BAR;
            PG8_LDA(At, 1, 1); PG8_STAGE(PG8_SA(1, 0), a3, voffA);
            PG8_BAR; PG8_WAIT_L(0); PG8_MMA(1, 0, At, B0); PG8_BAR; PG8_SCHED;
            PG8_STAGE(PG8_SB(1, 1), b3 + hsB, voffB);
            PG8_WAIT_V(6); PG8_BAR; PG8_MMA(1, 1, At, B1); PG8_BAR;
            }
        }
        if constexpr (ALIGN_EPI) { if (wr == 0) PG8_BAR; }
        if constexpr (!Epi::AFTER_DRAIN) { E(acc, cur, wr, wc, fr, fq); S.done(cur); }
        if (!has_next) break;
#pragma unroll
        for (int a = 0; a < 2; ++a)
#pragma unroll
            for (int b = 0; b < 2; ++b)
#pragma unroll
                for (int m = 0; m < 4; ++m)
#pragma unroll
                    for (int n = 0; n < 2; ++n) acc[a][b][m][n] = (f32x4){0.f, 0.f, 0.f, 0.f};
        cur = nxt; cA = nA; cB = nB; ++ui;
        if constexpr (ALIGN_EPI) { if (wr == 1) PG8_BAR; }
    }
    PG8_WAIT_V(0);
    if constexpr (!ALIGN_EPI) { if (wr == 0) PG8_BAR; }
    PG8_BAR;
    if constexpr (Epi::AFTER_DRAIN) { E.fused(acc, cur, wr, wc, fr, fq, lds, wid, lane); S.done(cur); }
#undef PG8_SA
#undef PG8_SB
#undef PG8_STAGE
#undef PG8_LDA
#undef PG8_LDB
#undef PG8_MMA
#undef PG8_WAIT_V
#undef PG8_WAIT_L
#undef PG8_BAR
#undef PG8_SCHED
}
}

constexpr int NWAVES = 8;
#ifndef MK_PER_PHASE
#define MK_PER_PHASE 0
#endif
constexpr int NPHASE = 12;
constexpr int M = 8192, D = 2048, SEQ = 2048;
constexpr int INC = 4384, INP = 4608;
constexpr float ALPHA = 1.189207115f;
constexpr float LN_EPS = 1e-5f, GN_EPS = 64e-5f;
constexpr size_t MiB = 1u << 20;
constexpr size_t WS_CTL = 0, CTL_ZERO_BYTES = 1 * MiB;
constexpr size_t WS_WGLU = 1 * MiB, WS_WOUT = 3 * MiB, WS_WQK = 11 * MiB, WS_WLORA = 19 * MiB, WS_IDX = 22 * MiB, WS_GATE = 26 * MiB, WS_A32 = 30 * MiB;
constexpr size_t WS_UTAB = 32 * MiB, WS_VTAB = 96 * MiB;
constexpr size_t WS_XB = 160 * MiB, WS_WIN = 192 * MiB, WS_U = 210 * MiB, WS_G = 230 * MiB, WS_MT = 238 * MiB;
constexpr size_t WS_SCAN = 160 * MiB;
constexpr size_t WS_PRW = 286 * MiB, WS_YS = 342 * MiB, WS_CAT = 358 * MiB, WS_ALORA = 390 * MiB, WS_LORA = 396 * MiB, WS_ORW = 444 * MiB;
constexpr size_t WS_Z = 160 * MiB, WS_H1 = 224 * MiB, WS_H1B = 288 * MiB, WS_SC = 390 * MiB;
constexpr size_t WS_END = 476 * MiB;
constexpr int SCAN_REC = 896;
constexpr int CW_BAR = 4096;
constexpr int RING_OFF = 0, RING_BYTES = 131072;
constexpr int LDSCTL_OFF = RING_BYTES, MISC_OFF = LDSCTL_OFF + 320;
constexpr int LDS_BYTES = 147456;

#define GAS __attribute__((address_space(1)))
#define LAS __attribute__((address_space(3)))
typedef unsigned short bf16;
typedef unsigned v4u __attribute__((ext_vector_type(4)));
typedef float f32x4 __attribute__((ext_vector_type(4)));
typedef float f32x2 __attribute__((ext_vector_type(2)));
typedef _Float16 h16x2 __attribute__((ext_vector_type(2)));
typedef __bf16 bf16x2v __attribute__((ext_vector_type(2)));
typedef GAS unsigned gu32;
#define RLX_AGENT __ATOMIC_RELAXED, __HIP_MEMORY_SCOPE_AGENT
#define LDS_WAIT() asm volatile("s_waitcnt lgkmcnt(0)" ::: "memory")
#define VM_WAIT() asm volatile("s_waitcnt vmcnt(0)" ::: "memory")
__device__ __forceinline__ unsigned f2bf(float f) { unsigned u = __builtin_bit_cast(unsigned, f); return (u + 0x7fffu + ((u >> 16) & 1u)) >> 16; }
__device__ __forceinline__ unsigned pk2(float lo, float hi) { return f2bf(lo) | (f2bf(hi) << 16); }
__device__ __forceinline__ float bflo(unsigned w) { return __uint_as_float(w << 16); }
__device__ __forceinline__ float bfhi(unsigned w) { return __uint_as_float(w & 0xffff0000u); }
__device__ __forceinline__ float bf1(bf16 h) { return __uint_as_float((unsigned)h << 16); }
__device__ __forceinline__ unsigned pkh(float lo, float hi) { h16x2 v; v.x = (_Float16)lo; v.y = (_Float16)hi; return __builtin_bit_cast(unsigned, v); }
__device__ __forceinline__ float hlo(unsigned w) { return (float)__builtin_bit_cast(h16x2, w).x; }
__device__ __forceinline__ float hhi(unsigned w) { return (float)__builtin_bit_cast(h16x2, w).y; }
__device__ __forceinline__ float wave_sum(float v) {
#pragma unroll
    for (int o = 1; o < 64; o <<= 1) v += __shfl_xor(v, o);
    return v;
}
using pg8::gelu_tanh; using pg8::sigmoidf; using pg8::pack8;

#define XB_TMO      128
#define XB_XCNT(j)  (256  + 64 * (j))
#define XB_XSUB(j)  (1280 + 64 * (j))
#define XB_XGEN(j)  (2304 + 64 * (j))
#define XB_TOP      3328
#define XB_TOPGEN   3392
#define XCD_BAR_WORDS 3456
#define XB_SPIN_CAP (1u << 18)

__device__ __forceinline__ unsigned xb_ld(unsigned* p)              { return __hip_atomic_load(p, __ATOMIC_RELAXED, __HIP_MEMORY_SCOPE_AGENT); }
__device__ __forceinline__ unsigned xb_add(unsigned* p, unsigned v) { return __hip_atomic_fetch_add(p, v, __ATOMIC_RELAXED, __HIP_MEMORY_SCOPE_AGENT); }
__device__ __forceinline__ unsigned xb_xcc_id() { return (unsigned)__builtin_amdgcn_s_getreg((3 << 11) | 20) & 0xFu; }
#define XB_SPIN(cond, bar) do { unsigned _sp = 0; while (cond) { __builtin_amdgcn_s_sleep(1); \
    if ((++_sp & 255u) == 0u) { if (xb_ld(&(bar)[XB_TMO])) break; if (_sp > XB_SPIN_CAP) { atomicAdd(&(bar)[XB_TMO], 1u); break; } } } } while (0)

struct XcdBarrier {
    unsigned* bar; unsigned x;
    volatile LAS unsigned* st;
};

__device__ __forceinline__ XcdBarrier xcd_barrier_post(unsigned* bar, volatile LAS unsigned* st) {
    XcdBarrier b; b.bar = bar; b.x = xb_xcc_id(); b.st = st;
    if (threadIdx.x == 0) (void)xb_add(&bar[XB_XCNT(b.x)], 1u);
    return b;
}
__device__ __forceinline__ void xcd_barrier_complete(unsigned* bar, unsigned x, unsigned& nloc, unsigned& nx) {
    const unsigned G = gridDim.x * gridDim.y * gridDim.z;
    unsigned sum, cnt, mine, sp = 0u;
    for (;;) {
        sum = 0u; cnt = 0u; mine = 0u;
#pragma unroll
        for (unsigned j = 0; j < 16; ++j) { const unsigned c = xb_ld(&bar[XB_XCNT(j)]); sum += c; cnt += (c > 0u) ? 1u : 0u; mine = (j == x) ? c : mine; }
        if (sum == G) break;
        __builtin_amdgcn_s_sleep(1);
        if ((++sp & 255u) == 0u) { if (xb_ld(&bar[XB_TMO])) break; if (sp > XB_SPIN_CAP) { atomicAdd(&bar[XB_TMO], 1u); break; } }
    }
    nloc = mine > 0u ? mine : 1u; nx = cnt > 0u ? cnt : 1u;
}

__device__ __forceinline__ void xcd_barrier(const XcdBarrier& b) {
    asm volatile("s_waitcnt vmcnt(0)" ::: "memory");
    __syncthreads();
    if (threadIdx.x == 0) {
        unsigned* bar = b.bar;
        __builtin_amdgcn_s_waitcnt(0);
        unsigned nloc = b.st[0], nx = b.st[1];
        if (nloc == 0u) { xcd_barrier_complete(bar, b.x, nloc, nx); b.st[0] = nloc; b.st[1] = nx; }
        const unsigned old = xb_add(&bar[XB_XSUB(b.x)], 1u);
        const unsigned gen = old / nloc;
        if (old + 1u == (gen + 1u) * nloc) {
            __builtin_amdgcn_fence(__ATOMIC_RELEASE, "agent");
            asm volatile("s_waitcnt vmcnt(0)" ::: "memory");
            const unsigned og = xb_add(&bar[XB_TOP], 1u);
            const unsigned tg = og / nx;
            if (og + 1u == (tg + 1u) * nx) xb_add(&bar[XB_TOPGEN], 1u);
            else XB_SPIN(xb_ld(&bar[XB_TOPGEN]) == tg, bar);
            __builtin_amdgcn_fence(__ATOMIC_ACQUIRE, "agent");
            xb_add(&bar[XB_XGEN(b.x)], 1u);
            asm volatile("s_waitcnt vmcnt(0)" ::: "memory");
        } else {
            XB_SPIN(xb_ld(&bar[XB_XGEN(b.x)]) == gen, bar);
            __builtin_amdgcn_fence(__ATOMIC_ACQUIRE, "agent");
            asm volatile("s_waitcnt vmcnt(0)" ::: "memory");
        }
    }
    __syncthreads();
}

struct Args { const float* in[33]; float* out; unsigned char* ws; int ph_lo, ph_hi, li, pad; };
struct Frame {
    LAS unsigned char* lds;
    volatile LAS unsigned* MISC;
    gu32* ctl;
    int tid, lane, wave, bid, G;
};
enum { I_X = 0, I_WIN, I_LAMRE, I_LAMIM, I_LOGSTEP, I_BRE, I_BIM, I_CRE, I_CIM, I_SD, I_WGLU, I_BGLU, I_MU, I_W0, I_WUP, I_A0, I_AUP, I_GUP, I_KK, I_KA, I_RK, I_GNG, I_GNB,
       I_WOUT, I_LN1G, I_LN1B, I_WQ, I_KEYS1, I_KEYS2, I_PU, I_PV, I_LN2G, I_LN2B };

__device__ __forceinline__ void p0_transpose_item(const float* W, int K, int N, bf16* WT, int row_off, LAS float* scr, int item, int lane) {
    const int nblk = N / 32, kb = item / nblk, nb = item % nblk, k0 = 64 * kb, n0 = 32 * nb;
#pragma unroll 8
    for (int i = 0; i < 32; ++i) { const int kk = 2 * i + (lane >> 5); scr[kk * 33 + (lane & 31)] = W[(size_t)(k0 + kk) * N + n0 + (lane & 31)]; }
    LDS_WAIT(); asm volatile("" ::: "memory");
    const int c = lane & 7;
#pragma unroll
    for (int j = 0; j < 4; ++j) { const int n = (lane >> 3) + 8 * j; const LAS float* s = scr + (8 * c) * 33 + n;
        v4u o; o.x = pk2(s[0 * 33], s[1 * 33]); o.y = pk2(s[2 * 33], s[3 * 33]); o.z = pk2(s[4 * 33], s[5 * 33]); o.w = pk2(s[6 * 33], s[7 * 33]);
        *(GAS v4u*)(WT + (size_t)(row_off + n0 + n) * K + k0 + 8 * c) = o; }
    LDS_WAIT(); asm volatile("" ::: "memory");
}
__device__ __forceinline__ void cvt_stream(const float* src, bf16* dst, size_t n8, size_t gtid, size_t nt) {
    for (size_t i = gtid; i < n8; i += nt) { const f32x4 a = ((const f32x4*)src)[2 * i], b = ((const f32x4*)src)[2 * i + 1]; ((v4u*)dst)[i] = pack8(a, b); }
}

__device__ __forceinline__ void p0_prologue(Frame& F, const Args& A) {
    unsigned char* ws = A.ws;
    const size_t gtid = (size_t)F.bid * 512 + F.tid, NT = (size_t)F.G * 512;
    const int gw = F.bid * NWAVES + F.wave, NGW = F.G * NWAVES;
    if (F.bid < 64) {
        const int g = F.bid, tid = F.tid;
        LAS f32x2* AP = (LAS f32x2*)(F.lds);
        LAS f32x2* BB = (LAS f32x2*)(F.lds + 16896);
        LAS float* KJ = (LAS float*)(F.lds + 16896 + 8192);
        const float* lam_re = A.in[I_LAMRE] + g * 64; const float* lam_im = A.in[I_LAMIM] + g * 64;
        const float step = __expf(A.in[I_LOGSTEP][g]);
        for (int idx = tid; idx < 33 * 64; idx += 512) { const int j = idx >> 6, p = idx & 63; const float lr = lam_re[p], li = lam_im[p];
            const float mag = __expf(lr * step * (float)j); float rev = (li * step * 0.15915494309f) * (float)j; rev -= floorf(rev);
            AP[idx] = (f32x2){mag * __builtin_amdgcn_cosf(rev), mag * __builtin_amdgcn_sinf(rev)}; }
        LDS_WAIT(); __syncthreads();
        for (int idx = tid; idx < 64 * 16; idx += 512) { const int p = idx >> 4, h = idx & 15; const float lr = lam_re[p], li = lam_im[p]; const f32x2 a = AP[64 + p];
            const float den = lr * lr + li * li, fr = ((a.x - 1.f) * lr + a.y * li) / den, fi = (a.y * lr - (a.x - 1.f) * li) / den;
            const float br = A.in[I_BRE][(g * 64 + p) * 16 + h], bi = A.in[I_BIM][(g * 64 + p) * 16 + h];
            BB[idx] = (f32x2){fr * br - fi * bi, fr * bi + fi * br}; }
        if (tid < 64) { const f32x2 a = AP[32 * 64 + tid]; float* a32 = (float*)(ws + WS_A32); a32[(g * 64 + tid) * 2] = a.x; a32[(g * 64 + tid) * 2 + 1] = a.y; }
        LDS_WAIT(); __syncthreads();
        const float* cre = A.in[I_CRE] + (size_t)g * 16 * 64; const float* cim = A.in[I_CIM] + (size_t)g * 16 * 64;
        for (int idx = tid; idx < 32 * 256; idx += 512) { const int j = idx >> 8, h = (idx >> 4) & 15, hp = idx & 15; float s = 0.f;
            for (int p = 0; p < 64; ++p) { const f32x2 a = AP[j * 64 + p], bb = BB[p * 16 + hp]; const float wr = a.x * bb.x - a.y * bb.y, wi = a.x * bb.y + a.y * bb.x;
                s += cre[h * 64 + p] * wr - cim[h * 64 + p] * wi; }
            KJ[idx] = s; }
        LDS_WAIT(); __syncthreads();
        bf16* Gt = (bf16*)(ws + WS_G); bf16* MT = (bf16*)(ws + WS_MT);
        for (int it = tid; it < 8192; it += 512) { const int row = it >> 6, cb = (it & 63) * 8, s = cb >> 4, h0 = cb & 15, p = row & 63, im = row >> 6; const f32x2 a = AP[(31 - s) * 64 + p];
            float v[8];
#pragma unroll
            for (int e = 0; e < 8; ++e) { const f32x2 bb = BB[p * 16 + h0 + e]; v[e] = im ? (a.x * bb.y + a.y * bb.x) : (a.x * bb.x - a.y * bb.y); }
            v4u o; o.x = pk2(v[0], v[1]); o.y = pk2(v[2], v[3]); o.z = pk2(v[4], v[5]); o.w = pk2(v[6], v[7]);
            *(v4u*)(Gt + (size_t)(g * 128 + row) * 512 + cb) = o; }
        const float* dsk = A.in[I_SD] + g * 16;
        for (int it = tid; it < 40960; it += 512) { const int n = it / 80, kb = (it % 80) * 8, t = n >> 4, h = n & 15; float v[8];
            if (kb < 512) { const int s = kb >> 4, h0 = kb & 15;
#pragma unroll
                for (int e = 0; e < 8; ++e) { const int hp = h0 + e; float x = 0.f; if (s <= t) { x = KJ[(t - s) * 256 + h * 16 + hp]; if (s == t && hp == h) x += dsk[h]; } v[e] = x; } }
            else { const int p0 = (kb < 576) ? (kb - 512) : (kb - 576);
#pragma unroll
                for (int e = 0; e < 8; ++e) { const int p = p0 + e; const f32x2 a = AP[(t + 1) * 64 + p]; const float cr = cre[h * 64 + p], ci = cim[h * 64 + p];
                    v[e] = (kb < 576) ? (cr * a.x - ci * a.y) : -(cr * a.y + ci * a.x); } }
            v4u o; o.x = pk2(v[0], v[1]); o.y = pk2(v[2], v[3]); o.z = pk2(v[4], v[5]); o.w = pk2(v[6], v[7]);
            *(v4u*)(MT + (size_t)(g * 512 + n) * 640 + kb) = o; }
        LDS_WAIT(); __syncthreads();
    }
    cvt_stream(A.in[I_X], (bf16*)(ws + WS_XB), (size_t)M * D / 8, gtid, NT);
    cvt_stream(A.in[I_PU], (bf16*)(ws + WS_UTAB), (size_t)16384 * 2048 / 8, gtid, NT);
    cvt_stream(A.in[I_PV], (bf16*)(ws + WS_VTAB), (size_t)16384 * 2048 / 8, gtid, NT);
    {
        LAS float* scr = (LAS float*)(F.lds + RING_OFF + F.wave * 16384);
        constexpr int I_IN = (2048 / 64) * (INC / 32), I_GL = (1024 / 64) * (1024 / 32), I_OU = (2048 / 64) * (2048 / 32);
        for (int it = gw; it < I_IN + I_GL + I_OU; it += NGW) { int r = it;
            if (r < I_IN) { p0_transpose_item(A.in[I_WIN], 2048, INC, (bf16*)(ws + WS_WIN), 0, scr, r, F.lane); continue; } r -= I_IN;
            if (r < I_GL) { p0_transpose_item(A.in[I_WGLU], 1024, 1024, (bf16*)(ws + WS_WGLU), 0, scr, r, F.lane); continue; } r -= I_GL;
            p0_transpose_item(A.in[I_WOUT], 2048, 2048, (bf16*)(ws + WS_WOUT), 0, scr, r, F.lane); }
        v4u* z = (v4u*)((bf16*)(ws + WS_WIN) + (size_t)INC * 2048);
        for (size_t i = gtid; i < (size_t)(INP - INC) * 2048 / 8; i += NT) z[i] = (v4u){0u, 0u, 0u, 0u};
    }
    {
        bf16* WL = (bf16*)(ws + WS_WLORA);
        for (size_t i = gtid; i < (size_t)3072 * 384; i += NT) { const int n = (int)(i / 384), k = (int)(i % 384); float v = 0.f;
            if (n < 1024) { if (k < 64) v = A.in[I_WUP][k * 1024 + n]; }
            else if (n < 2048) { if (k >= 64 && k < 128) v = A.in[I_AUP][(k - 64) * 1024 + (n - 1024)]; }
            else { if (k >= 128 && k < 288) v = A.in[I_GUP][(k - 128) * 1024 + (n - 2048)]; }
            WL[i] = (bf16)f2bf(v); }
    }
    __syncthreads();
    {
        LAS float* Ks = (LAS float*)(F.lds); LAS float* Ws = (LAS float*)(F.lds + 128 * 129 * 4);
        bf16* WQK = (bf16*)(ws + WS_WQK); const int tid = F.tid;
        for (int unit = F.bid; unit < 512; unit += F.G) { const int hj = unit >> 5, dblk = unit & 31, h = hj >> 1, j = hj & 1;
            const float* keys = (j ? A.in[I_KEYS2] : A.in[I_KEYS1]) + (size_t)h * 128 * 128;
            for (int idx = tid; idx < 16384; idx += 512) Ks[(idx >> 7) * 129 + (idx & 127)] = keys[idx];
            for (int idx = tid; idx < 8192; idx += 512) Ws[(idx >> 7) * 129 + (idx & 127)] = A.in[I_WQ][(size_t)(dblk * 64 + (idx >> 7)) * 2048 + hj * 128 + (idx & 127)];
            LDS_WAIT(); __syncthreads();
            const int key = tid & 127, dq = tid >> 7; float acc[16];
#pragma unroll
            for (int i = 0; i < 16; ++i) acc[i] = 0.f;
            for (int c = 0; c < 128; ++c) { const float a = Ks[key * 129 + c];
#pragma unroll
                for (int i = 0; i < 16; ++i) acc[i] += a * Ws[(dq * 16 + i) * 129 + c]; }
            v4u o0, o1; o0.x = pk2(acc[0], acc[1]); o0.y = pk2(acc[2], acc[3]); o0.z = pk2(acc[4], acc[5]); o0.w = pk2(acc[6], acc[7]);
            o1.x = pk2(acc[8], acc[9]); o1.y = pk2(acc[10], acc[11]); o1.z = pk2(acc[12], acc[13]); o1.w = pk2(acc[14], acc[15]);
            v4u* dst = (v4u*)(WQK + (size_t)(hj * 128 + key) * 2048 + dblk * 64 + dq * 16); dst[0] = o0; dst[1] = o1;
            LDS_WAIT(); __syncthreads(); }
    }
}

__device__ __forceinline__ void r1_lora_in(Frame& F, const Args& A) {
    const bf16* PRW = (const bf16*)(A.ws + WS_PRW); bf16* AL = (bf16*)(A.ws + WS_ALORA); const float* mu = A.in[I_MU];
    const int gw = F.bid * NWAVES + F.wave, NGW = F.G * NWAVES;
    for (int m = gw; m < M; m += NGW) { const int t = m & (SEQ - 1);
#pragma unroll
        for (int q = 0; q < 6; ++q) { const int idx = q * 64 + F.lane; float val = 0.f;
            if (idx < 288) { const int col = 3072 + idx; const float cur = bf1(PRW[(size_t)m * 3584 + col]); const float prev = (t > 0) ? bf1(PRW[(size_t)(m - 1) * 3584 + col]) : 0.f;
                const float s = cur + mu[col] * (prev - cur);
                val = (idx < 64) ? (1.f - 2.f / (1.f + __expf(2.f * s))) : ((idx < 128) ? s : sigmoidf(s)); }
            AL[(size_t)m * 384 + idx] = (bf16)f2bf(val); } }
}

__device__ __forceinline__ void r3_prep(Frame& F, const Args& A) {
    const bf16* PRW = (const bf16*)(A.ws + WS_PRW); const bf16* LO = (const bf16*)(A.ws + WS_LORA); unsigned char* SC = A.ws + WS_SCAN;
    const float* mu = A.in[I_MU]; const int lane = F.lane, head = lane >> 2, j0 = (lane & 3) * 16, ch = lane * 16;
    const int gw = F.bid * NWAVES + F.wave, NGW = F.G * NWAVES;
    for (int m = gw; m < M; m += NGW) { const int t = m & (SEQ - 1), b = m >> 11;
        float rs[16], ks[16], vs[16];
#pragma unroll
        for (int part = 0; part < 3; ++part) { const int col = part * 1024 + ch; const v4u c0 = *(const v4u*)(PRW + (size_t)m * 3584 + col), c1 = *(const v4u*)(PRW + (size_t)m * 3584 + col + 8);
            v4u p0 = (v4u){0u, 0u, 0u, 0u}, p1 = p0; if (t > 0) { p0 = *(const v4u*)(PRW + (size_t)(m - 1) * 3584 + col); p1 = *(const v4u*)(PRW + (size_t)(m - 1) * 3584 + col + 8); }
            float cu[16], pr[16];
#pragma unroll
            for (int e = 0; e < 4; ++e) { cu[2 * e] = bflo(c0[e]); cu[2 * e + 1] = bfhi(c0[e]); cu[8 + 2 * e] = bflo(c1[e]); cu[8 + 2 * e + 1] = bfhi(c1[e]);
                pr[2 * e] = bflo(p0[e]); pr[2 * e + 1] = bfhi(p0[e]); pr[8 + 2 * e] = bflo(p1[e]); pr[8 + 2 * e + 1] = bfhi(p1[e]); }
#pragma unroll
            for (int e = 0; e < 16; ++e) { const float s = cu[e] + mu[col + e] * (pr[e] - cu[e]); if (part == 0) rs[e] = s; else if (part == 1) ks[e] = s; else vs[e] = s; } }
        const v4u wl0 = *(const v4u*)(LO + (size_t)m * 3072 + ch), wl1 = *(const v4u*)(LO + (size_t)m * 3072 + ch + 8);
        const v4u al0 = *(const v4u*)(LO + (size_t)m * 3072 + 1024 + ch), al1 = *(const v4u*)(LO + (size_t)m * 3072 + 1024 + ch + 8);
        float wl[16], al[16];
#pragma unroll
        for (int e = 0; e < 4; ++e) { wl[2 * e] = bflo(wl0[e]); wl[2 * e + 1] = bfhi(wl0[e]); wl[8 + 2 * e] = bflo(wl1[e]); wl[8 + 2 * e + 1] = bfhi(wl1[e]);
            al[2 * e] = bflo(al0[e]); al[2 * e + 1] = bfhi(al0[e]); al[8 + 2 * e] = bflo(al1[e]); al[8 + 2 * e + 1] = bfhi(al1[e]); }
        float dec[16], kp[16], kk[16], aa[16]; float n2 = 0.f;
#pragma unroll
        for (int e = 0; e < 16; ++e) { const float x = A.in[I_W0][ch + e] + wl[e]; const float y = -x; const float sp = fmaxf(y, 0.f) + __logf(1.f + __expf(-fabsf(y)));
            const float w = -sp - 0.5f; dec[e] = __expf(-__expf(w));
            const float a = sigmoidf(A.in[I_A0][ch + e] + al[e]); aa[e] = a;
            kk[e] = ks[e] * A.in[I_KK][ch + e]; n2 += kk[e] * kk[e];
            kp[e] = ks[e] * (1.f + (a - 1.f) * A.in[I_KA][ch + e]); }
        n2 += __shfl_xor(n2, 1); n2 += __shfl_xor(n2, 2);
        const float inv = 1.f / fmaxf(sqrtf(n2), 1e-12f);
        unsigned char* rec = SC + ((size_t)(b * 16 + head) * SEQ + t) * SCAN_REC;
#pragma unroll
        for (int q = 0; q < 4; ++q) { unsigned char* pj = rec + ((lane & 3) * 4 + q) * 48;
            *(f32x4*)pj = (f32x4){dec[4 * q], dec[4 * q + 1], dec[4 * q + 2], dec[4 * q + 3]};
            v4u o; o.x = pkh(rs[4 * q], rs[4 * q + 1]); o.y = pkh(rs[4 * q + 2], rs[4 * q + 3]); o.z = pkh(kp[4 * q], kp[4 * q + 1]); o.w = pkh(kp[4 * q + 2], kp[4 * q + 3]); *(v4u*)(pj + 16) = o;
            const float k0 = kk[4 * q] * inv, k1 = kk[4 * q + 1] * inv, k2 = kk[4 * q + 2] * inv, k3 = kk[4 * q + 3] * inv;
            v4u o2; o2.x = pkh(k0, k1); o2.y = pkh(k2, k3); o2.z = pkh(k0 * aa[4 * q], k1 * aa[4 * q + 1]); o2.w = pkh(k2 * aa[4 * q + 2], k3 * aa[4 * q + 3]); *(v4u*)(pj + 32) = o2; }
        v4u v0, v1; v0.x = pkh(vs[0], vs[1]); v0.y = pkh(vs[2], vs[3]); v0.z = pkh(vs[4], vs[5]); v0.w = pkh(vs[6], vs[7]);
        v1.x = pkh(vs[8], vs[9]); v1.y = pkh(vs[10], vs[11]); v1.z = pkh(vs[12], vs[13]); v1.w = pkh(vs[14], vs[15]);
        *(v4u*)(rec + 768 + j0 * 2) = v0; *(v4u*)(rec + 768 + j0 * 2 + 16) = v1; }
}

__device__ __forceinline__ float dpp_f(float v, const int ctrl_sel) {
    const int iv = __builtin_bit_cast(int, v); int r;
    switch (ctrl_sel) { case 0: r = __builtin_amdgcn_update_dpp(0, iv, 0xB1, 0xf, 0xf, false); break;
                        case 1: r = __builtin_amdgcn_update_dpp(0, iv, 0x4E, 0xf, 0xf, false); break;
                        case 2: r = __builtin_amdgcn_update_dpp(0, iv, 0x141, 0xf, 0xf, false); break;
                        default: r = __builtin_amdgcn_update_dpp(0, iv, 0x140, 0xf, 0xf, false); break; }
    return __builtin_bit_cast(float, r);
}
__device__ __forceinline__ float allsum16(float x) { x += dpp_f(x, 0); x += dpp_f(x, 1); x += dpp_f(x, 2); x += dpp_f(x, 3); return x; }
struct ScanIn { f32x4 dec; v4u rk, kb; unsigned short v; };
__device__ __forceinline__ ScanIn scan_load(const unsigned char* base, int t, int jg, int row) {
    ScanIn s; const unsigned char* p = base + (size_t)t * SCAN_REC; s.dec = *(const f32x4*)(p + jg * 48); s.rk = *(const v4u*)(p + jg * 48 + 16); s.kb = *(const v4u*)(p + jg * 48 + 32);
    s.v = *(const unsigned short*)(p + 768 + row * 2); return s;
}
__device__ __forceinline__ void r4_scan(Frame& F, const Args& A) {
    if (F.bid >= 128) return;
    const int bh = F.bid >> 1, half = F.bid & 1, lane = F.lane, rl = lane >> 4, jg = lane & 15, row = half * 32 + F.wave * 4 + rl;
    const unsigned char* base = A.ws + WS_SCAN + (size_t)bh * SEQ * SCAN_REC;
    float* O = (float*)(A.ws + WS_ORW) + (size_t)(bh >> 4) * SEQ * 1024 + (bh & 15) * 64 + row;
    float S0 = 0.f, S1 = 0.f, S2 = 0.f, S3 = 0.f;
    ScanIn nx[4];
#pragma unroll
    for (int u = 0; u < 4; ++u) nx[u] = scan_load(base, u, jg, row);
    for (int t0 = 0; t0 < SEQ; t0 += 4) {
        ScanIn cu[4];
#pragma unroll
        for (int u = 0; u < 4; ++u) cu[u] = nx[u];
        if (t0 + 4 < SEQ) {
#pragma unroll
            for (int u = 0; u < 4; ++u) nx[u] = scan_load(base, t0 + 4 + u, jg, row); }
#pragma unroll
        for (int u = 0; u < 4; ++u) { const ScanIn& s = cu[u];
            const float r0 = hlo(s.rk.x), r1 = hhi(s.rk.x), r2 = hlo(s.rk.y), r3 = hhi(s.rk.y), k0 = hlo(s.rk.z), k1 = hhi(s.rk.z), k2 = hlo(s.rk.w), k3 = hhi(s.rk.w);
            const float c0 = hlo(s.kb.x), c1 = hhi(s.kb.x), c2 = hlo(s.kb.y), c3 = hhi(s.kb.y), b0 = hlo(s.kb.z), b1 = hhi(s.kb.z), b2 = hlo(s.kb.w), b3 = hhi(s.kb.w);
            const float v = (float)__builtin_bit_cast(_Float16, s.v);
            float sa = (S0 * c0 + S1 * c1) + (S2 * c2 + S3 * c3); sa = allsum16(sa);
            S0 = S0 * s.dec[0] - sa * b0 + v * k0; S1 = S1 * s.dec[1] - sa * b1 + v * k1; S2 = S2 * s.dec[2] - sa * b2 + v * k2; S3 = S3 * s.dec[3] - sa * b3 + v * k3;
            float o = (S0 * r0 + S1 * r1) + (S2 * r2 + S3 * r3); o = allsum16(o);
            if (jg == 0) O[(size_t)(t0 + u) * 1024] = o; }
    }
}

__device__ __forceinline__ void r5_post(Frame& F, const Args& A) {
    const float* ORW = (const float*)(A.ws + WS_ORW); const bf16* LO = (const bf16*)(A.ws + WS_LORA); const unsigned char* SC = A.ws + WS_SCAN; bf16* CAT = (bf16*)(A.ws + WS_CAT);
    const int lane = F.lane, head = lane >> 2, j0 = (lane & 3) * 16, ch = lane * 16;
    const int gw = F.bid * NWAVES + F.wave, NGW = F.G * NWAVES;
    for (int m = gw; m < M; m += NGW) { const int t = m & (SEQ - 1), b = m >> 11;
        float o[16];
#pragma unroll
        for (int q = 0; q < 4; ++q) { const f32x4 x = *(const f32x4*)(ORW + (size_t)m * 1024 + ch + 4 * q); o[4 * q] = x[0]; o[4 * q + 1] = x[1]; o[4 * q + 2] = x[2]; o[4 * q + 3] = x[3]; }
        float s = 0.f;
#pragma unroll
        for (int e = 0; e < 16; ++e) s += o[e];
        s += __shfl_xor(s, 1); s += __shfl_xor(s, 2); const float mean = s * (1.f / 64.f); float q2 = 0.f;
#pragma unroll
        for (int e = 0; e < 16; ++e) { const float d = o[e] - mean; q2 += d * d; }
        q2 += __shfl_xor(q2, 1); q2 += __shfl_xor(q2, 2); const float rstd = 1.f / sqrtf(q2 * (1.f / 64.f) + GN_EPS);
        const unsigned char* rec = SC + ((size_t)(b * 16 + head) * SEQ + t) * SCAN_REC; float dp = 0.f;
#pragma unroll
        for (int q = 0; q < 4; ++q) { const v4u rk = *(const v4u*)(rec + ((lane & 3) * 4 + q) * 48 + 16); const float* rkp = A.in[I_RK] + head * 64 + j0 + 4 * q;
            dp += hlo(rk.x) * hlo(rk.z) * rkp[0] + hhi(rk.x) * hhi(rk.z) * rkp[1] + hlo(rk.y) * hlo(rk.w) * rkp[2] + hhi(rk.y) * hhi(rk.w) * rkp[3]; }
        dp += __shfl_xor(dp, 1); dp += __shfl_xor(dp, 2);
        const v4u v0 = *(const v4u*)(rec + 768 + j0 * 2), v1 = *(const v4u*)(rec + 768 + j0 * 2 + 16);
        const v4u g0 = *(const v4u*)(LO + (size_t)m * 3072 + 2048 + ch), g1 = *(const v4u*)(LO + (size_t)m * 3072 + 2048 + ch + 8);
        float vv[16], gg[16];
#pragma unroll
        for (int e = 0; e < 4; ++e) { vv[2 * e] = hlo(v0[e]); vv[2 * e + 1] = hhi(v0[e]); vv[8 + 2 * e] = hlo(v1[e]); vv[8 + 2 * e + 1] = hhi(v1[e]);
            gg[2 * e] = bflo(g0[e]); gg[2 * e + 1] = bfhi(g0[e]); gg[8 + 2 * e] = bflo(g1[e]); gg[8 + 2 * e + 1] = bfhi(g1[e]); }
        float r[16];
#pragma unroll
        for (int e = 0; e < 16; ++e) r[e] = ((o[e] - mean) * rstd * A.in[I_GNG][ch + e] + A.in[I_GNB][ch + e] + dp * vv[e]) * gg[e];
        v4u w0, w1; w0.x = pk2(r[0], r[1]); w0.y = pk2(r[2], r[3]); w0.z = pk2(r[4], r[5]); w0.w = pk2(r[6], r[7]); w1.x = pk2(r[8], r[9]); w1.y = pk2(r[10], r[11]); w1.z = pk2(r[12], r[13]); w1.w = pk2(r[14], r[15]);
        *(v4u*)(CAT + (size_t)m * 2048 + 1024 + ch) = w0; *(v4u*)(CAT + (size_t)m * 2048 + 1024 + ch + 8) = w1; }
}

__device__ __forceinline__ void ln1_rows(Frame& F, const Args& A) {
    const float* Z = (const float*)(A.ws + WS_Z); float* H1 = (float*)(A.ws + WS_H1); bf16* H1B = (bf16*)(A.ws + WS_H1B);
    const int gw = F.bid * NWAVES + F.wave, NGW = F.G * NWAVES, lane = F.lane;
    for (int m = gw; m < M; m += NGW) { const f32x4* zr = (const f32x4*)(Z + (size_t)m * D) + lane; f32x4 v[8]; float s = 0.f;
#pragma unroll
        for (int j = 0; j < 8; ++j) { v[j] = zr[64 * j]; s += (v[j].x + v[j].y) + (v[j].z + v[j].w); }
        const float mean = wave_sum(s) * (1.f / D); float s2 = 0.f;
#pragma unroll
        for (int j = 0; j < 8; ++j) { v[j] = v[j] - mean; s2 += (v[j].x * v[j].x + v[j].y * v[j].y) + (v[j].z * v[j].z + v[j].w * v[j].w); }
        const float rstd = 1.f / sqrtf(wave_sum(s2) * (1.f / D) + LN_EPS);
#pragma unroll
        for (int j = 0; j < 8; ++j) { const f32x4 g = ((const f32x4*)A.in[I_LN1G])[64 * j + lane], bb = ((const f32x4*)A.in[I_LN1B])[64 * j + lane]; const f32x4 y = v[j] * rstd * g + bb;
            ((f32x4*)(H1 + (size_t)m * D))[64 * j + lane] = y;
            unsigned long long pk = (unsigned long long)pk2(y.x, y.y) | ((unsigned long long)pk2(y.z, y.w) << 32); ((unsigned long long*)(H1B + (size_t)m * D))[64 * j + lane] = pk; } }
}

__device__ __forceinline__ void ins16(float (&tv)[16], float x) {
#pragma unroll
    for (int k = 15; k >= 1; --k) tv[k] = __builtin_amdgcn_fmed3f(tv[k - 1], tv[k], x);
    tv[0] = fmaxf(tv[0], x);
}
__device__ __forceinline__ void topk_phase(Frame& F, const Args& A) {
    const float* SCp = (const float*)(A.ws + WS_SC); int* IDX = (int*)(A.ws + WS_IDX); float* GATE = (float*)(A.ws + WS_GATE);
    LAS float* scr = (LAS float*)(F.lds + F.wave * 8448); LAS unsigned* scu = (LAS unsigned*)scr;
    const int gw = F.bid * NWAVES + F.wave, NGW = F.G * NWAVES, lane = F.lane;
    for (int grp = gw; grp < M / 4; grp += NGW) { const float* base = SCp + (size_t)grp * 4 * 2048;
        float tv[16];
#pragma unroll
        for (int k = 0; k < 16; ++k) tv[k] = -INFINITY;
        for (int q = 0; q < 4; ++q) {
#pragma unroll
            for (int k = 0; k < 8; ++k) { const int rowl = k * 8 + (lane >> 3), c4 = (lane & 7) * 4; const f32x4 x = *(const f32x4*)(base + rowl * 128 + q * 32 + c4);
                scr[rowl * 33 + c4] = x[0]; scr[rowl * 33 + c4 + 1] = x[1]; scr[rowl * 33 + c4 + 2] = x[2]; scr[rowl * 33 + c4 + 3] = x[3]; }
            LDS_WAIT(); asm volatile("" ::: "memory");
#pragma unroll
            for (int i = 0; i < 32; ++i) { const unsigned key = (scu[lane * 33 + i] & ~127u) | (unsigned)(q * 32 + i); ins16(tv, __uint_as_float(key)); }
            LDS_WAIT(); asm volatile("" ::: "memory");
        }
        const int jb = lane & 1; float Av[16], Bv[16];
#pragma unroll
        for (int k = 0; k < 16; ++k) { const float ot = __shfl_xor(tv[k], 1); Av[k] = jb ? ot : tv[k]; Bv[k] = jb ? tv[k] : ot; }
#pragma unroll
        for (int k = 0; k < 16; ++k) { scu[lane * 33 + k] = __float_as_uint(Av[k]) & 127u; scu[lane * 33 + 16 + k] = __float_as_uint(Bv[k]) & 127u; }
        float tw[16];
#pragma unroll
        for (int k = 0; k < 16; ++k) tw[k] = -INFINITY;
#define CROW(i, n) _Pragma("unroll") for (int jj = 0; jj < (n); ++jj) { const float c = Av[i] + Bv[jj]; ins16(tw, __uint_as_float((__float_as_uint(c) & ~255u) | (unsigned)((i) * 16 + jj))); }
        CROW(0, 16) CROW(1, 8) CROW(2, 5) CROW(3, 4) CROW(4, 3) CROW(5, 2) CROW(6, 2) CROW(7, 2) CROW(8, 1) CROW(9, 1) CROW(10, 1) CROW(11, 1) CROW(12, 1) CROW(13, 1) CROW(14, 1) CROW(15, 1)
#undef CROW
        LDS_WAIT(); asm volatile("" ::: "memory");
        float ex[16]; float sum = 0.f;
#pragma unroll
        for (int k = 0; k < 16; ++k) { ex[k] = __expf(tw[k] - tw[0]); sum += ex[k]; }
        const float rs = 1.f / sum; int eid[16];
#pragma unroll
        for (int k = 0; k < 16; ++k) { const unsigned pos = __float_as_uint(tw[k]) & 255u; const unsigned ia = scu[lane * 33 + (pos >> 4)], ib = scu[lane * 33 + 16 + (pos & 15u)]; eid[k] = (int)(ia * 128u + ib); }
        const int token = grp * 4 + (lane >> 4), head = (lane >> 1) & 7; const size_t ob = (size_t)token * 128 + head * 16;
        if (jb == 0) {
#pragma unroll
            for (int k = 0; k < 16; k += 4) { *(int4*)(IDX + ob + k) = make_int4(eid[k], eid[k + 1], eid[k + 2], eid[k + 3]); *(f32x4*)(GATE + ob + k) = (f32x4){ex[k] * rs, ex[k + 1] * rs, ex[k + 2] * rs, ex[k + 3] * rs}; } }
        LDS_WAIT(); asm volatile("" ::: "memory");
    }
}

__device__ __forceinline__ float dot2bf(unsigned w, unsigned x, float acc) { return __builtin_amdgcn_fdot2_f32_bf16(__builtin_bit_cast(bf16x2v, w), __builtin_bit_cast(bf16x2v, x), acc, false); }
__device__ __forceinline__ void peer_phase(Frame& F, const Args& A) {
    const bf16* H1B = (const bf16*)(A.ws + WS_H1B); const float* H1 = (const float*)(A.ws + WS_H1); const bf16* UT = (const bf16*)(A.ws + WS_UTAB); const bf16* VT = (const bf16*)(A.ws + WS_VTAB);
    const int* IDX = (const int*)(A.ws + WS_IDX); const float* GATE = (const float*)(A.ws + WS_GATE);
    const int gw = F.bid * NWAVES + F.wave, NGW = F.G * NWAVES, lane = F.lane;
    for (int m = gw; m < M; m += NGW) {
        v4u xq[4];
#pragma unroll
        for (int q = 0; q < 4; ++q) xq[q] = ((const v4u*)(H1B + (size_t)m * D))[q * 64 + lane];
        float acc[32];
#pragma unroll
        for (int i = 0; i < 32; ++i) acc[i] = 0.f;
        for (int kk = 0; kk < 2; ++kk) { const int my_e = IDX[(size_t)m * 128 + kk * 64 + lane]; const float my_g = GATE[(size_t)m * 128 + kk * 64 + lane];
            for (int k = 0; k < 64; ++k) { const int e = __builtin_amdgcn_readlane(my_e, k); const float g = __builtin_bit_cast(float, __builtin_amdgcn_readlane(__builtin_bit_cast(int, my_g), k));
                const v4u* ur = (const v4u*)(UT + (size_t)e * D); const v4u* vr = (const v4u*)(VT + (size_t)e * D);
                v4u uq[4], vq[4];
#pragma unroll
                for (int q = 0; q < 4; ++q) { uq[q] = ur[q * 64 + lane]; vq[q] = vr[q * 64 + lane]; }
                float d = 0.f;
#pragma unroll
                for (int q = 0; q < 4; ++q) { d = dot2bf(uq[q].x, xq[q].x, d); d = dot2bf(uq[q].y, xq[q].y, d); d = dot2bf(uq[q].z, xq[q].z, d); d = dot2bf(uq[q].w, xq[q].w, d); }
                d = wave_sum(d); const float s = g * gelu_tanh(d);
#pragma unroll
                for (int q = 0; q < 4; ++q)
#pragma unroll
                    for (int c = 0; c < 4; ++c) { acc[q * 8 + 2 * c] += s * bflo(vq[q][c]); acc[q * 8 + 2 * c + 1] += s * bfhi(vq[q][c]); } } }
        float y[32]; float s1 = 0.f;
#pragma unroll
        for (int q = 0; q < 4; ++q) { const f32x4 h0 = ((const f32x4*)(H1 + (size_t)m * D))[(q * 64 + lane) * 2], h1 = ((const f32x4*)(H1 + (size_t)m * D))[(q * 64 + lane) * 2 + 1];
#pragma unroll
            for (int c = 0; c < 4; ++c) { y[q * 8 + c] = ALPHA * h0[c] + acc[q * 8 + c]; y[q * 8 + 4 + c] = ALPHA * h1[c] + acc[q * 8 + 4 + c]; } }
#pragma unroll
        for (int i = 0; i < 32; ++i) s1 += y[i];
        const float mean = wave_sum(s1) * (1.f / D); float s2 = 0.f;
#pragma unroll
        for (int i = 0; i < 32; ++i) { y[i] -= mean; s2 += y[i] * y[i]; }
        const float rstd = 1.f / sqrtf(wave_sum(s2) * (1.f / D) + LN_EPS);
#pragma unroll
        for (int q = 0; q < 4; ++q) { const int o4 = (q * 64 + lane) * 2; const f32x4 g0 = ((const f32x4*)A.in[I_LN2G])[o4], g1 = ((const f32x4*)A.in[I_LN2G])[o4 + 1], b0 = ((const f32x4*)A.in[I_LN2B])[o4], b1 = ((const f32x4*)A.in[I_LN2B])[o4 + 1];
            f32x4 r0, r1;
#pragma unroll
            for (int c = 0; c < 4; ++c) { r0[c] = y[q * 8 + c] * rstd * g0[c] + b0[c]; r1[c] = y[q * 8 + 4 + c] * rstd * g1[c] + b1[c]; }
            ((f32x4*)(A.out + (size_t)m * D))[o4] = r0; ((f32x4*)(A.out + (size_t)m * D))[o4 + 1] = r1; } }
}

__global__ void __launch_bounds__(NWAVES * 64, 2) fwd_kernel(Args args) {
    extern __shared__ __attribute__((aligned(16))) unsigned char lds[];
    Frame F;
    F.lds = (LAS unsigned char*)lds;
    F.MISC = (volatile LAS unsigned*)(F.lds + MISC_OFF);
    F.tid = threadIdx.x; F.lane = F.tid & 63; F.wave = __builtin_amdgcn_readfirstlane(F.tid >> 6);
    F.G = gridDim.x; F.bid = blockIdx.x;
    unsigned char* ws = args.ws;
    F.ctl = (gu32*)(ws + WS_CTL);
    for (int u = F.tid; u < (LDS_BYTES - LDSCTL_OFF) / 4; u += NWAVES * 64) ((LAS unsigned*)(F.lds + LDSCTL_OFF))[u] = 0u;
    __syncthreads();
    XcdBarrier bar; bar.bar = (unsigned*)(F.ctl + CW_BAR); bar.x = 0; bar.st = nullptr;
    if (!MK_PER_PHASE) bar = xcd_barrier_post((unsigned*)(F.ctl + CW_BAR), F.MISC + 8);
    const int lo = args.ph_lo, hi = args.ph_hi;
#ifndef PHMASK
#define PHMASK 0xFFFF
#endif
#define IN(k) (((PHMASK >> (k)) & 1) && lo <= (k) && (k) < hi)
#define SEAM(k) do { if (IN(k) && IN((k) + 1)) xcd_barrier(bar); } while (0)
    typedef pg8::bf16_t pb;
    pb* XB = (pb*)(ws + WS_XB); pb* WIN = (pb*)(ws + WS_WIN); pb* U = (pb*)(ws + WS_U); pb* Gt = (pb*)(ws + WS_G); pb* MT = (pb*)(ws + WS_MT);
    pb* PRW = (pb*)(ws + WS_PRW); pb* YS = (pb*)(ws + WS_YS); pb* CAT = (pb*)(ws + WS_CAT); pb* AL = (pb*)(ws + WS_ALORA); pb* LO = (pb*)(ws + WS_LORA);
    pb* WGLU = (pb*)(ws + WS_WGLU); pb* WOUT = (pb*)(ws + WS_WOUT); pb* WQK = (pb*)(ws + WS_WQK); pb* WL = (pb*)(ws + WS_WLORA); pb* H1B = (pb*)(ws + WS_H1B);

    if (IN(0)) { p0_prologue(F, args); } SEAM(0);
    if (IN(1)) {
        pg8::Gemm g{XB, WIN, 2048, 2048, 2048}; pg8::StaticOrder S; S.init(M, INP, F.G, F.bid); pg8::EpiProj E{U, PRW};
        pg8::gemm_phase<pg8::EpiProj, pg8::StaticOrder, true, true>(F.lds + RING_OFF, g, S, E); } SEAM(1);
    if (IN(2)) {
        pg8::Gemm g{U, Gt, 512, 640, 512}; pg8::OneUnit S{F.bid < 64 ? F.bid : -1, F.bid >> 1}; pg8::EpiSa E{U, (const float*)(ws + WS_A32)};
        pg8::gemm_phase<pg8::EpiSa, pg8::OneUnit, false, true>(F.lds + RING_OFF, g, S, E);
        r1_lora_in(F, args); } SEAM(2);
    if (IN(3)) {
        { pg8::Gemm g{U, MT, 640, 640, 640}; pg8::OneUnit S{F.bid < 128 ? (F.bid >> 1) : -1, F.bid}; pg8::EpiY E{YS};
          pg8::gemm_phase<pg8::EpiY, pg8::OneUnit, false, true>(F.lds + RING_OFF, g, S, E); }
        { pg8::Gemm g{AL, WL, 384, 384, 384}; pg8::ListOrder S{F.bid < 128 ? 256 + F.bid : F.bid - 128, F.bid < 128 ? -1 : F.bid, 32}; pg8::EpiStoreBf16 E{LO, 3072};
          pg8::gemm_phase<pg8::EpiStoreBf16, pg8::ListOrder, true, true>(F.lds + RING_OFF, g, S, E); } } SEAM(3);
    if (IN(4)) {
        { const int L = F.bid - 128; pg8::Gemm g{YS, WGLU, 1024, 1024, 1024}; pg8::OneUnit S{L >= 0 ? (L & 31) : -1, L >> 5}; pg8::EpiGLU E{YS, args.in[I_BGLU], CAT};
          pg8::gemm_phase<pg8::EpiGLU, pg8::OneUnit, false, true>(F.lds + RING_OFF, g, S, E); }
        r3_prep(F, args); } SEAM(4);
    if (IN(5)) { r4_scan(F, args); } SEAM(5);
    if (IN(6)) { r5_post(F, args); } SEAM(6);
    if (IN(7)) {
        pg8::Gemm g{CAT, WOUT, 2048, 2048, 2048}; pg8::StaticOrder S; S.init(M, D, F.G, F.bid); pg8::EpiF32 E{(float*)(ws + WS_Z), args.in[I_X], D, ALPHA};
        pg8::gemm_phase<pg8::EpiF32, pg8::StaticOrder, true, true>(F.lds + RING_OFF, g, S, E); } SEAM(7);
    if (IN(8)) { ln1_rows(F, args); } SEAM(8);
    if (IN(9)) {
        pg8::Gemm g{H1B, WQK, 2048, 2048, 2048}; pg8::StaticOrder S; S.init(M, D, F.G, F.bid); pg8::EpiF32 E{(float*)(ws + WS_SC), nullptr, D, 0.f};
        pg8::gemm_phase<pg8::EpiF32, pg8::StaticOrder, true, true>(F.lds + RING_OFF, g, S, E); } SEAM(9);
    if (IN(10)) { topk_phase(F, args); } SEAM(10);
    if (IN(11)) { peer_phase(F, args); }
#undef IN
#undef SEAM
}

extern "C" void kernel_launch(void* const* d_in, const int* in_sizes, int n_in, void* d_out, int out_size, void* d_ws, size_t ws_size, hipStream_t stream) {
    static int grid = 0;
    if (grid == 0) {
        if (n_in != 33 || in_sizes[0] != M * D || out_size != M * D || ws_size < WS_END) { fprintf(stderr, "kernel_launch: unexpected shapes (n_in %d, in0 %d, out %d, ws %zu)\n", n_in, n_in > 0 ? in_sizes[0] : -1, out_size, ws_size); grid = -1; return; }
        int dev = 0, cus = 0, per_cu = 0;
        if (hipGetDevice(&dev) != hipSuccess || hipDeviceGetAttribute(&cus, hipDeviceAttributeMultiprocessorCount, dev) != hipSuccess) { grid = -1; return; }
        if (hipFuncSetAttribute((const void*)fwd_kernel, hipFuncAttributeMaxDynamicSharedMemorySize, LDS_BYTES) != hipSuccess) { fprintf(stderr, "kernel_launch: hipFuncSetAttribute failed\n"); grid = -1; return; }
        if (hipOccupancyMaxActiveBlocksPerMultiprocessor(&per_cu, (const void*)fwd_kernel, NWAVES * 64, LDS_BYTES) != hipSuccess || per_cu < 1) { fprintf(stderr, "kernel_launch: occupancy query says %d blocks per CU\n", per_cu); per_cu = 1; }
        (void)hipGetLastError();
        grid = cus;
        if (grid != 256) fprintf(stderr, "kernel_launch: %d CUs (built for 256)\n", grid);
    }
    if (grid < 0) return;
    (void)hipMemsetAsync((char*)d_ws + WS_CTL, 0, CTL_ZERO_BYTES, stream);
    Args a{};
    for (int i = 0; i < 33; ++i) a.in[i] = (const float*)d_in[i];
    a.out = (float*)d_out; a.ws = (unsigned char*)d_ws;
#if MK_PER_PHASE
    for (int li = 0; li < NPHASE; ++li) { a.ph_lo = li; a.ph_hi = li + 1; a.li = li; hipLaunchKernelGGL(fwd_kernel, dim3(grid), dim3(NWAVES * 64), LDS_BYTES, stream, a); }
#else
    a.ph_lo = 0; a.ph_hi = NPHASE; a.li = 0;
    void* kargs[] = {(void*)&a};
    hipError_t e = hipLaunchCooperativeKernel((const void*)fwd_kernel, dim3(grid), dim3(NWAVES * 64), kargs, LDS_BYTES, stream);
    if (e != hipSuccess) fprintf(stderr, "kernel_launch: cooperative launch failed: %s\n", hipGetErrorString(e));
#endif
}
```

```cpp
#include <hip/hip_runtime.h>
#include <cstdio>
#include <cstdint>
#include <cmath>
namespace pg8 {
#define PG8_LAS __attribute__((address_space(3)))
typedef unsigned short bf16_t;
typedef short bf16x8 __attribute__((ext_vector_type(8)));
typedef float f32x4 __attribute__((ext_vector_type(4)));
typedef float f32x2 __attribute__((ext_vector_type(2)));
typedef unsigned u32x4 __attribute__((ext_vector_type(4)));
constexpr int BM = 256, BK = 64, HALF = 128, HTB = HALF * BK * 2  , STAGE_BYTES = 8 * HTB, NXCD = 8, WGM = 8;

__host__ __device__ __forceinline__ int lds_byte(int r, int c) { const int st = (r >> 4) * 2 + (c >> 5), rr = r & 15, cc = c & 31, ob = rr * 64 + cc * 2; return st * 1024 + (ob ^ (((ob >> 9) & 1) << 5)); }
__host__ __device__ __forceinline__ void stage_rc(int b, int& R, int& C) { const int st = b / 1024, sb = b % 1024, swz = sb ^ (((sb >> 9) & 1) << 5); R = (st >> 1) * 16 + swz / 64; C = (st & 1) * 32 + (swz % 64) / 2; }
__host__ __device__ __forceinline__ int perm32(int rho) { const int n = rho >> 4, i = rho & 15; return 8 * (i >> 2) + 4 * n + (i & 3); }

struct Unit { int pm, pn; };
struct Gemm { const bf16_t* A; const bf16_t* Bt; int K, lda, ldb; };

struct StaticOrder {
    int nM, nN, nwg, G, c;
    __host__ __device__ void init(int M, int N, int G_, int c_) { nM = M / BM; nN = N / BM; nwg = nM * nN; G = G_; c = c_; }
    __host__ __device__ bool next(int i, Unit& u) const {
        const long L = (long)i * G + c; if (L >= nwg) return false;
        int wgid = (int)L; { const int q = nwg / NXCD, r = nwg % NXCD, xcd = wgid % NXCD, off = wgid / NXCD; wgid = (xcd < r ? xcd * (q + 1) : r * (q + 1) + (xcd - r) * q) + off; }
        const int nig = WGM * nN, gid = wgid / nig, fm = gid * WGM, gsz = (nM - fm) < WGM ? (nM - fm) : WGM;
        u.pm = fm + ((wgid % nig) % gsz); u.pn = (wgid % nig) / gsz; return true;
    }
    __device__ __forceinline__ void a_ready(const Unit&) const {}
    __device__ __forceinline__ void done(const Unit&) const {}
};
struct ListOrder {
    int L0, L1, nM;
    __device__ bool next(int i, Unit& u) const { const int L = (i == 0) ? L0 : ((i == 1) ? L1 : -1); if (L < 0) return false; u.pm = L % nM; u.pn = L / nM; return true; }
    __device__ __forceinline__ void a_ready(const Unit&) const {}
    __device__ __forceinline__ void done(const Unit&) const {}
};
struct OneUnit {
    int pm, pn;
    __device__ bool next(int i, Unit& u) const { if (i != 0 || pm < 0) return false; u.pm = pm; u.pn = pn; return true; }
    __device__ __forceinline__ void a_ready(const Unit&) const {}
    __device__ __forceinline__ void done(const Unit&) const {}
};

__device__ __forceinline__ unsigned cvt_pk_bf16(float lo, float hi) { unsigned r; asm volatile("v_cvt_pk_bf16_f32 %0, %1, %2" : "=v"(r) : "v"(lo), "v"(hi)); return r; }
__device__ __forceinline__ float bf_lo(unsigned w) { return __uint_as_float(w << 16); }
__device__ __forceinline__ float bf_hi(unsigned w) { return __uint_as_float(w & 0xffff0000u); }
__device__ __forceinline__ float gelu_tanh(float x) { const float y = 0.7978845608f * (x + 0.044715f * x * x * x); return x * __builtin_amdgcn_rcpf(1.0f + __expf(-2.0f * y)); }
__device__ __forceinline__ float sigmoidf(float x) { return __builtin_amdgcn_rcpf(1.0f + __expf(-x)); }

__device__ __forceinline__ u32x4 pack8(const f32x4 v0, const f32x4 v1) { u32x4 w; w.x = cvt_pk_bf16(v0[0], v0[1]); w.y = cvt_pk_bf16(v0[2], v0[3]); w.z = cvt_pk_bf16(v1[0], v1[1]); w.w = cvt_pk_bf16(v1[2], v1[3]); return w; }

struct EpiStoreBf16 {
    static constexpr bool PERM = true, AFTER_DRAIN = false;
    bf16_t* O; int ldc;
    __device__ __forceinline__ void operator()(const f32x4 (&acc)[2][2][4][2], const Unit& u, int wr, int wc, int fr, int fq) const {
        const int row0 = u.pm * BM + wr * 64 + fr, col0 = u.pn * BM + wc * 32 + 8 * fq;
#pragma unroll
        for (int ai = 0; ai < 2; ++ai)
#pragma unroll
            for (int m = 0; m < 4; ++m) { bf16_t* rowp = O + (size_t)(row0 + ai * HALF + m * 16) * ldc + col0;
#pragma unroll
                for (int bj = 0; bj < 2; ++bj) *(u32x4*)(rowp + bj * HALF) = pack8(acc[ai][bj][m][0], acc[ai][bj][m][1]); }
    }
};
struct EpiProj {
    static constexpr bool PERM = true, AFTER_DRAIN = false;
    bf16_t* U; bf16_t* PRW;
    __device__ __forceinline__ void operator()(const f32x4 (&acc)[2][2][4][2], const Unit& u, int wr, int wc, int fr, int fq) const {
        const int row0 = u.pm * BM + wr * 64 + fr, col0 = u.pn * BM + wc * 32 + 8 * fq;
#pragma unroll
        for (int ai = 0; ai < 2; ++ai)
#pragma unroll
            for (int m = 0; m < 4; ++m) { const int row = row0 + ai * HALF + m * 16;
#pragma unroll
                for (int bj = 0; bj < 2; ++bj) { const int col = col0 + bj * HALF; const u32x4 w = pack8(acc[ai][bj][m][0], acc[ai][bj][m][1]);
                    if (u.pn < 4) { const int g = col >> 4, h0 = col & 15, b = row >> 11, t = row & 2047, c = t >> 5, s = t & 31;
                        *(u32x4*)(U + (size_t)(g * 256 + b * 64 + c) * 640 + s * 16 + h0) = w; }
                    else *(u32x4*)(PRW + (size_t)row * 3584 + (col - 1024)) = w; } }
    }
};
struct EpiY {
    static constexpr bool PERM = true, AFTER_DRAIN = false;
    bf16_t* YS;
    __device__ __forceinline__ void operator()(const f32x4 (&acc)[2][2][4][2], const Unit& u, int wr, int wc, int fr, int fq) const {
        const int g = u.pm, j = u.pn & 1;
#pragma unroll
        for (int ai = 0; ai < 2; ++ai)
#pragma unroll
            for (int m = 0; m < 4; ++m) { const int rowl = ai * HALF + wr * 64 + m * 16 + fr, b = rowl >> 6, c = rowl & 63;
#pragma unroll
                for (int bj = 0; bj < 2; ++bj) { const int n = 256 * j + bj * HALF + wc * 32 + 8 * fq, tl = n >> 4, h0 = n & 15;
                    f32x4 v0 = acc[ai][bj][m][0], v1 = acc[ai][bj][m][1];
#pragma unroll
                    for (int e = 0; e < 4; ++e) { v0[e] = gelu_tanh(v0[e]); v1[e] = gelu_tanh(v1[e]); }
                    *(u32x4*)(YS + (size_t)(b * 2048 + c * 32 + tl) * 1024 + g * 16 + h0) = pack8(v0, v1); }
                asm volatile("" ::: "memory"); }
    }
};
struct EpiGLU {
    static constexpr bool PERM = true, AFTER_DRAIN = false;
    const bf16_t* YS; const float* bglu; bf16_t* CAT;
    __device__ __forceinline__ void operator()(const f32x4 (&acc)[2][2][4][2], const Unit& u, int wr, int wc, int fr, int fq) const {
        const int row0 = u.pm * BM + wr * 64 + fr, col0 = u.pn * BM + wc * 32 + 8 * fq;
#pragma unroll
        for (int bj = 0; bj < 2; ++bj) { const int col = col0 + bj * HALF; const f32x4 b0 = *(const f32x4*)(bglu + col), b1 = *(const f32x4*)(bglu + col + 4);
#pragma unroll
            for (int ai = 0; ai < 2; ++ai)
#pragma unroll
                for (int m = 0; m < 4; ++m) { const int row = row0 + ai * HALF + m * 16; const u32x4 y = *(const u32x4*)(YS + (size_t)row * 1024 + col);
                    const f32x4 a0 = acc[ai][bj][m][0] + b0, a1 = acc[ai][bj][m][1] + b1; f32x4 o0, o1;
                    o0[0] = bf_lo(y.x) * sigmoidf(a0[0]); o0[1] = bf_hi(y.x) * sigmoidf(a0[1]); o0[2] = bf_lo(y.y) * sigmoidf(a0[2]); o0[3] = bf_hi(y.y) * sigmoidf(a0[3]);
                    o1[0] = bf_lo(y.z) * sigmoidf(a1[0]); o1[1] = bf_hi(y.z) * sigmoidf(a1[1]); o1[2] = bf_lo(y.w) * sigmoidf(a1[2]); o1[3] = bf_hi(y.w) * sigmoidf(a1[3]);
                    *(u32x4*)(CAT + (size_t)row * 2048 + col) = pack8(o0, o1); } }
    }
};
struct EpiF32 {
    static constexpr bool PERM = false, AFTER_DRAIN = false;
    float* O; const float* R; int ldc; float alpha;
    __device__ __forceinline__ void operator()(const f32x4 (&acc)[2][2][4][2], const Unit& u, int wr, int wc, int fr, int fq) const {
        const int row0 = u.pm * BM + wr * 64 + fr, col0 = u.pn * BM + wc * 32 + 4 * fq;
#pragma unroll
        for (int ai = 0; ai < 2; ++ai)
#pragma unroll
            for (int m = 0; m < 4; ++m) { const size_t off = (size_t)(row0 + ai * HALF + m * 16) * ldc + col0;
#pragma unroll
                for (int bj = 0; bj < 2; ++bj)
#pragma unroll
                    for (int n = 0; n < 2; ++n) { f32x4 o = acc[ai][bj][m][n]; if (R) { const f32x4 r = *(const f32x4*)(R + off + bj * HALF + n * 16); o = o + r * alpha; }
                        *(f32x4*)(O + off + bj * HALF + n * 16) = o; } }
    }
};
struct EpiSa {
    static constexpr bool PERM = false, AFTER_DRAIN = true;
    bf16_t* U; const float* A32;
    __device__ __forceinline__ void fused(const f32x4 (&acc)[2][2][4][2], const Unit& u, int wr, int wc, int fr, int fq, PG8_LAS unsigned char* lds, int wid, int lane) const {
        const int g = u.pm, gb = g & 1;
        PG8_LAS float* SL = (PG8_LAS float*)lds;
#pragma unroll
        for (int ai = 0; ai < 2; ++ai)
#pragma unroll
            for (int m = 0; m < 4; ++m) { const int rowl = ai * HALF + wr * 64 + m * 16 + fr;
#pragma unroll
                for (int bj = 0; bj < 2; ++bj) if (bj == gb) {
#pragma unroll
                    for (int n = 0; n < 2; ++n) *(PG8_LAS f32x4*)(SL + rowl * 128 + wc * 32 + n * 16 + 4 * fq) = acc[ai][bj][m][n]; } }
        asm volatile("s_waitcnt lgkmcnt(0)" ::: "memory"); __builtin_amdgcn_s_barrier(); asm volatile("" ::: "memory");
        const int tid = wid * 64 + lane;
        if (tid < 256) { const int b = tid >> 6, p = tid & 63; const float ar = A32[(g * 64 + p) * 2], ai_ = A32[(g * 64 + p) * 2 + 1]; float hr = 0.f, hi = 0.f;
            for (int c = 0; c < 64; ++c) { bf16_t* up = U + (size_t)(g * 256 + b * 64 + c) * 640 + 512 + p;
                const unsigned pk = cvt_pk_bf16(hr, hi); up[0] = (bf16_t)(pk & 0xffffu); up[64] = (bf16_t)(pk >> 16);
                const float sr = SL[(b * 64 + c) * 128 + p], si = SL[(b * 64 + c) * 128 + 64 + p];
                const float nr = ar * hr - ai_ * hi + sr, ni = ar * hi + ai_ * hr + si; hr = nr; hi = ni; } }
    }
};

template <class Epi, class Sched, bool ALIGN_EPI = false, bool SP2 = false>
__device__ __forceinline__ void gemm_phase(PG8_LAS unsigned char* lds, const Gemm g, const Sched& S, const Epi& E) {
    const int tid = threadIdx.x, wid = __builtin_amdgcn_readfirstlane(tid >> 6), lane = tid & 63, wr = wid >> 2, wc = wid & 3, fr = lane & 15, fq = lane >> 4;
    const int K = g.K, nt = K / BK;
    unsigned voffA[2], voffB[2];
#pragma unroll
    for (int i = 0; i < 2; ++i) { int R, C; stage_rc(tid * 16 + i * 8192, R, C); const int Rb = Epi::PERM ? ((R & ~31) + perm32(R & 31)) : R;
        voffA[i] = (unsigned)(R * g.lda + C) * 2u; voffB[i] = (unsigned)(Rb * g.ldb + C) * 2u; }
    const size_t kstep = (size_t)(BK * 2);
    const size_t hsA = (size_t)HALF * g.lda * 2, hsB = (size_t)HALF * g.ldb * 2;
    const size_t tsA = 2 * hsA, tsB = 2 * hsB;
    const unsigned ldsw = (unsigned)wid * 1024u;
    const int aoff = lds_byte(wr * 64 + fr, fq * 8), boff = lds_byte(wc * 32 + fr, fq * 8);
#define PG8_SA(b, h) (((b) * 2 + (h)) * HTB)
#define PG8_SB(b, h) ((4 + (b) * 2 + (h)) * HTB)
#define PG8_STAGE(bufoff, gbase, voff) do { _Pragma("unroll") for (int _i = 0; _i < 2; ++_i) \
        __builtin_amdgcn_global_load_lds((const unsigned*)((const char*)(gbase) + (voff)[_i]), (PG8_LAS unsigned*)(lds + (bufoff) + ldsw + _i * 8192), 16, 0, 0); } while (0)
#define PG8_LDA(dst, b, h) do { _Pragma("unroll") for (int m = 0; m < 4; ++m) _Pragma("unroll") for (int k = 0; k < 2; ++k) dst[m][k] = *(const PG8_LAS bf16x8*)(lds + PG8_SA(b, h) + aoff + m * 2048 + k * 1024); } while (0)
#define PG8_LDB(dst, b, h) do { _Pragma("unroll") for (int n = 0; n < 2; ++n) _Pragma("unroll") for (int k = 0; k < 2; ++k) dst[n][k] = *(const PG8_LAS bf16x8*)(lds + PG8_SB(b, h) + boff + n * 2048 + k * 1024); } while (0)
#define PG8_MMA(ai, bj, At, Bt) do { __builtin_amdgcn_s_setprio(1); _Pragma("unroll") for (int m = 0; m < 4; ++m) _Pragma("unroll") for (int n = 0; n < 2; ++n) _Pragma("unroll") for (int k = 0; k < 2; ++k) \
        acc[ai][bj][m][n] = __builtin_amdgcn_mfma_f32_16x16x32_bf16(Bt[n][k], At[m][k], acc[ai][bj][m][n], 0, 0, 0); __builtin_amdgcn_s_setprio(0); } while (0)
#define PG8_WAIT_V(n) asm volatile("s_waitcnt vmcnt(" #n ")" ::: "memory")
#define PG8_WAIT_L(n) asm volatile("s_waitcnt lgkmcnt(" #n ")" ::: "memory")
#define PG8_BAR __builtin_amdgcn_s_barrier()
#define PG8_SCHED __builtin_amdgcn_sched_barrier(0)
    Unit cur, nxt; int ui = 0;
    if (!S.next(0, cur)) return;
    f32x4 acc[2][2][4][2];
#pragma unroll
    for (int a = 0; a < 2; ++a)
#pragma unroll
        for (int b = 0; b < 2; ++b)
#pragma unroll
            for (int m = 0; m < 4; ++m)
#pragma unroll
                for (int n = 0; n < 2; ++n) acc[a][b][m][n] = (f32x4){0.f, 0.f, 0.f, 0.f};
    bf16x8 At[4][2], B0[2][2], B1[2][2];
    const char* cA = (const char*)g.A + (size_t)cur.pm * tsA; const char* cB = (const char*)g.Bt + (size_t)cur.pn * tsB;
    S.a_ready(cur);
    if constexpr (SP2) {
        PG8_STAGE(PG8_SB(0, 0), cB, voffB); PG8_STAGE(PG8_SB(0, 1), cB + hsB, voffB); PG8_STAGE(PG8_SA(0, 0), cA, voffA); PG8_STAGE(PG8_SA(0, 1), cA + hsA, voffA);
        if (wr == 1) PG8_BAR;
        PG8_WAIT_V(2); PG8_BAR;
        PG8_STAGE(PG8_SB(1, 0), cB + kstep, voffB); PG8_STAGE(PG8_SA(1, 0), cA + kstep, voffA); PG8_STAGE(PG8_SB(1, 1), cB + hsB + kstep, voffB);
        PG8_WAIT_V(6); PG8_BAR;
    } else {
        PG8_STAGE(PG8_SB(0, 0), cB, voffB); PG8_STAGE(PG8_SA(0, 0), cA, voffA); PG8_STAGE(PG8_SB(0, 1), cB + hsB, voffB); PG8_STAGE(PG8_SA(0, 1), cA + hsA, voffA);
        if (wr == 1) PG8_BAR;
        PG8_WAIT_V(4); PG8_BAR;
        PG8_STAGE(PG8_SB(1, 0), cB + kstep, voffB); PG8_STAGE(PG8_SA(1, 0), cA + kstep, voffA); PG8_STAGE(PG8_SB(1, 1), cB + hsB + kstep, voffB);
        PG8_WAIT_V(6); PG8_BAR;
    }
    for (;;) {
        const bool has_next = S.next(ui + 1, nxt);
        const char* nA = has_next ? (const char*)g.A + (size_t)nxt.pm * tsA : cA; const char* nB = has_next ? (const char*)g.Bt + (size_t)nxt.pn * tsB : cB;
#pragma nounroll
        for (int t = 0; t < nt; t += 2) {
            const bool last = (t == nt - 2);
            const char* a1 = cA + (size_t)(t + 1) * kstep;
            const char* a2 = last ? nA : cA + (size_t)(t + 2) * kstep; const char* b2 = last ? nB : cB + (size_t)(t + 2) * kstep;
            const char* a3 = a2 + kstep; const char* b3 = b2 + kstep;
            if (last && has_next) S.a_ready(nxt);
            if constexpr (SP2) {
            PG8_LDB(B0, 0, 0); PG8_LDB(B1, 0, 1); PG8_SCHED; PG8_LDA(At, 0, 0); PG8_STAGE(PG8_SA(1, 1), a1 + hsA, voffA);
            PG8_WAIT_V(8); PG8_WAIT_L(0); PG8_BAR; PG8_MMA(0, 0, At, B0); PG8_MMA(0, 1, At, B1); PG8_BAR; PG8_SCHED;
            PG8_LDA(At, 0, 1); PG8_STAGE(PG8_SB(0, 0), b2, voffB); PG8_STAGE(PG8_SB(0, 1), b2 + hsB, voffB); PG8_STAGE(PG8_SA(0, 0), a2, voffA);
            PG8_WAIT_V(8); PG8_WAIT_L(0); PG8_BAR; PG8_MMA(1, 0, At, B0); PG8_MMA(1, 1, At, B1); PG8_BAR; PG8_SCHED;
            PG8_LDB(B0, 1, 0); PG8_LDB(B1, 1, 1); PG8_SCHED; PG8_LDA(At, 1, 0); PG8_STAGE(PG8_SA(0, 1), a2 + hsA, voffA);
            PG8_WAIT_V(8); PG8_WAIT_L(0); PG8_BAR; PG8_MMA(0, 0, At, B0); PG8_MMA(0, 1, At, B1); PG8_BAR; PG8_SCHED;
            PG8_LDA(At, 1, 1); PG8_STAGE(PG8_SB(1, 0), b3, voffB); PG8_STAGE(PG8_SB(1, 1), b3 + hsB, voffB); PG8_STAGE(PG8_SA(1, 0), a3, voffA);
            PG8_WAIT_V(8); PG8_WAIT_L(0); PG8_BAR; PG8_MMA(1, 0, At, B0); PG8_MMA(1, 1, At, B1); PG8_BAR; PG8_SCHED;
            } else {
            PG8_LDB(B0, 0, 0); PG8_SCHED; PG8_LDA(At, 0, 0); PG8_STAGE(PG8_SA(1, 1), a1 + hsA, voffA);
            PG8_WAIT_L(8); PG8_BAR; PG8_WAIT_L(0); PG8_MMA(0, 0, At, B0); PG8_BAR; PG8_SCHED;
            PG8_LDB(B1, 0, 1); PG8_STAGE(PG8_SB(0, 0), b2, voffB);
            PG8_BAR; PG8_WAIT_L(0); PG8_MMA(0, 1, At, B1); PG8_BAR;
            PG8_LDA(At, 0, 1); PG8_STAGE(PG8_SA(0, 0), a2, voffA);
            PG8_BAR; PG8_WAIT_L(0); PG8_MMA(1, 0, At, B0); PG8_BAR; PG8_SCHED;
            PG8_STAGE(PG8_SB(0, 1), b2 + hsB, voffB);
            PG8_WAIT_V(6); PG8_BAR; PG8_MMA(1, 1, At, B1); PG8_BAR;
            PG8_LDB(B0, 1, 0); PG8_SCHED; PG8_LDA(At, 1, 0); PG8_STAGE(PG8_SA(0, 1), a2 + hsA, voffA);
            PG8_WAIT_L(8); PG8_BAR; PG8_WAIT_L(0); PG8_MMA(0, 0, At, B0); PG8_BAR; PG8_SCHED;
            PG8_LDB(B1, 1, 1); PG8_STAGE(PG8_SB(1, 0), b3, voffB);
            PG8_BAR; PG8_WAIT_L(0); PG8_MMA(0, 1, At, B1); PG8_BAR;
            PG8_LDA(At, 1, 1); PG8_STAGE(PG8_SA(1, 0), a3, voffA);
            PG8_BAR; PG8_WAIT_L(0); PG8_MMA(1, 0, At, B0); PG8_BAR; PG8_SCHED;
            PG8_STAGE(PG8_SB(1, 1), b3 + hsB, voffB);
            PG8_WAIT_V(6); PG8_BAR; PG8_MMA(1, 1, At, B1); PG8_BAR;
            }
        }
        if constexpr (ALIGN_EPI) { if (wr == 0) PG8_BAR; }
        if constexpr (!Epi::AFTER_DRAIN) { E(acc, cur, wr, wc, fr, fq); S.done(cur); }
        if (!has_next) break;
#pragma unroll
        for (int a = 0; a < 2; ++a)
#pragma unroll
            for (int b = 0; b < 2; ++b)
#pragma unroll
                for (int m = 0; m < 4; ++m)
#pragma unroll
                    for (int n = 0; n < 2; ++n) acc[a][b][m][n] = (f32x4){0.f, 0.f, 0.f, 0.f};
        cur = nxt; cA = nA; cB = nB; ++ui;
        if constexpr (ALIGN_EPI) { if (wr == 1) PG8_BAR; }
    }
    PG8_WAIT_V(0);
    if constexpr (!ALIGN_EPI) { if (wr == 0) PG8_BAR; }
    PG8_BAR;
    if constexpr (Epi::AFTER_DRAIN) { E.fused(acc, cur, wr, wc, fr, fq, lds, wid, lane); S.done(cur); }
#undef PG8_SA
#undef PG8_SB
#undef PG8_STAGE
#undef PG8_LDA
#undef PG8_LDB
#undef PG8_MMA
#undef PG8_WAIT_V
#undef PG8_WAIT_L
#undef PG8_BAR
#undef PG8_SCHED
}
}

constexpr int NWAVES = 8;
#ifndef MK_PER_PHASE
#define MK_PER_PHASE 0
#endif
constexpr int NPHASE = 12;
constexpr int M = 8192, D = 2048, SEQ = 2048;
constexpr int INC = 4384, INP = 4608;
constexpr float ALPHA = 1.189207115f;
constexpr float LN_EPS = 1e-5f, GN_EPS = 64e-5f;
constexpr size_t MiB = 1u << 20;
constexpr size_t WS_CTL = 0, CTL_ZERO_BYTES = 1 * MiB;
constexpr size_t WS_WGLU = 1 * MiB, WS_WOUT = 3 * MiB, WS_WQK = 11 * MiB, WS_WLORA = 19 * MiB, WS_IDX = 22 * MiB, WS_GATE = 26 * MiB, WS_A32 = 30 * MiB;
constexpr size_t WS_UTAB = 32 * MiB, WS_VTAB = 96 * MiB;
constexpr size_t WS_SU = 31 * MiB;
constexpr size_t WS_XB = 160 * MiB, WS_WIN = 192 * MiB, WS_U = 210 * MiB, WS_G = 230 * MiB, WS_MT = 238 * MiB;
constexpr size_t WS_SCAN = 160 * MiB;
constexpr size_t WS_PRW = 286 * MiB, WS_YS = 342 * MiB, WS_CAT = 358 * MiB, WS_ALORA = 390 * MiB, WS_LORA = 396 * MiB, WS_ORW = 444 * MiB;
constexpr size_t WS_Z = 160 * MiB, WS_H1 = 224 * MiB, WS_H1B = 288 * MiB, WS_SC = 390 * MiB;
constexpr size_t WS_END = 476 * MiB;
constexpr int SCAN_REC = 896;
constexpr int CW_BAR = 4096;
constexpr int RING_OFF = 0, RING_BYTES = 131072;
constexpr int LDSCTL_OFF = RING_BYTES, MISC_OFF = LDSCTL_OFF + 320;
constexpr int LDS_BYTES = 147456;

#define GAS __attribute__((address_space(1)))
#define LAS __attribute__((address_space(3)))
typedef unsigned short bf16;
typedef unsigned v4u __attribute__((ext_vector_type(4)));
typedef float f32x4 __attribute__((ext_vector_type(4)));
typedef float f32x2 __attribute__((ext_vector_type(2)));
typedef _Float16 h16x2 __attribute__((ext_vector_type(2)));
typedef __bf16 bf16x2v __attribute__((ext_vector_type(2)));
typedef GAS unsigned gu32;
#define RLX_AGENT __ATOMIC_RELAXED, __HIP_MEMORY_SCOPE_AGENT
#define LDS_WAIT() asm volatile("s_waitcnt lgkmcnt(0)" ::: "memory")
#define VM_WAIT() asm volatile("s_waitcnt vmcnt(0)" ::: "memory")
__device__ __forceinline__ unsigned f2bf(float f) { unsigned u = __builtin_bit_cast(unsigned, f); return (u + 0x7fffu + ((u >> 16) & 1u)) >> 16; }
__device__ __forceinline__ unsigned pk2(float lo, float hi) { return f2bf(lo) | (f2bf(hi) << 16); }
__device__ __forceinline__ float bflo(unsigned w) { return __uint_as_float(w << 16); }
__device__ __forceinline__ float bfhi(unsigned w) { return __uint_as_float(w & 0xffff0000u); }
__device__ __forceinline__ float bf1(bf16 h) { return __uint_as_float((unsigned)h << 16); }
__device__ __forceinline__ unsigned pkh(float lo, float hi) { h16x2 v; v.x = (_Float16)lo; v.y = (_Float16)hi; return __builtin_bit_cast(unsigned, v); }
__device__ __forceinline__ float hlo(unsigned w) { return (float)__builtin_bit_cast(h16x2, w).x; }
__device__ __forceinline__ float hhi(unsigned w) { return (float)__builtin_bit_cast(h16x2, w).y; }
__device__ __forceinline__ float wave_sum(float v) {
#pragma unroll
    for (int o = 1; o < 64; o <<= 1) v += __shfl_xor(v, o);
    return v;
}
using pg8::gelu_tanh; using pg8::sigmoidf; using pg8::pack8;

#define XB_TMO      128
#define XB_XCNT(j)  (256  + 64 * (j))
#define XB_XSUB(j)  (1280 + 64 * (j))
#define XB_XGEN(j)  (2304 + 64 * (j))
#define XB_TOP      3328
#define XB_TOPGEN   3392
#define XCD_BAR_WORDS 3456
#define XB_SPIN_CAP (1u << 18)

__device__ __forceinline__ unsigned xb_ld(unsigned* p)              { return __hip_atomic_load(p, __ATOMIC_RELAXED, __HIP_MEMORY_SCOPE_AGENT); }
__device__ __forceinline__ unsigned xb_add(unsigned* p, unsigned v) { return __hip_atomic_fetch_add(p, v, __ATOMIC_RELAXED, __HIP_MEMORY_SCOPE_AGENT); }
__device__ __forceinline__ unsigned xb_xcc_id() { return (unsigned)__builtin_amdgcn_s_getreg((3 << 11) | 20) & 0xFu; }
#define XB_SPIN(cond, bar) do { unsigned _sp = 0; while (cond) { __builtin_amdgcn_s_sleep(1); \
    if ((++_sp & 255u) == 0u) { if (xb_ld(&(bar)[XB_TMO])) break; if (_sp > XB_SPIN_CAP) { atomicAdd(&(bar)[XB_TMO], 1u); break; } } } } while (0)

struct XcdBarrier {
    unsigned* bar; unsigned x;
    volatile LAS unsigned* st;
};

__device__ __forceinline__ XcdBarrier xcd_barrier_post(unsigned* bar, volatile LAS unsigned* st) {
    XcdBarrier b; b.bar = bar; b.x = xb_xcc_id(); b.st = st;
    if (threadIdx.x == 0) (void)xb_add(&bar[XB_XCNT(b.x)], 1u);
    return b;
}
__device__ __forceinline__ void xcd_barrier_complete(unsigned* bar, unsigned x, unsigned& nloc, unsigned& nx) {
    const unsigned G = gridDim.x * gridDim.y * gridDim.z;
    unsigned sum, cnt, mine, sp = 0u;
    for (;;) {
        sum = 0u; cnt = 0u; mine = 0u;
#pragma unroll
        for (unsigned j = 0; j < 16; ++j) { const unsigned c = xb_ld(&bar[XB_XCNT(j)]); sum += c; cnt += (c > 0u) ? 1u : 0u; mine = (j == x) ? c : mine; }
        if (sum == G) break;
        __builtin_amdgcn_s_sleep(1);
        if ((++sp & 255u) == 0u) { if (xb_ld(&bar[XB_TMO])) break; if (sp > XB_SPIN_CAP) { atomicAdd(&bar[XB_TMO], 1u); break; } }
    }
    nloc = mine > 0u ? mine : 1u; nx = cnt > 0u ? cnt : 1u;
}

__device__ __forceinline__ void xcd_barrier(const XcdBarrier& b) {
    asm volatile("s_waitcnt vmcnt(0)" ::: "memory");
    __syncthreads();
    if (threadIdx.x == 0) {
        unsigned* bar = b.bar;
        __builtin_amdgcn_s_waitcnt(0);
        unsigned nloc = b.st[0], nx = b.st[1];
        if (nloc == 0u) { xcd_barrier_complete(bar, b.x, nloc, nx); b.st[0] = nloc; b.st[1] = nx; }
        const unsigned old = xb_add(&bar[XB_XSUB(b.x)], 1u);
        const unsigned gen = old / nloc;
        if (old + 1u == (gen + 1u) * nloc) {
            __builtin_amdgcn_fence(__ATOMIC_RELEASE, "agent");
            asm volatile("s_waitcnt vmcnt(0)" ::: "memory");
            const unsigned og = xb_add(&bar[XB_TOP], 1u);
            const unsigned tg = og / nx;
            if (og + 1u == (tg + 1u) * nx) xb_add(&bar[XB_TOPGEN], 1u);
            else XB_SPIN(xb_ld(&bar[XB_TOPGEN]) == tg, bar);
            __builtin_amdgcn_fence(__ATOMIC_ACQUIRE, "agent");
            xb_add(&bar[XB_XGEN(b.x)], 1u);
            asm volatile("s_waitcnt vmcnt(0)" ::: "memory");
        } else {
            XB_SPIN(xb_ld(&bar[XB_XGEN(b.x)]) == gen, bar);
            __builtin_amdgcn_fence(__ATOMIC_ACQUIRE, "agent");
            asm volatile("s_waitcnt vmcnt(0)" ::: "memory");
        }
    }
    __syncthreads();
}

struct Args { const float* in[33]; float* out; unsigned char* ws; int ph_lo, ph_hi, li, pad; };
struct Frame {
    LAS unsigned char* lds;
    volatile LAS unsigned* MISC;
    gu32* ctl;
    int tid, lane, wave, bid, G;
};
enum { I_X = 0, I_WIN, I_LAMRE, I_LAMIM, I_LOGSTEP, I_BRE, I_BIM, I_CRE, I_CIM, I_SD, I_WGLU, I_BGLU, I_MU, I_W0, I_WUP, I_A0, I_AUP, I_GUP, I_KK, I_KA, I_RK, I_GNG, I_GNB,
       I_WOUT, I_LN1G, I_LN1B, I_WQ, I_KEYS1, I_KEYS2, I_PU, I_PV, I_LN2G, I_LN2B };

__device__ __forceinline__ void p0_transpose_item(const float* W, int K, int N, bf16* WT, int row_off, LAS float* scr, int item, int lane) {
    const int nblk = N / 32, kb = item / nblk, nb = item % nblk, k0 = 64 * kb, n0 = 32 * nb;
#pragma unroll 8
    for (int i = 0; i < 32; ++i) { const int kk = 2 * i + (lane >> 5); scr[kk * 33 + (lane & 31)] = W[(size_t)(k0 + kk) * N + n0 + (lane & 31)]; }
    LDS_WAIT(); asm volatile("" ::: "memory");
    const int c = lane & 7;
#pragma unroll
    for (int j = 0; j < 4; ++j) { const int n = (lane >> 3) + 8 * j; const LAS float* s = scr + (8 * c) * 33 + n;
        v4u o; o.x = pk2(s[0 * 33], s[1 * 33]); o.y = pk2(s[2 * 33], s[3 * 33]); o.z = pk2(s[4 * 33], s[5 * 33]); o.w = pk2(s[6 * 33], s[7 * 33]);
        *(GAS v4u*)(WT + (size_t)(row_off + n0 + n) * K + k0 + 8 * c) = o; }
    LDS_WAIT(); asm volatile("" ::: "memory");
}
__device__ __forceinline__ void cvt_stream(const float* src, bf16* dst, size_t n8, size_t gtid, size_t nt) {
    for (size_t i = gtid; i < n8; i += nt) { const f32x4 a = ((const f32x4*)src)[2 * i], b = ((const f32x4*)src)[2 * i + 1]; ((v4u*)dst)[i] = pack8(a, b); }
}

__device__ __forceinline__ void peer_tables(Frame& F, const Args& A) {
    const int gw = F.bid * NWAVES + F.wave, NGW = F.G * NWAVES, lane = F.lane;
    unsigned char* U8 = A.ws + WS_UTAB; unsigned char* V8 = A.ws + WS_VTAB; float* SU = (float*)(A.ws + WS_SU);
    for (int e = gw; e < 16384; e += NGW) {
        const f32x4* ur = (const f32x4*)(A.in[I_PU] + (size_t)e * D) + lane * 8; f32x4 x[8]; float am = 0.f;
#pragma unroll
        for (int i = 0; i < 8; ++i) { x[i] = ur[i]; am = fmaxf(am, fmaxf(fmaxf(fabsf(x[i].x), fabsf(x[i].y)), fmaxf(fabsf(x[i].z), fabsf(x[i].w)))); }
#pragma unroll
        for (int o = 1; o < 64; o <<= 1) am = fmaxf(am, __shfl_xor(am, o));
        const float sc = (am > 0.f) ? am * (1.f / 127.f) : 1.f, inv = 1.f / sc;
        if (lane == 0) SU[e] = sc;
        v4u q0, q1;
#pragma unroll
        for (int i = 0; i < 8; ++i) { const int a = (int)rintf(x[i].x * inv), b = (int)rintf(x[i].y * inv), c = (int)rintf(x[i].z * inv), d = (int)rintf(x[i].w * inv);
            const unsigned w = (unsigned)(a & 255) | ((unsigned)(b & 255) << 8) | ((unsigned)(c & 255) << 16) | ((unsigned)(d & 255) << 24);
            if (i < 4) q0[i] = w; else q1[i - 4] = w; }
        v4u* ud = (v4u*)(U8 + (size_t)e * D) + lane * 2; ud[0] = q0; ud[1] = q1;
        const f32x4* vr = (const f32x4*)(A.in[I_PV] + (size_t)e * D) + lane * 8; v4u p0, p1;
#pragma unroll
        for (int i = 0; i < 8; ++i) { const f32x4 y = vr[i]; int w = 0; w = __builtin_amdgcn_cvt_pk_fp8_f32(y.x, y.y, w, false); w = __builtin_amdgcn_cvt_pk_fp8_f32(y.z, y.w, w, true);
            if (i < 4) p0[i] = (unsigned)w; else p1[i - 4] = (unsigned)w; }
        v4u* vd = (v4u*)(V8 + (size_t)e * D) + lane * 2; vd[0] = p0; vd[1] = p1;
    }
}

__device__ __forceinline__ void p0_prologue(Frame& F, const Args& A) {
    unsigned char* ws = A.ws;
    const size_t gtid = (size_t)F.bid * 512 + F.tid, NT = (size_t)F.G * 512;
    const int gw = F.bid * NWAVES + F.wave, NGW = F.G * NWAVES;
    if (F.bid < 64) {
        const int g = F.bid, tid = F.tid;
        LAS f32x2* AP = (LAS f32x2*)(F.lds);
        LAS f32x2* BB = (LAS f32x2*)(F.lds + 16896);
        LAS float* KJ = (LAS float*)(F.lds + 16896 + 8192);
        const float* lam_re = A.in[I_LAMRE] + g * 64; const float* lam_im = A.in[I_LAMIM] + g * 64;
        const float step = __expf(A.in[I_LOGSTEP][g]);
        for (int idx = tid; idx < 33 * 64; idx += 512) { const int j = idx >> 6, p = idx & 63; const float lr = lam_re[p], li = lam_im[p];
            const float mag = __expf(lr * step * (float)j); float rev = (li * step * 0.15915494309f) * (float)j; rev -= floorf(rev);
            AP[idx] = (f32x2){mag * __builtin_amdgcn_cosf(rev), mag * __builtin_amdgcn_sinf(rev)}; }
        LDS_WAIT(); __syncthreads();
        for (int idx = tid; idx < 64 * 16; idx += 512) { const int p = idx >> 4, h = idx & 15; const float lr = lam_re[p], li = lam_im[p]; const f32x2 a = AP[64 + p];
            const float den = lr * lr + li * li, fr = ((a.x - 1.f) * lr + a.y * li) / den, fi = (a.y * lr - (a.x - 1.f) * li) / den;
            const float br = A.in[I_BRE][(g * 64 + p) * 16 + h], bi = A.in[I_BIM][(g * 64 + p) * 16 + h];
            BB[idx] = (f32x2){fr * br - fi * bi, fr * bi + fi * br}; }
        if (tid < 64) { const f32x2 a = AP[32 * 64 + tid]; float* a32 = (float*)(ws + WS_A32); a32[(g * 64 + tid) * 2] = a.x; a32[(g * 64 + tid) * 2 + 1] = a.y; }
        LDS_WAIT(); __syncthreads();
        const float* cre = A.in[I_CRE] + (size_t)g * 16 * 64; const float* cim = A.in[I_CIM] + (size_t)g * 16 * 64;
        for (int idx = tid; idx < 32 * 256; idx += 512) { const int j = idx >> 8, h = (idx >> 4) & 15, hp = idx & 15; float s = 0.f;
            for (int p = 0; p < 64; ++p) { const f32x2 a = AP[j * 64 + p], bb = BB[p * 16 + hp]; const float wr = a.x * bb.x - a.y * bb.y, wi = a.x * bb.y + a.y * bb.x;
                s += cre[h * 64 + p] * wr - cim[h * 64 + p] * wi; }
            KJ[idx] = s; }
        LDS_WAIT(); __syncthreads();
        bf16* Gt = (bf16*)(ws + WS_G); bf16* MT = (bf16*)(ws + WS_MT);
        for (int it = tid; it < 8192; it += 512) { const int row = it >> 6, cb = (it & 63) * 8, s = cb >> 4, h0 = cb & 15, p = row & 63, im = row >> 6; const f32x2 a = AP[(31 - s) * 64 + p];
            float v[8];
#pragma unroll
            for (int e = 0; e < 8; ++e) { const f32x2 bb = BB[p * 16 + h0 + e]; v[e] = im ? (a.x * bb.y + a.y * bb.x) : (a.x * bb.x - a.y * bb.y); }
            v4u o; o.x = pk2(v[0], v[1]); o.y = pk2(v[2], v[3]); o.z = pk2(v[4], v[5]); o.w = pk2(v[6], v[7]);
            *(v4u*)(Gt + (size_t)(g * 128 + row) * 512 + cb) = o; }
        const float* dsk = A.in[I_SD] + g * 16;
        for (int it = tid; it < 40960; it += 512) { const int n = it / 80, kb = (it % 80) * 8, t = n >> 4, h = n & 15; float v[8];
            if (kb < 512) { const int s = kb >> 4, h0 = kb & 15;
#pragma unroll
                for (int e = 0; e < 8; ++e) { const int hp = h0 + e; float x = 0.f; if (s <= t) { x = KJ[(t - s) * 256 + h * 16 + hp]; if (s == t && hp == h) x += dsk[h]; } v[e] = x; } }
            else { const int p0 = (kb < 576) ? (kb - 512) : (kb - 576);
#pragma unroll
                for (int e = 0; e < 8; ++e) { const int p = p0 + e; const f32x2 a = AP[(t + 1) * 64 + p]; const float cr = cre[h * 64 + p], ci = cim[h * 64 + p];
                    v[e] = (kb < 576) ? (cr * a.x - ci * a.y) : -(cr * a.y + ci * a.x); } }
            v4u o; o.x = pk2(v[0], v[1]); o.y = pk2(v[2], v[3]); o.z = pk2(v[4], v[5]); o.w = pk2(v[6], v[7]);
            *(v4u*)(MT + (size_t)(g * 512 + n) * 640 + kb) = o; }
        LDS_WAIT(); __syncthreads();
    }
    cvt_stream(A.in[I_X], (bf16*)(ws + WS_XB), (size_t)M * D / 8, gtid, NT);
    peer_tables(F, A);
    {
        LAS float* scr = (LAS float*)(F.lds + RING_OFF + F.wave * 16384);
        constexpr int I_IN = (2048 / 64) * (INC / 32), I_GL = (1024 / 64) * (1024 / 32), I_OU = (2048 / 64) * (2048 / 32);
        for (int it = gw; it < I_IN + I_GL + I_OU; it += NGW) { int r = it;
            if (r < I_IN) { p0_transpose_item(A.in[I_WIN], 2048, INC, (bf16*)(ws + WS_WIN), 0, scr, r, F.lane); continue; } r -= I_IN;
            if (r < I_GL) { p0_transpose_item(A.in[I_WGLU], 1024, 1024, (bf16*)(ws + WS_WGLU), 0, scr, r, F.lane); continue; } r -= I_GL;
            p0_transpose_item(A.in[I_WOUT], 2048, 2048, (bf16*)(ws + WS_WOUT), 0, scr, r, F.lane); }
        v4u* z = (v4u*)((bf16*)(ws + WS_WIN) + (size_t)INC * 2048);
        for (size_t i = gtid; i < (size_t)(INP - INC) * 2048 / 8; i += NT) z[i] = (v4u){0u, 0u, 0u, 0u};
    }
    {
        bf16* WL = (bf16*)(ws + WS_WLORA);
        for (size_t i = gtid; i < (size_t)3072 * 384; i += NT) { const int n = (int)(i / 384), k = (int)(i % 384); float v = 0.f;
            if (n < 1024) { if (k < 64) v = A.in[I_WUP][k * 1024 + n]; }
            else if (n < 2048) { if (k >= 64 && k < 128) v = A.in[I_AUP][(k - 64) * 1024 + (n - 1024)]; }
            else { if (k >= 128 && k < 288) v = A.in[I_GUP][(k - 128) * 1024 + (n - 2048)]; }
            WL[i] = (bf16)f2bf(v); }
    }
    __syncthreads();
    {
        LAS float* Ks = (LAS float*)(F.lds); LAS float* Ws = (LAS float*)(F.lds + 128 * 129 * 4);
        bf16* WQK = (bf16*)(ws + WS_WQK); const int tid = F.tid;
        for (int unit = F.bid; unit < 512; unit += F.G) { const int hj = unit >> 5, dblk = unit & 31, h = hj >> 1, j = hj & 1;
            const float* keys = (j ? A.in[I_KEYS2] : A.in[I_KEYS1]) + (size_t)h * 128 * 128;
            for (int idx = tid; idx < 16384; idx += 512) Ks[(idx >> 7) * 129 + (idx & 127)] = keys[idx];
            for (int idx = tid; idx < 8192; idx += 512) Ws[(idx >> 7) * 129 + (idx & 127)] = A.in[I_WQ][(size_t)(dblk * 64 + (idx >> 7)) * 2048 + hj * 128 + (idx & 127)];
            LDS_WAIT(); __syncthreads();
            const int key = tid & 127, dq = tid >> 7; float acc[16];
#pragma unroll
            for (int i = 0; i < 16; ++i) acc[i] = 0.f;
            for (int c = 0; c < 128; ++c) { const float a = Ks[key * 129 + c];
#pragma unroll
                for (int i = 0; i < 16; ++i) acc[i] += a * Ws[(dq * 16 + i) * 129 + c]; }
            v4u o0, o1; o0.x = pk2(acc[0], acc[1]); o0.y = pk2(acc[2], acc[3]); o0.z = pk2(acc[4], acc[5]); o0.w = pk2(acc[6], acc[7]);
            o1.x = pk2(acc[8], acc[9]); o1.y = pk2(acc[10], acc[11]); o1.z = pk2(acc[12], acc[13]); o1.w = pk2(acc[14], acc[15]);
            v4u* dst = (v4u*)(WQK + (size_t)(hj * 128 + key) * 2048 + dblk * 64 + dq * 16); dst[0] = o0; dst[1] = o1;
            LDS_WAIT(); __syncthreads(); }
    }
}

__device__ __forceinline__ void r1_lora_in(Frame& F, const Args& A) {
    const bf16* PRW = (const bf16*)(A.ws + WS_PRW); bf16* AL = (bf16*)(A.ws + WS_ALORA); const float* mu = A.in[I_MU];
    const int gw = F.bid * NWAVES + F.wave, NGW = F.G * NWAVES;
    for (int m = gw; m < M; m += NGW) { const int t = m & (SEQ - 1);
#pragma unroll
        for (int q = 0; q < 6; ++q) { const int idx = q * 64 + F.lane; float val = 0.f;
            if (idx < 288) { const int col = 3072 + idx; const float cur = bf1(PRW[(size_t)m * 3584 + col]); const float prev = (t > 0) ? bf1(PRW[(size_t)(m - 1) * 3584 + col]) : 0.f;
                const float s = cur + mu[col] * (prev - cur);
                val = (idx < 64) ? (1.f - 2.f / (1.f + __expf(2.f * s))) : ((idx < 128) ? s : sigmoidf(s)); }
            AL[(size_t)m * 384 + idx] = (bf16)f2bf(val); } }
}

__device__ __forceinline__ void r3_prep(Frame& F, const Args& A) {
    const bf16* PRW = (const bf16*)(A.ws + WS_PRW); const bf16* LO = (const bf16*)(A.ws + WS_LORA); unsigned char* SC = A.ws + WS_SCAN;
    const float* mu = A.in[I_MU]; const int lane = F.lane, head = lane >> 2, j0 = (lane & 3) * 16, ch = lane * 16;
    const int gw = F.bid * NWAVES + F.wave, NGW = F.G * NWAVES;
    for (int m = gw; m < M; m += NGW) { const int t = m & (SEQ - 1), b = m >> 11;
        float rs[16], ks[16], vs[16];
#pragma unroll
        for (int part = 0; part < 3; ++part) { const int col = part * 1024 + ch; const v4u c0 = *(const v4u*)(PRW + (size_t)m * 3584 + col), c1 = *(const v4u*)(PRW + (size_t)m * 3584 + col + 8);
            v4u p0 = (v4u){0u, 0u, 0u, 0u}, p1 = p0; if (t > 0) { p0 = *(const v4u*)(PRW + (size_t)(m - 1) * 3584 + col); p1 = *(const v4u*)(PRW + (size_t)(m - 1) * 3584 + col + 8); }
            float cu[16], pr[16];
#pragma unroll
            for (int e = 0; e < 4; ++e) { cu[2 * e] = bflo(c0[e]); cu[2 * e + 1] = bfhi(c0[e]); cu[8 + 2 * e] = bflo(c1[e]); cu[8 + 2 * e + 1] = bfhi(c1[e]);
                pr[2 * e] = bflo(p0[e]); pr[2 * e + 1] = bfhi(p0[e]); pr[8 + 2 * e] = bflo(p1[e]); pr[8 + 2 * e + 1] = bfhi(p1[e]); }
#pragma unroll
            for (int e = 0; e < 16; ++e) { const float s = cu[e] + mu[col + e] * (pr[e] - cu[e]); if (part == 0) rs[e] = s; else if (part == 1) ks[e] = s; else vs[e] = s; } }
        const v4u wl0 = *(const v4u*)(LO + (size_t)m * 3072 + ch), wl1 = *(const v4u*)(LO + (size_t)m * 3072 + ch + 8);
        const v4u al0 = *(const v4u*)(LO + (size_t)m * 3072 + 1024 + ch), al1 = *(const v4u*)(LO + (size_t)m * 3072 + 1024 + ch + 8);
        float wl[16], al[16];
#pragma unroll
        for (int e = 0; e < 4; ++e) { wl[2 * e] = bflo(wl0[e]); wl[2 * e + 1] = bfhi(wl0[e]); wl[8 + 2 * e] = bflo(wl1[e]); wl[8 + 2 * e + 1] = bfhi(wl1[e]);
            al[2 * e] = bflo(al0[e]); al[2 * e + 1] = bfhi(al0[e]); al[8 + 2 * e] = bflo(al1[e]); al[8 + 2 * e + 1] = bfhi(al1[e]); }
        float dec[16], kp[16], kk[16], aa[16]; float n2 = 0.f;
#pragma unroll
        for (int e = 0; e < 16; ++e) { const float x = A.in[I_W0][ch + e] + wl[e]; const float y = -x; const float sp = fmaxf(y, 0.f) + __logf(1.f + __expf(-fabsf(y)));
            const float w = -sp - 0.5f; dec[e] = __expf(-__expf(w));
            const float a = sigmoidf(A.in[I_A0][ch + e] + al[e]); aa[e] = a;
            kk[e] = ks[e] * A.in[I_KK][ch + e]; n2 += kk[e] * kk[e];
            kp[e] = ks[e] * (1.f + (a - 1.f) * A.in[I_KA][ch + e]); }
        n2 += __shfl_xor(n2, 1); n2 += __shfl_xor(n2, 2);
        const float inv = 1.f / fmaxf(sqrtf(n2), 1e-12f);
        unsigned char* rec = SC + ((size_t)(b * 16 + head) * SEQ + t) * SCAN_REC;
#pragma unroll
        for (int q = 0; q < 4; ++q) { unsigned char* pj = rec + ((lane & 3) * 4 + q) * 48;
            *(f32x4*)pj = (f32x4){dec[4 * q], dec[4 * q + 1], dec[4 * q + 2], dec[4 * q + 3]};
            v4u o; o.x = pkh(rs[4 * q], rs[4 * q + 1]); o.y = pkh(rs[4 * q + 2], rs[4 * q + 3]); o.z = pkh(kp[4 * q], kp[4 * q + 1]); o.w = pkh(kp[4 * q + 2], kp[4 * q + 3]); *(v4u*)(pj + 16) = o;
            const float k0 = kk[4 * q] * inv, k1 = kk[4 * q + 1] * inv, k2 = kk[4 * q + 2] * inv, k3 = kk[4 * q + 3] * inv;
            v4u o2; o2.x = pkh(k0, k1); o2.y = pkh(k2, k3); o2.z = pkh(k0 * aa[4 * q], k1 * aa[4 * q + 1]); o2.w = pkh(k2 * aa[4 * q + 2], k3 * aa[4 * q + 3]); *(v4u*)(pj + 32) = o2; }
        v4u v0, v1; v0.x = pkh(vs[0], vs[1]); v0.y = pkh(vs[2], vs[3]); v0.z = pkh(vs[4], vs[5]); v0.w = pkh(vs[6], vs[7]);
        v1.x = pkh(vs[8], vs[9]); v1.y = pkh(vs[10], vs[11]); v1.z = pkh(vs[12], vs[13]); v1.w = pkh(vs[14], vs[15]);
        *(v4u*)(rec + 768 + j0 * 2) = v0; *(v4u*)(rec + 768 + j0 * 2 + 16) = v1; }
}

__device__ __forceinline__ float dpp_f(float v, const int ctrl_sel) {
    const int iv = __builtin_bit_cast(int, v); int r;
    switch (ctrl_sel) { case 0: r = __builtin_amdgcn_update_dpp(0, iv, 0xB1, 0xf, 0xf, false); break;
                        case 1: r = __builtin_amdgcn_update_dpp(0, iv, 0x4E, 0xf, 0xf, false); break;
                        case 2: r = __builtin_amdgcn_update_dpp(0, iv, 0x141, 0xf, 0xf, false); break;
                        default: r = __builtin_amdgcn_update_dpp(0, iv, 0x140, 0xf, 0xf, false); break; }
    return __builtin_bit_cast(float, r);
}
__device__ __forceinline__ float allsum16(float x) { x += dpp_f(x, 0); x += dpp_f(x, 1); x += dpp_f(x, 2); x += dpp_f(x, 3); return x; }
constexpr int SCH = 32, SCH_BYTES = SCH * SCAN_REC, SCH_PIECES = SCH_BYTES / 16;
__device__ __forceinline__ void r4_scan(Frame& F, const Args& A) {
    if (F.bid >= 128) return;
    const int bh = F.bid >> 1, half = F.bid & 1, lane = F.lane, tid = F.tid, rl = lane >> 4, jg = lane & 15, row = half * 32 + F.wave * 4 + rl;
    const unsigned char* gbase = A.ws + WS_SCAN + (size_t)bh * SEQ * SCAN_REC;
    float* O = (float*)(A.ws + WS_ORW) + (size_t)(bh >> 4) * SEQ * 1024 + (bh & 15) * 64 + row;
    float S0 = 0.f, S1 = 0.f, S2 = 0.f, S3 = 0.f;
    v4u st0, st1, st2, st3;
#define SC_GLOAD(c) do { const unsigned char* g_ = gbase + (size_t)(c) * SCH_BYTES + tid * 16; st0 = *(const v4u*)g_; st1 = *(const v4u*)(g_ + 8192); st2 = *(const v4u*)(g_ + 16384); \
        if (tid < SCH_PIECES - 1536) st3 = *(const v4u*)(g_ + 24576); } while (0)
#define SC_LWRITE(b) do { LAS unsigned char* l_ = F.lds + (b) * SCH_BYTES + tid * 16; *(LAS v4u*)l_ = st0; *(LAS v4u*)(l_ + 8192) = st1; *(LAS v4u*)(l_ + 16384) = st2; \
        if (tid < SCH_PIECES - 1536) *(LAS v4u*)(l_ + 24576) = st3; } while (0)
    SC_GLOAD(0); SC_LWRITE(0); SC_GLOAD(1);
    for (int c = 0; c < SEQ / SCH; ++c) {
        LDS_WAIT(); __syncthreads();
        if (c + 1 < SEQ / SCH) SC_LWRITE((c + 1) & 1);
        if (c + 2 < SEQ / SCH) SC_GLOAD(c + 2);
        const LAS unsigned char* cb = F.lds + (c & 1) * SCH_BYTES;
        for (int s4 = 0; s4 < SCH; s4 += 16) { float keep = 0.f;
#pragma unroll
            for (int u = 0; u < 16; ++u) { const LAS unsigned char* p = cb + (s4 + u) * SCAN_REC;
                const f32x4 dec = *(const LAS f32x4*)(p + jg * 48); const v4u rk = *(const LAS v4u*)(p + jg * 48 + 16), kb = *(const LAS v4u*)(p + jg * 48 + 32);
                const float v = (float)__builtin_bit_cast(_Float16, *(const LAS unsigned short*)(p + 768 + row * 2));
                const float r0 = hlo(rk.x), r1 = hhi(rk.x), r2 = hlo(rk.y), r3 = hhi(rk.y), k0 = hlo(rk.z), k1 = hhi(rk.z), k2 = hlo(rk.w), k3 = hhi(rk.w);
                const float c0 = hlo(kb.x), c1 = hhi(kb.x), c2 = hlo(kb.y), c3 = hhi(kb.y), b0 = hlo(kb.z), b1 = hhi(kb.z), b2 = hlo(kb.w), b3 = hhi(kb.w);
                float sa = (S0 * c0 + S1 * c1) + (S2 * c2 + S3 * c3); sa = allsum16(sa);
                S0 = S0 * dec[0] - sa * b0 + v * k0; S1 = S1 * dec[1] - sa * b1 + v * k1; S2 = S2 * dec[2] - sa * b2 + v * k2; S3 = S3 * dec[3] - sa * b3 + v * k3;
                float o = (S0 * r0 + S1 * r1) + (S2 * r2 + S3 * r3); o = allsum16(o);
                keep = (jg == u) ? o : keep; }
            O[(size_t)(c * SCH + s4 + jg) * 1024] = keep; }
    }
#undef SC_GLOAD
#undef SC_LWRITE
}

__device__ __forceinline__ void r5_post(Frame& F, const Args& A) {
    const float* ORW = (const float*)(A.ws + WS_ORW); const bf16* LO = (const bf16*)(A.ws + WS_LORA); const unsigned char* SC = A.ws + WS_SCAN; bf16* CAT = (bf16*)(A.ws + WS_CAT);
    const int lane = F.lane, head = lane >> 2, j0 = (lane & 3) * 16, ch = lane * 16;
    const int gw = F.bid * NWAVES + F.wave, NGW = F.G * NWAVES;
    for (int m = gw; m < M; m += NGW) { const int t = m & (SEQ - 1), b = m >> 11;
        float o[16];
#pragma unroll
        for (int q = 0; q < 4; ++q) { const f32x4 x = *(const f32x4*)(ORW + (size_t)m * 1024 + ch + 4 * q); o[4 * q] = x[0]; o[4 * q + 1] = x[1]; o[4 * q + 2] = x[2]; o[4 * q + 3] = x[3]; }
        float s = 0.f;
#pragma unroll
        for (int e = 0; e < 16; ++e) s += o[e];
        s += __shfl_xor(s, 1); s += __shfl_xor(s, 2); const float mean = s * (1.f / 64.f); float q2 = 0.f;
#pragma unroll
        for (int e = 0; e < 16; ++e) { const float d = o[e] - mean; q2 += d * d; }
        q2 += __shfl_xor(q2, 1); q2 += __shfl_xor(q2, 2); const float rstd = 1.f / sqrtf(q2 * (1.f / 64.f) + GN_EPS);
        const unsigned char* rec = SC + ((size_t)(b * 16 + head) * SEQ + t) * SCAN_REC; float dp = 0.f;
#pragma unroll
        for (int q = 0; q < 4; ++q) { const v4u rk = *(const v4u*)(rec + ((lane & 3) * 4 + q) * 48 + 16); const float* rkp = A.in[I_RK] + head * 64 + j0 + 4 * q;
            dp += hlo(rk.x) * hlo(rk.z) * rkp[0] + hhi(rk.x) * hhi(rk.z) * rkp[1] + hlo(rk.y) * hlo(rk.w) * rkp[2] + hhi(rk.y) * hhi(rk.w) * rkp[3]; }
        dp += __shfl_xor(dp, 1); dp += __shfl_xor(dp, 2);
        const v4u v0 = *(const v4u*)(rec + 768 + j0 * 2), v1 = *(const v4u*)(rec + 768 + j0 * 2 + 16);
        const v4u g0 = *(const v4u*)(LO + (size_t)m * 3072 + 2048 + ch), g1 = *(const v4u*)(LO + (size_t)m * 3072 + 2048 + ch + 8);
        float vv[16], gg[16];
#pragma unroll
        for (int e = 0; e < 4; ++e) { vv[2 * e] = hlo(v0[e]); vv[2 * e + 1] = hhi(v0[e]); vv[8 + 2 * e] = hlo(v1[e]); vv[8 + 2 * e + 1] = hhi(v1[e]);
            gg[2 * e] = bflo(g0[e]); gg[2 * e + 1] = bfhi(g0[e]); gg[8 + 2 * e] = bflo(g1[e]); gg[8 + 2 * e + 1] = bfhi(g1[e]); }
        float r[16];
#pragma unroll
        for (int e = 0; e < 16; ++e) r[e] = ((o[e] - mean) * rstd * A.in[I_GNG][ch + e] + A.in[I_GNB][ch + e] + dp * vv[e]) * gg[e];
        v4u w0, w1; w0.x = pk2(r[0], r[1]); w0.y = pk2(r[2], r[3]); w0.z = pk2(r[4], r[5]); w0.w = pk2(r[6], r[7]); w1.x = pk2(r[8], r[9]); w1.y = pk2(r[10], r[11]); w1.z = pk2(r[12], r[13]); w1.w = pk2(r[14], r[15]);
        *(v4u*)(CAT + (size_t)m * 2048 + 1024 + ch) = w0; *(v4u*)(CAT + (size_t)m * 2048 + 1024 + ch + 8) = w1; }
}

__device__ __forceinline__ void ln1_rows(Frame& F, const Args& A) {
    const float* Z = (const float*)(A.ws + WS_Z); float* H1 = (float*)(A.ws + WS_H1); bf16* H1B = (bf16*)(A.ws + WS_H1B);
    const int gw = F.bid * NWAVES + F.wave, NGW = F.G * NWAVES, lane = F.lane;
    for (int m = gw; m < M; m += NGW) { const f32x4* zr = (const f32x4*)(Z + (size_t)m * D) + lane; f32x4 v[8]; float s = 0.f;
#pragma unroll
        for (int j = 0; j < 8; ++j) { v[j] = zr[64 * j]; s += (v[j].x + v[j].y) + (v[j].z + v[j].w); }
        const float mean = wave_sum(s) * (1.f / D); float s2 = 0.f;
#pragma unroll
        for (int j = 0; j < 8; ++j) { v[j] = v[j] - mean; s2 += (v[j].x * v[j].x + v[j].y * v[j].y) + (v[j].z * v[j].z + v[j].w * v[j].w); }
        const float rstd = 1.f / sqrtf(wave_sum(s2) * (1.f / D) + LN_EPS);
#pragma unroll
        for (int j = 0; j < 8; ++j) { const f32x4 g = ((const f32x4*)A.in[I_LN1G])[64 * j + lane], bb = ((const f32x4*)A.in[I_LN1B])[64 * j + lane]; const f32x4 y = v[j] * rstd * g + bb;
            ((f32x4*)(H1 + (size_t)m * D))[64 * j + lane] = y;
            unsigned long long pk = (unsigned long long)pk2(y.x, y.y) | ((unsigned long long)pk2(y.z, y.w) << 32); ((unsigned long long*)(H1B + (size_t)m * D))[64 * j + lane] = pk; } }
}

__device__ __forceinline__ void ins16(float (&tv)[16], float x) {
#pragma unroll
    for (int k = 15; k >= 1; --k) tv[k] = __builtin_amdgcn_fmed3f(tv[k - 1], tv[k], x);
    tv[0] = fmaxf(tv[0], x);
}
__device__ __forceinline__ void topk_phase(Frame& F, const Args& A) {
    const float* SCp = (const float*)(A.ws + WS_SC); int* IDX = (int*)(A.ws + WS_IDX); float* GATE = (float*)(A.ws + WS_GATE);
    LAS float* scr = (LAS float*)(F.lds + F.wave * 8448); LAS unsigned* scu = (LAS unsigned*)scr;
    const int gw = F.bid * NWAVES + F.wave, NGW = F.G * NWAVES, lane = F.lane;
    for (int grp = gw; grp < M / 4; grp += NGW) { const float* base = SCp + (size_t)grp * 4 * 2048;
        float tv[16];
#pragma unroll
        for (int k = 0; k < 16; ++k) tv[k] = -INFINITY;
        for (int q = 0; q < 4; ++q) {
#pragma unroll
            for (int k = 0; k < 8; ++k) { const int rowl = k * 8 + (lane >> 3), c4 = (lane & 7) * 4; const f32x4 x = *(const f32x4*)(base + rowl * 128 + q * 32 + c4);
                scr[rowl * 33 + c4] = x[0]; scr[rowl * 33 + c4 + 1] = x[1]; scr[rowl * 33 + c4 + 2] = x[2]; scr[rowl * 33 + c4 + 3] = x[3]; }
            LDS_WAIT(); asm volatile("" ::: "memory");
#pragma unroll
            for (int i = 0; i < 32; ++i) { const unsigned key = (scu[lane * 33 + i] & ~127u) | (unsigned)(q * 32 + i); ins16(tv, __uint_as_float(key)); }
            LDS_WAIT(); asm volatile("" ::: "memory");
        }
        const int jb = lane & 1; float Av[16], Bv[16];
#pragma unroll
        for (int k = 0; k < 16; ++k) { const float ot = __shfl_xor(tv[k], 1); Av[k] = jb ? ot : tv[k]; Bv[k] = jb ? tv[k] : ot; }
#pragma unroll
        for (int k = 0; k < 16; ++k) { scu[lane * 33 + k] = __float_as_uint(Av[k]) & 127u; scu[lane * 33 + 16 + k] = __float_as_uint(Bv[k]) & 127u; }
        float tw[16];
#pragma unroll
        for (int k = 0; k < 16; ++k) tw[k] = -INFINITY;
#define CROW(i, n) _Pragma("unroll") for (int jj = 0; jj < (n); ++jj) { const float c = Av[i] + Bv[jj]; ins16(tw, __uint_as_float((__float_as_uint(c) & ~255u) | (unsigned)((i) * 16 + jj))); }
        CROW(0, 16) CROW(1, 8) CROW(2, 5) CROW(3, 4) CROW(4, 3) CROW(5, 2) CROW(6, 2) CROW(7, 2) CROW(8, 1) CROW(9, 1) CROW(10, 1) CROW(11, 1) CROW(12, 1) CROW(13, 1) CROW(14, 1) CROW(15, 1)
#undef CROW
        LDS_WAIT(); asm volatile("" ::: "memory");
        float ex[16]; float sum = 0.f;
#pragma unroll
        for (int k = 0; k < 16; ++k) { ex[k] = __expf(tw[k] - tw[0]); sum += ex[k]; }
        const float rs = 1.f / sum; int eid[16];
#pragma unroll
        for (int k = 0; k < 16; ++k) { const unsigned pos = __float_as_uint(tw[k]) & 255u; const unsigned ia = scu[lane * 33 + (pos >> 4)], ib = scu[lane * 33 + 16 + (pos & 15u)]; eid[k] = (int)(ia * 128u + ib); }
        const int token = grp * 4 + (lane >> 4), head = (lane >> 1) & 7; const size_t ob = (size_t)token * 128 + head * 16;
        if (jb == 0) {
#pragma unroll
            for (int k = 0; k < 16; k += 4) { *(int4*)(IDX + ob + k) = make_int4(eid[k], eid[k + 1], eid[k + 2], eid[k + 3]); *(f32x4*)(GATE + ob + k) = (f32x4){ex[k] * rs, ex[k + 1] * rs, ex[k + 2] * rs, ex[k + 3] * rs}; } }
        LDS_WAIT(); asm volatile("" ::: "memory");
    }
}

constexpr int PR = 3, PSLOT = 4096 + 256, PEER_WAVE_LDS = 16384, PNT = 2, PNP = PNT * 128;
__device__ __forceinline__ int wave_sum_i32(int v) {
#pragma unroll
    for (int o = 1; o < 64; o <<= 1) v += __shfl_xor(v, o);
    return v;
}
__device__ __forceinline__ void peer_phase(Frame& F, const Args& A) {
    const float* H1 = (const float*)(A.ws + WS_H1); const unsigned char* U8 = A.ws + WS_UTAB; const unsigned char* V8 = A.ws + WS_VTAB; const float* SU = (const float*)(A.ws + WS_SU);
    const int* IDX = (const int*)(A.ws + WS_IDX); const float* GATE = (const float*)(A.ws + WS_GATE);
    const int gw = F.bid * NWAVES + F.wave, NGW = F.G * NWAVES;
    LAS unsigned char* wl = F.lds + F.wave * PEER_WAVE_LDS;
    LAS unsigned* list = (LAS unsigned*)(wl + PR * PSLOT);
    LAS unsigned* cnt = (LAS unsigned*)(wl + PR * PSLOT + 2048);
    for (int grp = gw; grp < M / PNT; grp += NGW) { const int tok0 = grp * PNT; int lane = (int)__builtin_amdgcn_mbcnt_hi(~0u, __builtin_amdgcn_mbcnt_lo(~0u, 0u)); asm volatile("" : "+v"(lane));
        cnt[lane] = 0u; cnt[64 + lane] = 0u;
        int ev[2 * PNT]; float gv[2 * PNT];
#pragma unroll
        for (int q = 0; q < 2 * PNT; ++q) { ev[q] = IDX[(size_t)(tok0 + (q >> 1)) * 128 + (q & 1) * 64 + lane]; gv[q] = GATE[(size_t)(tok0 + (q >> 1)) * 128 + (q & 1) * 64 + lane]; }
        LDS_WAIT(); asm volatile("" ::: "memory");
#pragma unroll
        for (int q = 0; q < 2 * PNT; ++q) __hip_atomic_fetch_add(cnt + (ev[q] >> 7), 1u, __ATOMIC_RELAXED, __HIP_MEMORY_SCOPE_WORKGROUP);
        LDS_WAIT(); asm volatile("" ::: "memory");
        { const unsigned a = cnt[2 * lane], b = cnt[2 * lane + 1]; unsigned inc = a + b;
#pragma unroll
          for (int o = 1; o < 64; o <<= 1) { const unsigned t = __shfl_up(inc, o); if (lane >= o) inc += t; }
          const unsigned ex = inc - (a + b); cnt[2 * lane] = ex; cnt[2 * lane + 1] = ex + a; }
        LDS_WAIT(); asm volatile("" ::: "memory");
#pragma unroll
        for (int q = 0; q < 2 * PNT; ++q) { const unsigned pos = __hip_atomic_fetch_add(cnt + (ev[q] >> 7), 1u, __ATOMIC_RELAXED, __HIP_MEMORY_SCOPE_WORKGROUP);
            const unsigned short gh = __builtin_bit_cast(unsigned short, (_Float16)gv[q]); list[pos] = (unsigned)ev[q] | ((unsigned)(q >> 1) << 14) | ((unsigned)gh << 16); }
        LDS_WAIT(); asm volatile("" ::: "memory");
        unsigned xq[PNT][8]; float sx[PNT];
#pragma unroll
        for (int k = 0; k < PNT; ++k) { const float* hr = H1 + (size_t)(tok0 + k) * D + lane * 16; f32x4 x[8]; float am = 0.f;
#pragma unroll
            for (int i = 0; i < 8; ++i) { x[i] = *(const f32x4*)(hr + (i >> 2) * 1024 + (i & 3) * 4); am = fmaxf(am, fmaxf(fmaxf(fabsf(x[i].x), fabsf(x[i].y)), fmaxf(fabsf(x[i].z), fabsf(x[i].w)))); }
#pragma unroll
            for (int o = 1; o < 64; o <<= 1) am = fmaxf(am, __shfl_xor(am, o));
            const float sc = (am > 0.f) ? am * (1.f / 127.f) : 1.f, inv = 1.f / sc; sx[k] = __builtin_bit_cast(float, __builtin_amdgcn_readfirstlane(__builtin_bit_cast(int, sc)));
#pragma unroll
            for (int i = 0; i < 8; ++i) { const int a = (int)rintf(x[i].x * inv), b = (int)rintf(x[i].y * inv), c = (int)rintf(x[i].z * inv), d = (int)rintf(x[i].w * inv);
                xq[k][i] = (unsigned)(a & 255) | ((unsigned)(b & 255) << 8) | ((unsigned)(c & 255) << 16) | ((unsigned)(d & 255) << 24); }
            asm volatile("" ::: "memory"); }
        float acc[PNT][32];
#pragma unroll
        for (int k = 0; k < PNT; ++k)
#pragma unroll
            for (int i = 0; i < 32; ++i) acc[k][i] = 0.f;
#define PEER_ISSUE(n) do { const unsigned ent_ = (unsigned)__builtin_amdgcn_readfirstlane((int)list[(n)]); const unsigned e_ = ent_ & 0x3fffu; LAS unsigned char* sl_ = wl + ((n) % PR) * PSLOT; \
        const unsigned char* up_ = U8 + (size_t)e_ * D + lane * 16; const unsigned char* vp_ = V8 + (size_t)e_ * D + lane * 16; \
        __builtin_amdgcn_global_load_lds((const unsigned*)up_, (LAS unsigned*)sl_, 16, 0, 0); __builtin_amdgcn_global_load_lds((const unsigned*)(up_ + 1024), (LAS unsigned*)(sl_ + 1024), 16, 0, 0); \
        __builtin_amdgcn_global_load_lds((const unsigned*)vp_, (LAS unsigned*)(sl_ + 2048), 16, 0, 0); __builtin_amdgcn_global_load_lds((const unsigned*)(vp_ + 1024), (LAS unsigned*)(sl_ + 3072), 16, 0, 0); \
        __builtin_amdgcn_global_load_lds((const unsigned*)(SU + e_), (LAS unsigned*)(sl_ + 4096), 4, 0, 0); } while (0)
#define PEER_CORE(k) do { int d_ = 0; \
        d_ = __builtin_amdgcn_sdot4((int)u0.x, (int)xq[k][0], d_, false); d_ = __builtin_amdgcn_sdot4((int)u0.y, (int)xq[k][1], d_, false); d_ = __builtin_amdgcn_sdot4((int)u0.z, (int)xq[k][2], d_, false); d_ = __builtin_amdgcn_sdot4((int)u0.w, (int)xq[k][3], d_, false); \
        d_ = __builtin_amdgcn_sdot4((int)u1.x, (int)xq[k][4], d_, false); d_ = __builtin_amdgcn_sdot4((int)u1.y, (int)xq[k][5], d_, false); d_ = __builtin_amdgcn_sdot4((int)u1.z, (int)xq[k][6], d_, false); d_ = __builtin_amdgcn_sdot4((int)u1.w, (int)xq[k][7], d_, false); \
        d_ = wave_sum_i32(d_); const float z_ = (float)d_ * su * sx[k]; const float s_ = gate * gelu_tanh(z_); \
        v4u v0 = v0_, v1 = v1_; asm volatile("" : "+v"(v0), "+v"(v1));     \
        _Pragma("unroll") for (int i = 0; i < 4; ++i) { const f32x2 a_ = __builtin_amdgcn_cvt_pk_f32_fp8((int)v0[i], false), b_ = __builtin_amdgcn_cvt_pk_f32_fp8((int)v0[i], true); \
            acc[k][4 * i] += s_ * a_.x; acc[k][4 * i + 1] += s_ * a_.y; acc[k][4 * i + 2] += s_ * b_.x; acc[k][4 * i + 3] += s_ * b_.y; } \
        _Pragma("unroll") for (int i = 0; i < 4; ++i) { const f32x2 a_ = __builtin_amdgcn_cvt_pk_f32_fp8((int)v1[i], false), b_ = __builtin_amdgcn_cvt_pk_f32_fp8((int)v1[i], true); \
            acc[k][16 + 4 * i] += s_ * a_.x; acc[k][16 + 4 * i + 1] += s_ * a_.y; acc[k][16 + 4 * i + 2] += s_ * b_.x; acc[k][16 + 4 * i + 3] += s_ * b_.y; } } while (0)
        PEER_ISSUE(0); PEER_ISSUE(1);
        for (int n = 0; n < PNP; ++n) {
            if (n + PR - 1 < PNP) { PEER_ISSUE(n + PR - 1); asm volatile("s_waitcnt vmcnt(10)" ::: "memory"); }
            else asm volatile("s_waitcnt vmcnt(0)" ::: "memory");
            const LAS unsigned char* sl = wl + (n % PR) * PSLOT;
            const v4u u0 = *(const LAS v4u*)(sl + lane * 16), u1 = *(const LAS v4u*)(sl + 1024 + lane * 16), v0_ = *(const LAS v4u*)(sl + 2048 + lane * 16), v1_ = *(const LAS v4u*)(sl + 3072 + lane * 16);
            const float su = __builtin_bit_cast(float, __builtin_amdgcn_readfirstlane(*(const LAS int*)(sl + 4096))); const unsigned ent = (unsigned)__builtin_amdgcn_readfirstlane((int)list[n]);
            LDS_WAIT(); asm volatile("" ::: "memory");
            const int tk = (int)((ent >> 14) & 3u); const float gate = (float)__builtin_bit_cast(_Float16, (unsigned short)(ent >> 16));
            if (tk == 0) PEER_CORE(0); else PEER_CORE(1);
        }
#undef PEER_ISSUE
#undef PEER_CORE
        asm volatile("" : "+v"(lane));
#pragma unroll
        for (int k = 0; k < PNT; ++k) { const size_t ro = (size_t)(tok0 + k) * D + lane * 16; float y[32]; float s1 = 0.f;
#pragma unroll
            for (int i = 0; i < 8; ++i) { const f32x4 h = *(const f32x4*)(H1 + ro + (i >> 2) * 1024 + (i & 3) * 4);
#pragma unroll
                for (int c = 0; c < 4; ++c) { y[4 * i + c] = ALPHA * h[c] + acc[k][4 * i + c]; s1 += y[4 * i + c]; } }
            const float mean = wave_sum(s1) * (1.f / D); float s2 = 0.f;
#pragma unroll
            for (int i = 0; i < 32; ++i) { y[i] -= mean; s2 += y[i] * y[i]; }
            const float rstd = 1.f / sqrtf(wave_sum(s2) * (1.f / D) + LN_EPS);
#pragma unroll
            for (int i = 0; i < 8; ++i) { const int co = lane * 16 + (i >> 2) * 1024 + (i & 3) * 4; const f32x4 g = *(const f32x4*)(A.in[I_LN2G] + co), bb = *(const f32x4*)(A.in[I_LN2B] + co); f32x4 r;
#pragma unroll
                for (int c = 0; c < 4; ++c) r[c] = y[4 * i + c] * rstd * g[c] + bb[c];
                *(f32x4*)(A.out + (size_t)(tok0 + k) * D + co) = r; }
            asm volatile("" ::: "memory"); }
        asm volatile("s_waitcnt vmcnt(0) lgkmcnt(0)" ::: "memory");
    }
}

__global__ void __launch_bounds__(NWAVES * 64, 2) fwd_kernel(Args args) {
    extern __shared__ __attribute__((aligned(16))) unsigned char lds[];
    Frame F;
    F.lds = (LAS unsigned char*)lds;
    F.MISC = (volatile LAS unsigned*)(F.lds + MISC_OFF);
    F.tid = threadIdx.x; F.lane = F.tid & 63; F.wave = __builtin_amdgcn_readfirstlane(F.tid >> 6);
    F.G = gridDim.x; F.bid = blockIdx.x;
    unsigned char* ws = args.ws;
    F.ctl = (gu32*)(ws + WS_CTL);
    for (int u = F.tid; u < (LDS_BYTES - LDSCTL_OFF) / 4; u += NWAVES * 64) ((LAS unsigned*)(F.lds + LDSCTL_OFF))[u] = 0u;
    __syncthreads();
    XcdBarrier bar; bar.bar = (unsigned*)(F.ctl + CW_BAR); bar.x = 0; bar.st = nullptr;
    if (!MK_PER_PHASE) bar = xcd_barrier_post((unsigned*)(F.ctl + CW_BAR), F.MISC + 8);
    const int lo = args.ph_lo, hi = args.ph_hi;
#ifndef PHMASK
#define PHMASK 0xFFFF
#endif
#define IN(k) (((PHMASK >> (k)) & 1) && lo <= (k) && (k) < hi)
#ifndef PROBE_DUP
#define PROBE_DUP -1
#endif
#define SEAM(k) do { if (IN(k) && IN((k) + 1)) xcd_barrier(bar); } while (0)
#define REP(k) for (int rep_ = 0; rep_ < ((PROBE_DUP == (k)) ? 2 : 1); ++rep_, ((PROBE_DUP == (k) && rep_ == 1) ? xcd_barrier(bar) : (void)0))
    typedef pg8::bf16_t pb;
    pb* XB = (pb*)(ws + WS_XB); pb* WIN = (pb*)(ws + WS_WIN); pb* U = (pb*)(ws + WS_U); pb* Gt = (pb*)(ws + WS_G); pb* MT = (pb*)(ws + WS_MT);
    pb* PRW = (pb*)(ws + WS_PRW); pb* YS = (pb*)(ws + WS_YS); pb* CAT = (pb*)(ws + WS_CAT); pb* AL = (pb*)(ws + WS_ALORA); pb* LO = (pb*)(ws + WS_LORA);
    pb* WGLU = (pb*)(ws + WS_WGLU); pb* WOUT = (pb*)(ws + WS_WOUT); pb* WQK = (pb*)(ws + WS_WQK); pb* WL = (pb*)(ws + WS_WLORA); pb* H1B = (pb*)(ws + WS_H1B);

    if (IN(0)) REP(0) { p0_prologue(F, args); } SEAM(0);
    if (IN(1)) REP(1) {
        pg8::Gemm g{XB, WIN, 2048, 2048, 2048}; pg8::StaticOrder S; S.init(M, INP, F.G, F.bid); pg8::EpiProj E{U, PRW};
        pg8::gemm_phase<pg8::EpiProj, pg8::StaticOrder, true, true>(F.lds + RING_OFF, g, S, E); } SEAM(1);
    if (IN(2)) REP(2) {
        pg8::Gemm g{U, Gt, 512, 640, 512}; pg8::OneUnit S{F.bid < 64 ? F.bid : -1, F.bid >> 1}; pg8::EpiSa E{U, (const float*)(ws + WS_A32)};
        pg8::gemm_phase<pg8::EpiSa, pg8::OneUnit, false, true>(F.lds + RING_OFF, g, S, E);
        r1_lora_in(F, args); } SEAM(2);
    if (IN(3)) REP(3) {
        { pg8::Gemm g{U, MT, 640, 640, 640}; pg8::OneUnit S{F.bid < 128 ? (F.bid >> 1) : -1, F.bid}; pg8::EpiY E{YS};
          pg8::gemm_phase<pg8::EpiY, pg8::OneUnit, false, true>(F.lds + RING_OFF, g, S, E); }
        { pg8::Gemm g{AL, WL, 384, 384, 384}; pg8::ListOrder S{F.bid < 128 ? 256 + F.bid : F.bid - 128, F.bid < 128 ? -1 : F.bid, 32}; pg8::EpiStoreBf16 E{LO, 3072};
          pg8::gemm_phase<pg8::EpiStoreBf16, pg8::ListOrder, true, true>(F.lds + RING_OFF, g, S, E); } } SEAM(3);
    if (IN(4)) REP(4) {
        { const int L = F.bid - 128; pg8::Gemm g{YS, WGLU, 1024, 1024, 1024}; pg8::OneUnit S{L >= 0 ? (L & 31) : -1, L >> 5}; pg8::EpiGLU E{YS, args.in[I_BGLU], CAT};
          pg8::gemm_phase<pg8::EpiGLU, pg8::OneUnit, false, true>(F.lds + RING_OFF, g, S, E); }
        r3_prep(F, args); } SEAM(4);
    if (IN(5)) REP(5) { r4_scan(F, args); } SEAM(5);
    if (IN(6)) REP(6) { r5_post(F, args); } SEAM(6);
    if (IN(7)) REP(7) {
        pg8::Gemm g{CAT, WOUT, 2048, 2048, 2048}; pg8::StaticOrder S; S.init(M, D, F.G, F.bid); pg8::EpiF32 E{(float*)(ws + WS_Z), args.in[I_X], D, ALPHA};
        pg8::gemm_phase<pg8::EpiF32, pg8::StaticOrder, true, true>(F.lds + RING_OFF, g, S, E); } SEAM(7);
    if (IN(8)) REP(8) { ln1_rows(F, args); } SEAM(8);
    if (IN(9)) REP(9) {
        pg8::Gemm g{H1B, WQK, 2048, 2048, 2048}; pg8::StaticOrder S; S.init(M, D, F.G, F.bid); pg8::EpiF32 E{(float*)(ws + WS_SC), nullptr, D, 0.f};
        pg8::gemm_phase<pg8::EpiF32, pg8::StaticOrder, true, true>(F.lds + RING_OFF, g, S, E); } SEAM(9);
    if (IN(10)) REP(10) { topk_phase(F, args); } SEAM(10);
    if (IN(11)) REP(11) { peer_phase(F, args); }
#undef IN
#undef SEAM
}

extern "C" void kernel_launch(void* const* d_in, const int* in_sizes, int n_in, void* d_out, int out_size, void* d_ws, size_t ws_size, hipStream_t stream) {
    static int grid = 0;
    if (grid == 0) {
        if (n_in != 33 || in_sizes[0] != M * D || out_size != M * D || ws_size < WS_END) { fprintf(stderr, "kernel_launch: unexpected shapes (n_in %d, in0 %d, out %d, ws %zu)\n", n_in, n_in > 0 ? in_sizes[0] : -1, out_size, ws_size); grid = -1; return; }
        int dev = 0, cus = 0, per_cu = 0;
        if (hipGetDevice(&dev) != hipSuccess || hipDeviceGetAttribute(&cus, hipDeviceAttributeMultiprocessorCount, dev) != hipSuccess) { grid = -1; return; }
        if (hipFuncSetAttribute((const void*)fwd_kernel, hipFuncAttributeMaxDynamicSharedMemorySize, LDS_BYTES) != hipSuccess) { fprintf(stderr, "kernel_launch: hipFuncSetAttribute failed\n"); grid = -1; return; }
        if (hipOccupancyMaxActiveBlocksPerMultiprocessor(&per_cu, (const void*)fwd_kernel, NWAVES * 64, LDS_BYTES) != hipSuccess || per_cu < 1) { fprintf(stderr, "kernel_launch: occupancy query says %d blocks per CU\n", per_cu); per_cu = 1; }
        (void)hipGetLastError();
        grid = cus;
        if (grid != 256) fprintf(stderr, "kernel_launch: %d CUs (built for 256)\n", grid);
    }
    if (grid < 0) return;
    (void)hipMemsetAsync((char*)d_ws + WS_CTL, 0, CTL_ZERO_BYTES, stream);
    Args a{};
    for (int i = 0; i < 33; ++i) a.in[i] = (const float*)d_in[i];
    a.out = (float*)d_out; a.ws = (unsigned char*)d_ws;
#if MK_PER_PHASE
    for (int li = 0; li < NPHASE; ++li) { a.ph_lo = li; a.ph_hi = li + 1; a.li = li; hipLaunchKernelGGL(fwd_kernel, dim3(grid), dim3(NWAVES * 64), LDS_BYTES, stream, a); }
#else
    a.ph_lo = 0; a.ph_hi = NPHASE; a.li = 0;
    void* kargs[] = {(void*)&a};
    hipError_t e = hipLaunchCooperativeKernel((const void*)fwd_kernel, dim3(grid), dim3(NWAVES * 64), kargs, LDS_BYTES, stream);
    if (e != hipSuccess) fprintf(stderr, "kernel_launch: cooperative launch failed: %s\n", hipGetErrorString(e));
#endif
}
```

```cpp
#include <hip/hip_runtime.h>
#include <cstdio>
#include <cstdint>
#include <cmath>
namespace pg8 {
#define PG8_LAS __attribute__((address_space(3)))
typedef unsigned short bf16_t;
typedef short bf16x8 __attribute__((ext_vector_type(8)));
typedef float f32x4 __attribute__((ext_vector_type(4)));
typedef float f32x2 __attribute__((ext_vector_type(2)));
typedef unsigned u32x4 __attribute__((ext_vector_type(4)));
constexpr int BM = 256, BK = 64, HALF = 128, HTB = HALF * BK * 2  , STAGE_BYTES = 8 * HTB, NXCD = 8, WGM = 8;

__host__ __device__ __forceinline__ int lds_byte(int r, int c) { const int st = (r >> 4) * 2 + (c >> 5), rr = r & 15, cc = c & 31, ob = rr * 64 + cc * 2; return st * 1024 + (ob ^ (((ob >> 9) & 1) << 5)); }
__host__ __device__ __forceinline__ void stage_rc(int b, int& R, int& C) { const int st = b / 1024, sb = b % 1024, swz = sb ^ (((sb >> 9) & 1) << 5); R = (st >> 1) * 16 + swz / 64; C = (st & 1) * 32 + (swz % 64) / 2; }
__host__ __device__ __forceinline__ int perm32(int rho) { const int n = rho >> 4, i = rho & 15; return 8 * (i >> 2) + 4 * n + (i & 3); }

struct Unit { int pm, pn; };
struct Gemm { const bf16_t* A; const bf16_t* Bt; int K, lda, ldb; };

struct StaticOrder {
    int nM, nN, nwg, G, c;
    __host__ __device__ void init(int M, int N, int G_, int c_) { nM = M / BM; nN = N / BM; nwg = nM * nN; G = G_; c = c_; }
    __host__ __device__ bool next(int i, Unit& u) const {
        const long L = (long)i * G + c; if (L >= nwg) return false;
        int wgid = (int)L; { const int q = nwg / NXCD, r = nwg % NXCD, xcd = wgid % NXCD, off = wgid / NXCD; wgid = (xcd < r ? xcd * (q + 1) : r * (q + 1) + (xcd - r) * q) + off; }
        const int nig = WGM * nN, gid = wgid / nig, fm = gid * WGM, gsz = (nM - fm) < WGM ? (nM - fm) : WGM;
        u.pm = fm + ((wgid % nig) % gsz); u.pn = (wgid % nig) / gsz; return true;
    }
    __device__ __forceinline__ void a_ready(const Unit&) const {}
    __device__ __forceinline__ void done(const Unit&) const {}
};
struct ListOrder {
    int L0, L1, nM;
    __device__ bool next(int i, Unit& u) const { const int L = (i == 0) ? L0 : ((i == 1) ? L1 : -1); if (L < 0) return false; u.pm = L % nM; u.pn = L / nM; return true; }
    __device__ __forceinline__ void a_ready(const Unit&) const {}
    __device__ __forceinline__ void done(const Unit&) const {}
};
struct OneUnit {
    int pm, pn;
    __device__ bool next(int i, Unit& u) const { if (i != 0 || pm < 0) return false; u.pm = pm; u.pn = pn; return true; }
    __device__ __forceinline__ void a_ready(const Unit&) const {}
    __device__ __forceinline__ void done(const Unit&) const {}
};

__device__ __forceinline__ unsigned cvt_pk_bf16(float lo, float hi) { unsigned r; asm volatile("v_cvt_pk_bf16_f32 %0, %1, %2" : "=v"(r) : "v"(lo), "v"(hi)); return r; }
__device__ __forceinline__ float bf_lo(unsigned w) { return __uint_as_float(w << 16); }
__device__ __forceinline__ float bf_hi(unsigned w) { return __uint_as_float(w & 0xffff0000u); }
__device__ __forceinline__ float gelu_tanh(float x) { const float y = 0.7978845608f * (x + 0.044715f * x * x * x); return x * __builtin_amdgcn_rcpf(1.0f + __expf(-2.0f * y)); }
__device__ __forceinline__ float sigmoidf(float x) { return __builtin_amdgcn_rcpf(1.0f + __expf(-x)); }

__device__ __forceinline__ u32x4 pack8(const f32x4 v0, const f32x4 v1) { u32x4 w; w.x = cvt_pk_bf16(v0[0], v0[1]); w.y = cvt_pk_bf16(v0[2], v0[3]); w.z = cvt_pk_bf16(v1[0], v1[1]); w.w = cvt_pk_bf16(v1[2], v1[3]); return w; }

struct EpiStoreBf16 {
    static constexpr bool PERM = true, AFTER_DRAIN = false;
    bf16_t* O; int ldc;
    __device__ __forceinline__ void operator()(const f32x4 (&acc)[2][2][4][2], const Unit& u, int wr, int wc, int fr, int fq) const {
        const int row0 = u.pm * BM + wr * 64 + fr, col0 = u.pn * BM + wc * 32 + 8 * fq;
#pragma unroll
        for (int ai = 0; ai < 2; ++ai)
#pragma unroll
            for (int m = 0; m < 4; ++m) { bf16_t* rowp = O + (size_t)(row0 + ai * HALF + m * 16) * ldc + col0;
#pragma unroll
                for (int bj = 0; bj < 2; ++bj) *(u32x4*)(rowp + bj * HALF) = pack8(acc[ai][bj][m][0], acc[ai][bj][m][1]); }
    }
};
struct EpiProj {
    static constexpr bool PERM = true, AFTER_DRAIN = false;
    bf16_t* U; bf16_t* PRW;
    __device__ __forceinline__ void operator()(const f32x4 (&acc)[2][2][4][2], const Unit& u, int wr, int wc, int fr, int fq) const {
        const int row0 = u.pm * BM + wr * 64 + fr, col0 = u.pn * BM + wc * 32 + 8 * fq;
#pragma unroll
        for (int ai = 0; ai < 2; ++ai)
#pragma unroll
            for (int m = 0; m < 4; ++m) { const int row = row0 + ai * HALF + m * 16;
#pragma unroll
                for (int bj = 0; bj < 2; ++bj) { const int col = col0 + bj * HALF; const u32x4 w = pack8(acc[ai][bj][m][0], acc[ai][bj][m][1]);
                    if (u.pn < 4) { const int g = col >> 4, h0 = col & 15, b = row >> 11, t = row & 2047, c = t >> 5, s = t & 31;
                        *(u32x4*)(U + (size_t)(g * 256 + b * 64 + c) * 640 + s * 16 + h0) = w; }
                    else *(u32x4*)(PRW + (size_t)row * 3584 + (col - 1024)) = w; } }
    }
};
struct EpiY {
    static constexpr bool PERM = true, AFTER_DRAIN = false;
    bf16_t* YS;
    __device__ __forceinline__ void operator()(const f32x4 (&acc)[2][2][4][2], const Unit& u, int wr, int wc, int fr, int fq) const {
        const int g = u.pm, j = u.pn & 1;
#pragma unroll
        for (int ai = 0; ai < 2; ++ai)
#pragma unroll
            for (int m = 0; m < 4; ++m) { const int rowl = ai * HALF + wr * 64 + m * 16 + fr, b = rowl >> 6, c = rowl & 63;
#pragma unroll
                for (int bj = 0; bj < 2; ++bj) { const int n = 256 * j + bj * HALF + wc * 32 + 8 * fq, tl = n >> 4, h0 = n & 15;
                    f32x4 v0 = acc[ai][bj][m][0], v1 = acc[ai][bj][m][1];
#pragma unroll
                    for (int e = 0; e < 4; ++e) { v0[e] = gelu_tanh(v0[e]); v1[e] = gelu_tanh(v1[e]); }
                    *(u32x4*)(YS + (size_t)(b * 2048 + c * 32 + tl) * 1024 + g * 16 + h0) = pack8(v0, v1); }
                asm volatile("" ::: "memory"); }
    }
};
struct EpiGLU {
    static constexpr bool PERM = true, AFTER_DRAIN = false;
    const bf16_t* YS; const float* bglu; bf16_t* CAT;
    __device__ __forceinline__ void operator()(const f32x4 (&acc)[2][2][4][2], const Unit& u, int wr, int wc, int fr, int fq) const {
        const int row0 = u.pm * BM + wr * 64 + fr, col0 = u.pn * BM + wc * 32 + 8 * fq;
#pragma unroll
        for (int bj = 0; bj < 2; ++bj) { const int col = col0 + bj * HALF; const f32x4 b0 = *(const f32x4*)(bglu + col), b1 = *(const f32x4*)(bglu + col + 4);
#pragma unroll
            for (int ai = 0; ai < 2; ++ai)
#pragma unroll
                for (int m = 0; m < 4; ++m) { const int row = row0 + ai * HALF + m * 16; const u32x4 y = *(const u32x4*)(YS + (size_t)row * 1024 + col);
                    const f32x4 a0 = acc[ai][bj][m][0] + b0, a1 = acc[ai][bj][m][1] + b1; f32x4 o0, o1;
                    o0[0] = bf_lo(y.x) * sigmoidf(a0[0]); o0[1] = bf_hi(y.x) * sigmoidf(a0[1]); o0[2] = bf_lo(y.y) * sigmoidf(a0[2]); o0[3] = bf_hi(y.y) * sigmoidf(a0[3]);
                    o1[0] = bf_lo(y.z) * sigmoidf(a1[0]); o1[1] = bf_hi(y.z) * sigmoidf(a1[1]); o1[2] = bf_lo(y.w) * sigmoidf(a1[2]); o1[3] = bf_hi(y.w) * sigmoidf(a1[3]);
                    *(u32x4*)(CAT + (size_t)row * 2048 + col) = pack8(o0, o1); } }
    }
};
struct EpiF32 {
    static constexpr bool PERM = false, AFTER_DRAIN = false;
    float* O; const float* R; int ldc; float alpha;
    __device__ __forceinline__ void operator()(const f32x4 (&acc)[2][2][4][2], const Unit& u, int wr, int wc, int fr, int fq) const {
        const int row0 = u.pm * BM + wr * 64 + fr, col0 = u.pn * BM + wc * 32 + 4 * fq;
#pragma unroll
        for (int ai = 0; ai < 2; ++ai)
#pragma unroll
            for (int m = 0; m < 4; ++m) { const size_t off = (size_t)(row0 + ai * HALF + m * 16) * ldc + col0;
#pragma unroll
                for (int bj = 0; bj < 2; ++bj)
#pragma unroll
                    for (int n = 0; n < 2; ++n) { f32x4 o = acc[ai][bj][m][n]; if (R) { const f32x4 r = *(const f32x4*)(R + off + bj * HALF + n * 16); o = o + r * alpha; }
                        *(f32x4*)(O + off + bj * HALF + n * 16) = o; } }
    }
};
struct EpiSa {
    static constexpr bool PERM = false, AFTER_DRAIN = true;
    bf16_t* U; const float* A32;
    __device__ __forceinline__ void fused(const f32x4 (&acc)[2][2][4][2], const Unit& u, int wr, int wc, int fr, int fq, PG8_LAS unsigned char* lds, int wid, int lane) const {
        const int g = u.pm, gb = g & 1;
        PG8_LAS float* SL = (PG8_LAS float*)lds;
#pragma unroll
        for (int ai = 0; ai < 2; ++ai)
#pragma unroll
            for (int m = 0; m < 4; ++m) { const int rowl = ai * HALF + wr * 64 + m * 16 + fr;
#pragma unroll
                for (int bj = 0; bj < 2; ++bj) if (bj == gb) {
#pragma unroll
                    for (int n = 0; n < 2; ++n) *(PG8_LAS f32x4*)(SL + rowl * 128 + wc * 32 + n * 16 + 4 * fq) = acc[ai][bj][m][n]; } }
        asm volatile("s_waitcnt lgkmcnt(0)" ::: "memory"); __builtin_amdgcn_s_barrier(); asm volatile("" ::: "memory");
        const int tid = wid * 64 + lane;
        if (tid < 256) { const int b = tid >> 6, p = tid & 63; const float ar = A32[(g * 64 + p) * 2], ai_ = A32[(g * 64 + p) * 2 + 1]; float hr = 0.f, hi = 0.f;
            for (int c = 0; c < 64; ++c) { bf16_t* up = U + (size_t)(g * 256 + b * 64 + c) * 640 + 512 + p;
                const unsigned pk = cvt_pk_bf16(hr, hi); up[0] = (bf16_t)(pk & 0xffffu); up[64] = (bf16_t)(pk >> 16);
                const float sr = SL[(b * 64 + c) * 128 + p], si = SL[(b * 64 + c) * 128 + 64 + p];
                const float nr = ar * hr - ai_ * hi + sr, ni = ar * hi + ai_ * hr + si; hr = nr; hi = ni; } }
    }
};

template <class Epi, class Sched, bool ALIGN_EPI = false, bool SP2 = false>
__device__ __forceinline__ void gemm_phase(PG8_LAS unsigned char* lds, const Gemm g, const Sched& S, const Epi& E) {
    const int tid = threadIdx.x, wid = __builtin_amdgcn_readfirstlane(tid >> 6), lane = tid & 63, wr = wid >> 2, wc = wid & 3, fr = lane & 15, fq = lane >> 4;
    const int K = g.K, nt = K / BK;
    unsigned voffA[2], voffB[2];
#pragma unroll
    for (int i = 0; i < 2; ++i) { int R, C; stage_rc(tid * 16 + i * 8192, R, C); const int Rb = Epi::PERM ? ((R & ~31) + perm32(R & 31)) : R;
        voffA[i] = (unsigned)(R * g.lda + C) * 2u; voffB[i] = (unsigned)(Rb * g.ldb + C) * 2u; }
    const size_t kstep = (size_t)(BK * 2);
    const size_t hsA = (size_t)HALF * g.lda * 2, hsB = (size_t)HALF * g.ldb * 2;
    const size_t tsA = 2 * hsA, tsB = 2 * hsB;
    const unsigned ldsw = (unsigned)wid * 1024u;
    const int aoff = lds_byte(wr * 64 + fr, fq * 8), boff = lds_byte(wc * 32 + fr, fq * 8);
#define PG8_SA(b, h) (((b) * 2 + (h)) * HTB)
#define PG8_SB(b, h) ((4 + (b) * 2 + (h)) * HTB)
#define PG8_STAGE(bufoff, gbase, voff) do { _Pragma("unroll") for (int _i = 0; _i < 2; ++_i) \
        __builtin_amdgcn_global_load_lds((const unsigned*)((const char*)(gbase) + (voff)[_i]), (PG8_LAS unsigned*)(lds + (bufoff) + ldsw + _i * 8192), 16, 0, 0); } while (0)
#define PG8_LDA(dst, b, h) do { _Pragma("unroll") for (int m = 0; m < 4; ++m) _Pragma("unroll") for (int k = 0; k < 2; ++k) dst[m][k] = *(const PG8_LAS bf16x8*)(lds + PG8_SA(b, h) + aoff + m * 2048 + k * 1024); } while (0)
#define PG8_LDB(dst, b, h) do { _Pragma("unroll") for (int n = 0; n < 2; ++n) _Pragma("unroll") for (int k = 0; k < 2; ++k) dst[n][k] = *(const PG8_LAS bf16x8*)(lds + PG8_SB(b, h) + boff + n * 2048 + k * 1024); } while (0)
#define PG8_MMA(ai, bj, At, Bt) do { __builtin_amdgcn_s_setprio(1); _Pragma("unroll") for (int m = 0; m < 4; ++m) _Pragma("unroll") for (int n = 0; n < 2; ++n) _Pragma("unroll") for (int k = 0; k < 2; ++k) \
        acc[ai][bj][m][n] = __builtin_amdgcn_mfma_f32_16x16x32_bf16(Bt[n][k], At[m][k], acc[ai][bj][m][n], 0, 0, 0); __builtin_amdgcn_s_setprio(0); } while (0)
#define PG8_WAIT_V(n) asm volatile("s_waitcnt vmcnt(" #n ")" ::: "memory")
#define PG8_WAIT_L(n) asm volatile("s_waitcnt lgkmcnt(" #n ")" ::: "memory")
#define PG8_BAR __builtin_amdgcn_s_barrier()
#define PG8_SCHED __builtin_amdgcn_sched_barrier(0)
    Unit cur, nxt; int ui = 0;
    if (!S.next(0, cur)) return;
    f32x4 acc[2][2][4][2];
#pragma unroll
    for (int a = 0; a < 2; ++a)
#pragma unroll
        for (int b = 0; b < 2; ++b)
#pragma unroll
            for (int m = 0; m < 4; ++m)
#pragma unroll
                for (int n = 0; n < 2; ++n) acc[a][b][m][n] = (f32x4){0.f, 0.f, 0.f, 0.f};
    bf16x8 At[4][2], B0[2][2], B1[2][2];
    const char* cA = (const char*)g.A + (size_t)cur.pm * tsA; const char* cB = (const char*)g.Bt + (size_t)cur.pn * tsB;
    S.a_ready(cur);
    if constexpr (SP2) {
        PG8_STAGE(PG8_SB(0, 0), cB, voffB); PG8_STAGE(PG8_SB(0, 1), cB + hsB, voffB); PG8_STAGE(PG8_SA(0, 0), cA, voffA); PG8_STAGE(PG8_SA(0, 1), cA + hsA, voffA);
        if (wr == 1) PG8_BAR;
        PG8_WAIT_V(2); PG8_BAR;
        PG8_STAGE(PG8_SB(1, 0), cB + kstep, voffB); PG8_STAGE(PG8_SA(1, 0), cA + kstep, voffA); PG8_STAGE(PG8_SB(1, 1), cB + hsB + kstep, voffB);
        PG8_WAIT_V(6); PG8_BAR;
    } else {
        PG8_STAGE(PG8_SB(0, 0), cB, voffB); PG8_STAGE(PG8_SA(0, 0), cA, voffA); PG8_STAGE(PG8_SB(0, 1), cB + hsB, voffB); PG8_STAGE(PG8_SA(0, 1), cA + hsA, voffA);
        if (wr == 1) PG8_BAR;
        PG8_WAIT_V(4); PG8_BAR;
        PG8_STAGE(PG8_SB(1, 0), cB + kstep, voffB); PG8_STAGE(PG8_SA(1, 0), cA + kstep, voffA); PG8_STAGE(PG8_SB(1, 1), cB + hsB + kstep, voffB);
        PG8_WAIT_V(6); PG8_BAR;
    }
    for (;;) {
        const bool has_next = S.next(ui + 1, nxt);
        const char* nA = has_next ? (const char*)g.A + (size_t)nxt.pm * tsA : cA; const char* nB = has_next ? (const char*)g.Bt + (size_t)nxt.pn * tsB : cB;
#pragma nounroll
        for (int t = 0; t < nt; t += 2) {
            const bool last = (t == nt - 2);
            const char* a1 = cA + (size_t)(t + 1) * kstep;
            const char* a2 = last ? nA : cA + (size_t)(t + 2) * kstep; const char* b2 = last ? nB : cB + (size_t)(t + 2) * kstep;
            const char* a3 = a2 + kstep; const char* b3 = b2 + kstep;
            if (last && has_next) S.a_ready(nxt);
            if constexpr (SP2) {
            PG8_LDB(B0, 0, 0); PG8_LDB(B1, 0, 1); PG8_SCHED; PG8_LDA(At, 0, 0); PG8_STAGE(PG8_SA(1, 1), a1 + hsA, voffA);
            PG8_WAIT_V(8); PG8_WAIT_L(0); PG8_BAR; PG8_MMA(0, 0, At, B0); PG8_MMA(0, 1, At, B1); PG8_BAR; PG8_SCHED;
            PG8_LDA(At, 0, 1); PG8_STAGE(PG8_SB(0, 0), b2, voffB); PG8_STAGE(PG8_SB(0, 1), b2 + hsB, voffB); PG8_STAGE(PG8_SA(0, 0), a2, voffA);
            PG8_WAIT_V(8); PG8_WAIT_L(0); PG8_BAR; PG8_MMA(1, 0, At, B0); PG8_MMA(1, 1, At, B1); PG8_BAR; PG8_SCHED;
            PG8_LDB(B0, 1, 0); PG8_LDB(B1, 1, 1); PG8_SCHED; PG8_LDA(At, 1, 0); PG8_STAGE(PG8_SA(0, 1), a2 + hsA, voffA);
            PG8_WAIT_V(8); PG8_WAIT_L(0); PG8_BAR; PG8_MMA(0, 0, At, B0); PG8_MMA(0, 1, At, B1); PG8_BAR; PG8_SCHED;
            PG8_LDA(At, 1, 1); PG8_STAGE(PG8_SB(1, 0), b3, voffB); PG8_STAGE(PG8_SB(1, 1), b3 + hsB, voffB); PG8_STAGE(PG8_SA(1, 0), a3, voffA);
            PG8_WAIT_V(8); PG8_WAIT_L(0); PG8_BAR; PG8_MMA(1, 0, At, B0); PG8_MMA(1, 1, At, B1); PG8_BAR; PG8_SCHED;
            } else {
            PG8_LDB(B0, 0, 0); PG8_SCHED; PG8_LDA(At, 0, 0); PG8_STAGE(PG8_SA(1, 1), a1 + hsA, voffA);
            PG8_WAIT_L(8); PG8_BAR; PG8_WAIT_L(0); PG8_MMA(0, 0, At, B0); PG8_BAR; PG8_SCHED;
            PG8_LDB(B1, 0, 1); PG8_STAGE(PG8_SB(0, 0), b2, voffB);
            PG8_BAR; PG8_WAIT_L(0); PG8_MMA(0, 1, At, B1); PG8_BAR;
            PG8_LDA(At, 0, 1); PG8_STAGE(PG8_SA(0, 0), a2, voffA);
            PG8_BAR; PG8_WAIT_L(0); PG8_MMA(1, 0, At, B0); PG8_BAR; PG8_SCHED;
            PG8_STAGE(PG8_SB(0, 1), b2 + hsB, voffB);
            PG8_WAIT_V(6); PG8_BAR; PG8_MMA(1, 1, At, B1); PG8_BAR;
            PG8_LDB(B0, 1, 0); PG8_SCHED; PG8_LDA(At, 1, 0); PG8_STAGE(PG8_SA(0, 1), a2 + hsA, voffA);
            PG8_WAIT_L(8); PG8_BAR; PG8_WAIT_L(0); PG8_MMA(0, 0, At, B0); PG8_BAR; PG8_SCHED;
            PG8_LDB(B1, 1, 1); PG8_STAGE(PG8_SB(1, 0), b3, voffB);
            PG8_BAR; PG8_WAIT_L(0); PG8_MMA(0, 1, At, B1); PG8_BAR;
            PG8_LDA(At, 1, 1); PG8_STAGE(PG8_SA(1, 0), a3, voffA);
            PG8_BAR; PG8_WAIT_L(0); PG8_MMA(1, 0, At, B0); PG8_BAR; PG8_SCHED;
            PG8_STAGE(PG8_SB(1, 1), b3 + hsB, voffB);
            PG8_WAIT_V(6); PG8_BAR; PG8_MMA(1, 1, At, B1); PG8_BAR;
            }
        }
        if constexpr (ALIGN_EPI) { if (wr == 0) PG8_BAR; }
        if constexpr (!Epi::AFTER_DRAIN) { E(acc, cur, wr, wc, fr, fq); S.done(cur); }
        if (!has_next) break;
#pragma unroll
        for (int a = 0; a < 2; ++a)
#pragma unroll
            for (int b = 0; b < 2; ++b)
#pragma unroll
                for (int m = 0; m < 4; ++m)
#pragma unroll
                    for (int n = 0; n < 2; ++n) acc[a][b][m][n] = (f32x4){0.f, 0.f, 0.f, 0.f};
        cur = nxt; cA = nA; cB = nB; ++ui;
        if constexpr (ALIGN_EPI) { if (wr == 1) PG8_BAR; }
    }
    PG8_WAIT_V(0);
    if constexpr (!ALIGN_EPI) { if (wr == 0) PG8_BAR; }
    PG8_BAR;
    if constexpr (Epi::AFTER_DRAIN) { E.fused(acc, cur, wr, wc, fr, fq, lds, wid, lane); S.done(cur); }
#undef PG8_SA
#undef PG8_SB
#undef PG8_STAGE
#undef PG8_LDA
#undef PG8_LDB
#undef PG8_MMA
#undef PG8_WAIT_V
#undef PG8_WAIT_L
#undef PG8_BAR
#undef PG8_SCHED
}
}

constexpr int NWAVES = 8;
#ifndef MK_PER_PHASE
#define MK_PER_PHASE 0
#endif
constexpr int NPHASE = 12;
constexpr int M = 8192, D = 2048, SEQ = 2048;
constexpr int INC = 4384, INP = 4608;
constexpr float ALPHA = 1.189207115f;
constexpr float LN_EPS = 1e-5f, GN_EPS = 64e-5f;
constexpr size_t MiB = 1u << 20;
constexpr size_t WS_CTL = 0, CTL_ZERO_BYTES = 1 * MiB;
constexpr size_t WS_WGLU = 1 * MiB, WS_WOUT = 3 * MiB, WS_WQK = 11 * MiB, WS_WLORA = 19 * MiB, WS_IDX = 22 * MiB, WS_GATE = 26 * MiB, WS_A32 = 30 * MiB;
constexpr size_t WS_UTAB = 32 * MiB, WS_VTAB = 96 * MiB;
constexpr size_t WS_SU = 31 * MiB;
constexpr size_t WS_XB = 160 * MiB, WS_WIN = 192 * MiB, WS_U = 210 * MiB, WS_G = 230 * MiB, WS_MT = 238 * MiB;
constexpr size_t WS_SCAN = 160 * MiB;
constexpr size_t WS_PRW = 286 * MiB, WS_YS = 342 * MiB, WS_CAT = 358 * MiB, WS_ALORA = 390 * MiB, WS_LORA = 396 * MiB, WS_ORW = 444 * MiB;
constexpr size_t WS_Z = 160 * MiB, WS_H1 = 224 * MiB, WS_H1B = 288 * MiB, WS_SC = 390 * MiB;
constexpr size_t WS_END = 476 * MiB;
constexpr int SCAN_REC = 896;
constexpr int CW_BAR = 4096;
constexpr int RING_OFF = 0, RING_BYTES = 131072;
constexpr int LDSCTL_OFF = RING_BYTES, MISC_OFF = LDSCTL_OFF + 320;
constexpr int LDS_BYTES = 147456;

#define GAS __attribute__((address_space(1)))
#define LAS __attribute__((address_space(3)))
typedef unsigned short bf16;
typedef unsigned v4u __attribute__((ext_vector_type(4)));
typedef float f32x4 __attribute__((ext_vector_type(4)));
typedef float f32x2 __attribute__((ext_vector_type(2)));
typedef _Float16 h16x2 __attribute__((ext_vector_type(2)));
typedef __bf16 bf16x2v __attribute__((ext_vector_type(2)));
typedef GAS unsigned gu32;
#define RLX_AGENT __ATOMIC_RELAXED, __HIP_MEMORY_SCOPE_AGENT
#define LDS_WAIT() asm volatile("s_waitcnt lgkmcnt(0)" ::: "memory")
#define VM_WAIT() asm volatile("s_waitcnt vmcnt(0)" ::: "memory")
__device__ __forceinline__ unsigned f2bf(float f) { unsigned u = __builtin_bit_cast(unsigned, f); return (u + 0x7fffu + ((u >> 16) & 1u)) >> 16; }
__device__ __forceinline__ unsigned pk2(float lo, float hi) { return f2bf(lo) | (f2bf(hi) << 16); }
__device__ __forceinline__ float bflo(unsigned w) { return __uint_as_float(w << 16); }
__device__ __forceinline__ float bfhi(unsigned w) { return __uint_as_float(w & 0xffff0000u); }
__device__ __forceinline__ float bf1(bf16 h) { return __uint_as_float((unsigned)h << 16); }
__device__ __forceinline__ unsigned pkh(float lo, float hi) { h16x2 v; v.x = (_Float16)lo; v.y = (_Float16)hi; return __builtin_bit_cast(unsigned, v); }
__device__ __forceinline__ float hlo(unsigned w) { return (float)__builtin_bit_cast(h16x2, w).x; }
__device__ __forceinline__ float hhi(unsigned w) { return (float)__builtin_bit_cast(h16x2, w).y; }
__device__ __forceinline__ float wave_sum(float v) {
#pragma unroll
    for (int o = 1; o < 64; o <<= 1) v += __shfl_xor(v, o);
    return v;
}
using pg8::gelu_tanh; using pg8::sigmoidf; using pg8::pack8;

#define XB_TMO      128
#define XB_XCNT(j)  (256  + 64 * (j))
#define XB_XSUB(j)  (1280 + 64 * (j))
#define XB_XGEN(j)  (2304 + 64 * (j))
#define XB_TOP      3328
#define XB_TOPGEN   3392
#define XCD_BAR_WORDS 3456
#define XB_SPIN_CAP (1u << 18)

__device__ __forceinline__ unsigned xb_ld(unsigned* p)              { return __hip_atomic_load(p, __ATOMIC_RELAXED, __HIP_MEMORY_SCOPE_AGENT); }
__device__ __forceinline__ unsigned xb_add(unsigned* p, unsigned v) { return __hip_atomic_fetch_add(p, v, __ATOMIC_RELAXED, __HIP_MEMORY_SCOPE_AGENT); }
__device__ __forceinline__ unsigned xb_xcc_id() { return (unsigned)__builtin_amdgcn_s_getreg((3 << 11) | 20) & 0xFu; }
#define XB_SPIN(cond, bar) do { unsigned _sp = 0; while (cond) { __builtin_amdgcn_s_sleep(1); \
    if ((++_sp & 255u) == 0u) { if (xb_ld(&(bar)[XB_TMO])) break; if (_sp > XB_SPIN_CAP) { atomicAdd(&(bar)[XB_TMO], 1u); break; } } } } while (0)

struct XcdBarrier {
    unsigned* bar; unsigned x;
    volatile LAS unsigned* st;
};

__device__ __forceinline__ XcdBarrier xcd_barrier_post(unsigned* bar, volatile LAS unsigned* st) {
    XcdBarrier b; b.bar = bar; b.x = xb_xcc_id(); b.st = st;
    if (threadIdx.x == 0) (void)xb_add(&bar[XB_XCNT(b.x)], 1u);
    return b;
}
__device__ __forceinline__ void xcd_barrier_complete(unsigned* bar, unsigned x, unsigned& nloc, unsigned& nx) {
    const unsigned G = gridDim.x * gridDim.y * gridDim.z;
    unsigned sum, cnt, mine, sp = 0u;
    for (;;) {
        sum = 0u; cnt = 0u; mine = 0u;
#pragma unroll
        for (unsigned j = 0; j < 16; ++j) { const unsigned c = xb_ld(&bar[XB_XCNT(j)]); sum += c; cnt += (c > 0u) ? 1u : 0u; mine = (j == x) ? c : mine; }
        if (sum == G) break;
        __builtin_amdgcn_s_sleep(1);
        if ((++sp & 255u) == 0u) { if (xb_ld(&bar[XB_TMO])) break; if (sp > XB_SPIN_CAP) { atomicAdd(&bar[XB_TMO], 1u); break; } }
    }
    nloc = mine > 0u ? mine : 1u; nx = cnt > 0u ? cnt : 1u;
}

__device__ __forceinline__ void xcd_barrier(const XcdBarrier& b) {
    asm volatile("s_waitcnt vmcnt(0)" ::: "memory");
    __syncthreads();
    if (threadIdx.x == 0) {
        unsigned* bar = b.bar;
        __builtin_amdgcn_s_waitcnt(0);
        unsigned nloc = b.st[0], nx = b.st[1];
        if (nloc == 0u) { xcd_barrier_complete(bar, b.x, nloc, nx); b.st[0] = nloc; b.st[1] = nx; }
        const unsigned old = xb_add(&bar[XB_XSUB(b.x)], 1u);
        const unsigned gen = old / nloc;
        if (old + 1u == (gen + 1u) * nloc) {
            __builtin_amdgcn_fence(__ATOMIC_RELEASE, "agent");
            asm volatile("s_waitcnt vmcnt(0)" ::: "memory");
            const unsigned og = xb_add(&bar[XB_TOP], 1u);
            const unsigned tg = og / nx;
            if (og + 1u == (tg + 1u) * nx) xb_add(&bar[XB_TOPGEN], 1u);
            else XB_SPIN(xb_ld(&bar[XB_TOPGEN]) == tg, bar);
            __builtin_amdgcn_fence(__ATOMIC_ACQUIRE, "agent");
            xb_add(&bar[XB_XGEN(b.x)], 1u);
            asm volatile("s_waitcnt vmcnt(0)" ::: "memory");
        } else {
            XB_SPIN(xb_ld(&bar[XB_XGEN(b.x)]) == gen, bar);
            __builtin_amdgcn_fence(__ATOMIC_ACQUIRE, "agent");
            asm volatile("s_waitcnt vmcnt(0)" ::: "memory");
        }
    }
    __syncthreads();
}

struct Args { const float* in[33]; float* out; unsigned char* ws; int ph_lo, ph_hi, li, dup; };
struct Frame {
    LAS unsigned char* lds;
    volatile LAS unsigned* MISC;
    gu32* ctl;
    int tid, lane, wave, bid, G;
};
enum { I_X = 0, I_WIN, I_LAMRE, I_LAMIM, I_LOGSTEP, I_BRE, I_BIM, I_CRE, I_CIM, I_SD, I_WGLU, I_BGLU, I_MU, I_W0, I_WUP, I_A0, I_AUP, I_GUP, I_KK, I_KA, I_RK, I_GNG, I_GNB,
       I_WOUT, I_LN1G, I_LN1B, I_WQ, I_KEYS1, I_KEYS2, I_PU, I_PV, I_LN2G, I_LN2B };

__device__ __forceinline__ void p0_transpose_item(const float* W, int K, int N, bf16* WT, int row_off, LAS float* scr, int item, int lane) {
    const int nblk = N / 32, kb = item / nblk, nb = item % nblk, k0 = 64 * kb, n0 = 32 * nb;
#pragma unroll 8
    for (int i = 0; i < 32; ++i) { const int kk = 2 * i + (lane >> 5); scr[kk * 33 + (lane & 31)] = W[(size_t)(k0 + kk) * N + n0 + (lane & 31)]; }
    LDS_WAIT(); asm volatile("" ::: "memory");
    const int c = lane & 7;
#pragma unroll
    for (int j = 0; j < 4; ++j) { const int n = (lane >> 3) + 8 * j; const LAS float* s = scr + (8 * c) * 33 + n;
        v4u o; o.x = pk2(s[0 * 33], s[1 * 33]); o.y = pk2(s[2 * 33], s[3 * 33]); o.z = pk2(s[4 * 33], s[5 * 33]); o.w = pk2(s[6 * 33], s[7 * 33]);
        *(GAS v4u*)(WT + (size_t)(row_off + n0 + n) * K + k0 + 8 * c) = o; }
    LDS_WAIT(); asm volatile("" ::: "memory");
}
__device__ __forceinline__ void cvt_stream(const float* src, bf16* dst, size_t n8, size_t gtid, size_t nt) {
    for (size_t i = gtid; i < n8; i += nt) { const f32x4 a = ((const f32x4*)src)[2 * i], b = ((const f32x4*)src)[2 * i + 1]; ((v4u*)dst)[i] = pack8(a, b); }
}

__device__ __forceinline__ void peer_tables(Frame& F, const Args& A, int first_blk, int nblk) {
    if (F.bid < first_blk || F.bid >= first_blk + nblk) return;
    const int gw = (F.bid - first_blk) * NWAVES + F.wave, NGW = nblk * NWAVES, lane = F.lane;
    unsigned char* U8 = A.ws + WS_UTAB; unsigned char* V8 = A.ws + WS_VTAB; float* SU = (float*)(A.ws + WS_SU);
    for (int e = gw; e < 16384; e += NGW) {
        const f32x4* ur = (const f32x4*)(A.in[I_PU] + (size_t)e * D) + lane; const f32x4* vr = (const f32x4*)(A.in[I_PV] + (size_t)e * D) + lane; f32x4 x[8], y[8]; float am = 0.f;
#pragma unroll
        for (int i = 0; i < 8; ++i) { x[i] = ur[64 * i]; y[i] = vr[64 * i]; }
#pragma unroll
        for (int i = 0; i < 8; ++i) am = fmaxf(am, fmaxf(fmaxf(fabsf(x[i].x), fabsf(x[i].y)), fmaxf(fabsf(x[i].z), fabsf(x[i].w))));
#pragma unroll
        for (int o = 1; o < 64; o <<= 1) am = fmaxf(am, __shfl_xor(am, o));
        const float sc = (am > 0.f) ? am * (1.f / 127.f) : 1.f, inv = 1.f / sc;
        if (lane == 0) SU[e] = sc;
        unsigned* ud = (unsigned*)(U8 + (size_t)e * D) + lane; unsigned* vd = (unsigned*)(V8 + (size_t)e * D) + lane;
#pragma unroll
        for (int i = 0; i < 8; ++i) { const int a = (int)rintf(x[i].x * inv), b = (int)rintf(x[i].y * inv), c = (int)rintf(x[i].z * inv), d = (int)rintf(x[i].w * inv);
            ud[64 * i] = (unsigned)(a & 255) | ((unsigned)(b & 255) << 8) | ((unsigned)(c & 255) << 16) | ((unsigned)(d & 255) << 24);
            int w = 0; w = __builtin_amdgcn_cvt_pk_fp8_f32(y[i].x, y[i].y, w, false); w = __builtin_amdgcn_cvt_pk_fp8_f32(y[i].z, y[i].w, w, true); vd[64 * i] = (unsigned)w; }
    }
}

__device__ __forceinline__ void s5_params(Frame& F, const Args& A, int first_blk) {
    unsigned char* ws = A.ws;
    if (F.bid >= first_blk && F.bid < first_blk + 64) {
        const int g = F.bid - first_blk, tid = F.tid;
        LAS f32x2* AP = (LAS f32x2*)(F.lds);
        LAS f32x2* BB = (LAS f32x2*)(F.lds + 16896);
        LAS float* KJ = (LAS float*)(F.lds + 16896 + 8192);
        const float* lam_re = A.in[I_LAMRE] + g * 64; const float* lam_im = A.in[I_LAMIM] + g * 64;
        const float step = __expf(A.in[I_LOGSTEP][g]);
        for (int idx = tid; idx < 33 * 64; idx += 512) { const int j = idx >> 6, p = idx & 63; const float lr = lam_re[p], li = lam_im[p];
            const float mag = __expf(lr * step * (float)j); float rev = (li * step * 0.15915494309f) * (float)j; rev -= floorf(rev);
            AP[idx] = (f32x2){mag * __builtin_amdgcn_cosf(rev), mag * __builtin_amdgcn_sinf(rev)}; }
        LDS_WAIT(); __syncthreads();
        for (int idx = tid; idx < 64 * 16; idx += 512) { const int p = idx >> 4, h = idx & 15; const float lr = lam_re[p], li = lam_im[p]; const f32x2 a = AP[64 + p];
            const float den = lr * lr + li * li, fr = ((a.x - 1.f) * lr + a.y * li) / den, fi = (a.y * lr - (a.x - 1.f) * li) / den;
            const float br = A.in[I_BRE][(g * 64 + p) * 16 + h], bi = A.in[I_BIM][(g * 64 + p) * 16 + h];
            BB[idx] = (f32x2){fr * br - fi * bi, fr * bi + fi * br}; }
        if (tid < 64) { const f32x2 a = AP[32 * 64 + tid]; float* a32 = (float*)(ws + WS_A32); a32[(g * 64 + tid) * 2] = a.x; a32[(g * 64 + tid) * 2 + 1] = a.y; }
        LDS_WAIT(); __syncthreads();
        const float* cre = A.in[I_CRE] + (size_t)g * 16 * 64; const float* cim = A.in[I_CIM] + (size_t)g * 16 * 64;
        for (int idx = tid; idx < 32 * 256; idx += 512) { const int j = idx >> 8, h = (idx >> 4) & 15, hp = idx & 15; float s = 0.f;
            for (int p = 0; p < 64; ++p) { const f32x2 a = AP[j * 64 + p], bb = BB[p * 16 + hp]; const float wr = a.x * bb.x - a.y * bb.y, wi = a.x * bb.y + a.y * bb.x;
                s += cre[h * 64 + p] * wr - cim[h * 64 + p] * wi; }
            KJ[idx] = s; }
        LDS_WAIT(); __syncthreads();
        bf16* Gt = (bf16*)(ws + WS_G); bf16* MT = (bf16*)(ws + WS_MT);
        for (int it = tid; it < 8192; it += 512) { const int row = it >> 6, cb = (it & 63) * 8, s = cb >> 4, h0 = cb & 15, p = row & 63, im = row >> 6; const f32x2 a = AP[(31 - s) * 64 + p];
            float v[8];
#pragma unroll
            for (int e = 0; e < 8; ++e) { const f32x2 bb = BB[p * 16 + h0 + e]; v[e] = im ? (a.x * bb.y + a.y * bb.x) : (a.x * bb.x - a.y * bb.y); }
            v4u o; o.x = pk2(v[0], v[1]); o.y = pk2(v[2], v[3]); o.z = pk2(v[4], v[5]); o.w = pk2(v[6], v[7]);
            *(v4u*)(Gt + (size_t)(g * 128 + row) * 512 + cb) = o; }
        const float* dsk = A.in[I_SD] + g * 16;
        for (int it = tid; it < 40960; it += 512) { const int n = it / 80, kb = (it % 80) * 8, t = n >> 4, h = n & 15; float v[8];
            if (kb < 512) { const int s = kb >> 4, h0 = kb & 15;
#pragma unroll
                for (int e = 0; e < 8; ++e) { const int hp = h0 + e; float x = 0.f; if (s <= t) { x = KJ[(t - s) * 256 + h * 16 + hp]; if (s == t && hp == h) x += dsk[h]; } v[e] = x; } }
            else { const int p0 = (kb < 576) ? (kb - 512) : (kb - 576);
#pragma unroll
                for (int e = 0; e < 8; ++e) { const int p = p0 + e; const f32x2 a = AP[(t + 1) * 64 + p]; const float cr = cre[h * 64 + p], ci = cim[h * 64 + p];
                    v[e] = (kb < 576) ? (cr * a.x - ci * a.y) : -(cr * a.y + ci * a.x); } }
            v4u o; o.x = pk2(v[0], v[1]); o.y = pk2(v[2], v[3]); o.z = pk2(v[4], v[5]); o.w = pk2(v[6], v[7]);
            *(v4u*)(MT + (size_t)(g * 512 + n) * 640 + kb) = o; }
        LDS_WAIT(); __syncthreads();
    }
}

__device__ __forceinline__ void p0_prologue(Frame& F, const Args& A) {
    unsigned char* ws = A.ws;
    const size_t gtid = (size_t)F.bid * 512 + F.tid, NT = (size_t)F.G * 512;
    const int gw = F.bid * NWAVES + F.wave, NGW = F.G * NWAVES;
    cvt_stream(A.in[I_X], (bf16*)(ws + WS_XB), (size_t)M * D / 8, gtid, NT);
    {
        LAS float* scr = (LAS float*)(F.lds + RING_OFF + F.wave * 16384);
        constexpr int I_IN = (2048 / 64) * (INC / 32), I_GL = (1024 / 64) * (1024 / 32);
        for (int it = gw; it < I_IN + I_GL; it += NGW) { int r = it;
            if (r < I_IN) { p0_transpose_item(A.in[I_WIN], 2048, INC, (bf16*)(ws + WS_WIN), 0, scr, r, F.lane); continue; } r -= I_IN;
            p0_transpose_item(A.in[I_WGLU], 1024, 1024, (bf16*)(ws + WS_WGLU), 0, scr, r, F.lane); }
        v4u* z = (v4u*)((bf16*)(ws + WS_WIN) + (size_t)INC * 2048);
        for (size_t i = gtid; i < (size_t)(INP - INC) * 2048 / 8; i += NT) z[i] = (v4u){0u, 0u, 0u, 0u};
    }
    {
        bf16* WL = (bf16*)(ws + WS_WLORA);
        for (size_t i = gtid; i < (size_t)3072 * 384; i += NT) { const int n = (int)(i / 384), k = (int)(i % 384); float v = 0.f;
            if (n < 1024) { if (k < 64) v = A.in[I_WUP][k * 1024 + n]; }
            else if (n < 2048) { if (k >= 64 && k < 128) v = A.in[I_AUP][(k - 64) * 1024 + (n - 1024)]; }
            else { if (k >= 128 && k < 288) v = A.in[I_GUP][(k - 128) * 1024 + (n - 2048)]; }
            WL[i] = (bf16)f2bf(v); }
    }
}

__device__ __forceinline__ void deferred_weights(Frame& F, const Args& A, int first_blk, int nblk) {
    if (F.bid < first_blk || F.bid >= first_blk + nblk) return;
    unsigned char* ws = A.ws; const int rb = F.bid - first_blk;
    {
        LAS float* scr = (LAS float*)(F.lds + RING_OFF + F.wave * 16384);
        constexpr int I_OU = (2048 / 64) * (2048 / 32);
        for (int it = rb * NWAVES + F.wave; it < I_OU; it += nblk * NWAVES) p0_transpose_item(A.in[I_WOUT], 2048, 2048, (bf16*)(ws + WS_WOUT), 0, scr, it, F.lane);
    }
    __syncthreads();
    {
        LAS float* Ks = (LAS float*)(F.lds); LAS float* Ws = (LAS float*)(F.lds + 128 * 129 * 4);
        bf16* WQK = (bf16*)(ws + WS_WQK); const int tid = F.tid;
        for (int unit = rb; unit < 512; unit += nblk) { const int hj = unit >> 5, dblk = unit & 31, h = hj >> 1, j = hj & 1;
            const float* keys = (j ? A.in[I_KEYS2] : A.in[I_KEYS1]) + (size_t)h * 128 * 128;
            for (int idx = tid; idx < 16384; idx += 512) Ks[(idx >> 7) * 129 + (idx & 127)] = keys[idx];
            for (int idx = tid; idx < 8192; idx += 512) Ws[(idx >> 7) * 129 + (idx & 127)] = A.in[I_WQ][(size_t)(dblk * 64 + (idx >> 7)) * 2048 + hj * 128 + (idx & 127)];
            LDS_WAIT(); __syncthreads();
            const int key = tid & 127, dq = tid >> 7; float acc[16];
#pragma unroll
            for (int i = 0; i < 16; ++i) acc[i] = 0.f;
            for (int c = 0; c < 128; ++c) { const float a = Ks[key * 129 + c];
#pragma unroll
                for (int i = 0; i < 16; ++i) acc[i] += a * Ws[(dq * 16 + i) * 129 + c]; }
            v4u o0, o1; o0.x = pk2(acc[0], acc[1]); o0.y = pk2(acc[2], acc[3]); o0.z = pk2(acc[4], acc[5]); o0.w = pk2(acc[6], acc[7]);
            o1.x = pk2(acc[8], acc[9]); o1.y = pk2(acc[10], acc[11]); o1.z = pk2(acc[12], acc[13]); o1.w = pk2(acc[14], acc[15]);
            v4u* dst = (v4u*)(WQK + (size_t)(hj * 128 + key) * 2048 + dblk * 64 + dq * 16); dst[0] = o0; dst[1] = o1;
            LDS_WAIT(); __syncthreads(); }
    }
}

__device__ __forceinline__ void r1_lora_in(Frame& F, const Args& A) {
    const bf16* PRW = (const bf16*)(A.ws + WS_PRW); bf16* AL = (bf16*)(A.ws + WS_ALORA); const float* mu = A.in[I_MU];
    const int gw = F.bid * NWAVES + F.wave, NGW = F.G * NWAVES;
    for (int m = gw; m < M; m += NGW) { const int t = m & (SEQ - 1);
#pragma unroll
        for (int q = 0; q < 6; ++q) { const int idx = q * 64 + F.lane; float val = 0.f;
            if (idx < 288) { const int col = 3072 + idx; const float cur = bf1(PRW[(size_t)m * 3584 + col]); const float prev = (t > 0) ? bf1(PRW[(size_t)(m - 1) * 3584 + col]) : 0.f;
                const float s = cur + mu[col] * (prev - cur);
                val = (idx < 64) ? (1.f - 2.f / (1.f + __expf(2.f * s))) : ((idx < 128) ? s : sigmoidf(s)); }
            AL[(size_t)m * 384 + idx] = (bf16)f2bf(val); } }
}

__device__ __forceinline__ void r3_prep(Frame& F, const Args& A) {
    const bf16* PRW = (const bf16*)(A.ws + WS_PRW); const bf16* LO = (const bf16*)(A.ws + WS_LORA); unsigned char* SC = A.ws + WS_SCAN;
    const float* mu = A.in[I_MU]; const int lane = F.lane, head = lane >> 2, j0 = (lane & 3) * 16, ch = lane * 16;
    const int gw = F.bid * NWAVES + F.wave, NGW = F.G * NWAVES;
    for (int m = gw; m < M; m += NGW) { const int t = m & (SEQ - 1), b = m >> 11;
        float rs[16], ks[16], vs[16];
#pragma unroll
        for (int part = 0; part < 3; ++part) { const int col = part * 1024 + ch; const v4u c0 = *(const v4u*)(PRW + (size_t)m * 3584 + col), c1 = *(const v4u*)(PRW + (size_t)m * 3584 + col + 8);
            v4u p0 = (v4u){0u, 0u, 0u, 0u}, p1 = p0; if (t > 0) { p0 = *(const v4u*)(PRW + (size_t)(m - 1) * 3584 + col); p1 = *(const v4u*)(PRW + (size_t)(m - 1) * 3584 + col + 8); }
            float cu[16], pr[16];
#pragma unroll
            for (int e = 0; e < 4; ++e) { cu[2 * e] = bflo(c0[e]); cu[2 * e + 1] = bfhi(c0[e]); cu[8 + 2 * e] = bflo(c1[e]); cu[8 + 2 * e + 1] = bfhi(c1[e]);
                pr[2 * e] = bflo(p0[e]); pr[2 * e + 1] = bfhi(p0[e]); pr[8 + 2 * e] = bflo(p1[e]); pr[8 + 2 * e + 1] = bfhi(p1[e]); }
#pragma unroll
            for (int e = 0; e < 16; ++e) { const float s = cu[e] + mu[col + e] * (pr[e] - cu[e]); if (part == 0) rs[e] = s; else if (part == 1) ks[e] = s; else vs[e] = s; } }
        const v4u wl0 = *(const v4u*)(LO + (size_t)m * 3072 + ch), wl1 = *(const v4u*)(LO + (size_t)m * 3072 + ch + 8);
        const v4u al0 = *(const v4u*)(LO + (size_t)m * 3072 + 1024 + ch), al1 = *(const v4u*)(LO + (size_t)m * 3072 + 1024 + ch + 8);
        float wl[16], al[16];
#pragma unroll
        for (int e = 0; e < 4; ++e) { wl[2 * e] = bflo(wl0[e]); wl[2 * e + 1] = bfhi(wl0[e]); wl[8 + 2 * e] = bflo(wl1[e]); wl[8 + 2 * e + 1] = bfhi(wl1[e]);
            al[2 * e] = bflo(al0[e]); al[2 * e + 1] = bfhi(al0[e]); al[8 + 2 * e] = bflo(al1[e]); al[8 + 2 * e + 1] = bfhi(al1[e]); }
        float dec[16], kp[16], kk[16], aa[16]; float n2 = 0.f;
#pragma unroll
        for (int e = 0; e < 16; ++e) { const float x = A.in[I_W0][ch + e] + wl[e]; const float y = -x; const float sp = fmaxf(y, 0.f) + __logf(1.f + __expf(-fabsf(y)));
            const float w = -sp - 0.5f; dec[e] = __expf(-__expf(w));
            const float a = sigmoidf(A.in[I_A0][ch + e] + al[e]); aa[e] = a;
            kk[e] = ks[e] * A.in[I_KK][ch + e]; n2 += kk[e] * kk[e];
            kp[e] = ks[e] * (1.f + (a - 1.f) * A.in[I_KA][ch + e]); }
        n2 += __shfl_xor(n2, 1); n2 += __shfl_xor(n2, 2);
        const float inv = 1.f / fmaxf(sqrtf(n2), 1e-12f);
        unsigned char* rec = SC + ((size_t)(b * 16 + head) * SEQ + t) * SCAN_REC;
#pragma unroll
        for (int q = 0; q < 4; ++q) { unsigned char* pj = rec + ((lane & 3) * 4 + q) * 48;
            *(f32x4*)pj = (f32x4){dec[4 * q], dec[4 * q + 1], dec[4 * q + 2], dec[4 * q + 3]};
            v4u o; o.x = pkh(rs[4 * q], rs[4 * q + 1]); o.y = pkh(rs[4 * q + 2], rs[4 * q + 3]); o.z = pkh(kp[4 * q], kp[4 * q + 1]); o.w = pkh(kp[4 * q + 2], kp[4 * q + 3]); *(v4u*)(pj + 16) = o;
            const float k0 = kk[4 * q] * inv, k1 = kk[4 * q + 1] * inv, k2 = kk[4 * q + 2] * inv, k3 = kk[4 * q + 3] * inv;
            v4u o2; o2.x = pkh(k0, k1); o2.y = pkh(k2, k3); o2.z = pkh(k0 * aa[4 * q], k1 * aa[4 * q + 1]); o2.w = pkh(k2 * aa[4 * q + 2], k3 * aa[4 * q + 3]); *(v4u*)(pj + 32) = o2; }
        v4u v0, v1; v0.x = pkh(vs[0], vs[1]); v0.y = pkh(vs[2], vs[3]); v0.z = pkh(vs[4], vs[5]); v0.w = pkh(vs[6], vs[7]);
        v1.x = pkh(vs[8], vs[9]); v1.y = pkh(vs[10], vs[11]); v1.z = pkh(vs[12], vs[13]); v1.w = pkh(vs[14], vs[15]);
        *(v4u*)(rec + 768 + j0 * 2) = v0; *(v4u*)(rec + 768 + j0 * 2 + 16) = v1; }
}

__device__ __forceinline__ float dpp_f(float v, const int ctrl_sel) {
    const int iv = __builtin_bit_cast(int, v); int r;
    switch (ctrl_sel) { case 0: r = __builtin_amdgcn_update_dpp(0, iv, 0xB1, 0xf, 0xf, false); break;
                        case 1: r = __builtin_amdgcn_update_dpp(0, iv, 0x4E, 0xf, 0xf, false); break;
                        case 2: r = __builtin_amdgcn_update_dpp(0, iv, 0x141, 0xf, 0xf, false); break;
                        default: r = __builtin_amdgcn_update_dpp(0, iv, 0x140, 0xf, 0xf, false); break; }
    return __builtin_bit_cast(float, r);
}
__device__ __forceinline__ float allsum16(float x) { x += dpp_f(x, 0); x += dpp_f(x, 1); x += dpp_f(x, 2); x += dpp_f(x, 3); return x; }
__device__ __forceinline__ float fmix_lo(float a, unsigned h, float c) { float d; asm("v_fma_mix_f32 %0, %1, %2, %3 op_sel:[0,0,0] op_sel_hi:[0,1,0]" : "=v"(d) : "v"(a), "v"(h), "v"(c)); return d; }
__device__ __forceinline__ float fmix_hi(float a, unsigned h, float c) { float d; asm("v_fma_mix_f32 %0, %1, %2, %3 op_sel:[0,1,0] op_sel_hi:[0,1,0]" : "=v"(d) : "v"(a), "v"(h), "v"(c)); return d; }
__device__ __forceinline__ float fmixz_lo(float a, unsigned h) { float d; asm("v_fma_mix_f32 %0, %1, %2, 0 op_sel:[0,0,0] op_sel_hi:[0,1,0]" : "=v"(d) : "v"(a), "v"(h)); return d; }
__device__ __forceinline__ float fmix2_lo(unsigned vh, unsigned h, float c) { float d; asm("v_fma_mix_f32 %0, %1, %2, %3 op_sel:[0,0,0] op_sel_hi:[1,1,0]" : "=v"(d) : "v"(vh), "v"(h), "v"(c)); return d; }
__device__ __forceinline__ float fmix2_hi(unsigned vh, unsigned h, float c) { float d; asm("v_fma_mix_f32 %0, %1, %2, %3 op_sel:[0,1,0] op_sel_hi:[1,1,0]" : "=v"(d) : "v"(vh), "v"(h), "v"(c)); return d; }
constexpr int SCH = 32, SCH_BYTES = SCH * SCAN_REC, SCH_PIECES = SCH_BYTES / 16;
__device__ __forceinline__ void r4_scan(Frame& F, const Args& A) {
    if (F.bid >= 128) return;
    const int bh = F.bid >> 1, half = F.bid & 1, lane = F.lane, tid = F.tid, rl = lane >> 4, jg = lane & 15, row = half * 32 + F.wave * 4 + rl;
    const unsigned char* gbase = A.ws + WS_SCAN + (size_t)bh * SEQ * SCAN_REC;
    float* O = (float*)(A.ws + WS_ORW) + (size_t)(bh >> 4) * SEQ * 1024 + (bh & 15) * 64 + row;
    float S0 = 0.f, S1 = 0.f, S2 = 0.f, S3 = 0.f;
    v4u st0, st1, st2, st3;
#define SC_GLOAD(c) do { const unsigned char* g_ = gbase + (size_t)(c) * SCH_BYTES + tid * 16; st0 = *(const v4u*)g_; st1 = *(const v4u*)(g_ + 8192); st2 = *(const v4u*)(g_ + 16384); \
        if (tid < SCH_PIECES - 1536) st3 = *(const v4u*)(g_ + 24576); } while (0)
#define SC_LWRITE(b) do { LAS unsigned char* l_ = F.lds + (b) * SCH_BYTES + tid * 16; *(LAS v4u*)l_ = st0; *(LAS v4u*)(l_ + 8192) = st1; *(LAS v4u*)(l_ + 16384) = st2; \
        if (tid < SCH_PIECES - 1536) *(LAS v4u*)(l_ + 24576) = st3; } while (0)
    SC_GLOAD(0); SC_LWRITE(0); SC_GLOAD(1);
    for (int c = 0; c < SEQ / SCH; ++c) {
        LDS_WAIT(); __syncthreads();
        if (c + 1 < SEQ / SCH) SC_LWRITE((c + 1) & 1);
        if (c + 2 < SEQ / SCH) SC_GLOAD(c + 2);
        const LAS unsigned char* cb = F.lds + (c & 1) * SCH_BYTES;
        for (int s4 = 0; s4 < SCH; s4 += 16) { float keep = 0.f;
#pragma unroll
            for (int u = 0; u < 16; ++u) { const LAS unsigned char* p = cb + (s4 + u) * SCAN_REC;
                const f32x4 dec = *(const LAS f32x4*)(p + jg * 48); const v4u rk = *(const LAS v4u*)(p + jg * 48 + 16), kb = *(const LAS v4u*)(p + jg * 48 + 32);
                const unsigned vh = (unsigned)*(const LAS unsigned short*)(p + 768 + row * 2);
                float sa = fmix_hi(S1, kb.x, fmixz_lo(S0, kb.x)) + fmix_hi(S3, kb.y, fmixz_lo(S2, kb.y)); sa = allsum16(sa);
                const float t0 = fmix2_lo(vh, rk.z, S0 * dec[0]), t1 = fmix2_hi(vh, rk.z, S1 * dec[1]), t2 = fmix2_lo(vh, rk.w, S2 * dec[2]), t3 = fmix2_hi(vh, rk.w, S3 * dec[3]);
                const float nsa = -sa;
                S0 = fmix_lo(nsa, kb.z, t0); S1 = fmix_hi(nsa, kb.z, t1); S2 = fmix_lo(nsa, kb.w, t2); S3 = fmix_hi(nsa, kb.w, t3);
                float o = fmix_hi(S1, rk.x, fmixz_lo(S0, rk.x)) + fmix_hi(S3, rk.y, fmixz_lo(S2, rk.y)); o = allsum16(o);
                keep = (jg == u) ? o : keep; }
            O[(size_t)(c * SCH + s4 + jg) * 1024] = keep; }
    }
#undef SC_GLOAD
#undef SC_LWRITE
}

__device__ __forceinline__ void r5_post(Frame& F, const Args& A) {
    const float* ORW = (const float*)(A.ws + WS_ORW); const bf16* LO = (const bf16*)(A.ws + WS_LORA); const unsigned char* SC = A.ws + WS_SCAN; bf16* CAT = (bf16*)(A.ws + WS_CAT);
    const int lane = F.lane, head = lane >> 2, j0 = (lane & 3) * 16, ch = lane * 16;
    const int gw = F.bid * NWAVES + F.wave, NGW = F.G * NWAVES;
    for (int m = gw; m < M; m += NGW) { const int t = m & (SEQ - 1), b = m >> 11;
        float o[16];
#pragma unroll
        for (int q = 0; q < 4; ++q) { const f32x4 x = *(const f32x4*)(ORW + (size_t)m * 1024 + ch + 4 * q); o[4 * q] = x[0]; o[4 * q + 1] = x[1]; o[4 * q + 2] = x[2]; o[4 * q + 3] = x[3]; }
        float s = 0.f;
#pragma unroll
        for (int e = 0; e < 16; ++e) s += o[e];
        s += __shfl_xor(s, 1); s += __shfl_xor(s, 2); const float mean = s * (1.f / 64.f); float q2 = 0.f;
#pragma unroll
        for (int e = 0; e < 16; ++e) { const float d = o[e] - mean; q2 += d * d; }
        q2 += __shfl_xor(q2, 1); q2 += __shfl_xor(q2, 2); const float rstd = 1.f / sqrtf(q2 * (1.f / 64.f) + GN_EPS);
        const unsigned char* rec = SC + ((size_t)(b * 16 + head) * SEQ + t) * SCAN_REC; float dp = 0.f;
#pragma unroll
        for (int q = 0; q < 4; ++q) { const v4u rk = *(const v4u*)(rec + ((lane & 3) * 4 + q) * 48 + 16); const float* rkp = A.in[I_RK] + head * 64 + j0 + 4 * q;
            dp += hlo(rk.x) * hlo(rk.z) * rkp[0] + hhi(rk.x) * hhi(rk.z) * rkp[1] + hlo(rk.y) * hlo(rk.w) * rkp[2] + hhi(rk.y) * hhi(rk.w) * rkp[3]; }
        dp += __shfl_xor(dp, 1); dp += __shfl_xor(dp, 2);
        const v4u v0 = *(const v4u*)(rec + 768 + j0 * 2), v1 = *(const v4u*)(rec + 768 + j0 * 2 + 16);
        const v4u g0 = *(const v4u*)(LO + (size_t)m * 3072 + 2048 + ch), g1 = *(const v4u*)(LO + (size_t)m * 3072 + 2048 + ch + 8);
        float vv[16], gg[16];
#pragma unroll
        for (int e = 0; e < 4; ++e) { vv[2 * e] = hlo(v0[e]); vv[2 * e + 1] = hhi(v0[e]); vv[8 + 2 * e] = hlo(v1[e]); vv[8 + 2 * e + 1] = hhi(v1[e]);
            gg[2 * e] = bflo(g0[e]); gg[2 * e + 1] = bfhi(g0[e]); gg[8 + 2 * e] = bflo(g1[e]); gg[8 + 2 * e + 1] = bfhi(g1[e]); }
        float r[16];
#pragma unroll
        for (int e = 0; e < 16; ++e) r[e] = ((o[e] - mean) * rstd * A.in[I_GNG][ch + e] + A.in[I_GNB][ch + e] + dp * vv[e]) * gg[e];
        v4u w0, w1; w0.x = pk2(r[0], r[1]); w0.y = pk2(r[2], r[3]); w0.z = pk2(r[4], r[5]); w0.w = pk2(r[6], r[7]); w1.x = pk2(r[8], r[9]); w1.y = pk2(r[10], r[11]); w1.z = pk2(r[12], r[13]); w1.w = pk2(r[14], r[15]);
        *(v4u*)(CAT + (size_t)m * 2048 + 1024 + ch) = w0; *(v4u*)(CAT + (size_t)m * 2048 + 1024 + ch + 8) = w1; }
}

__device__ __forceinline__ void ln1_rows(Frame& F, const Args& A) {
    const float* Z = (const float*)(A.ws + WS_Z); float* H1 = (float*)(A.ws + WS_H1); bf16* H1B = (bf16*)(A.ws + WS_H1B);
    const int gw = F.bid * NWAVES + F.wave, NGW = F.G * NWAVES, lane = F.lane;
    for (int m = gw; m < M; m += NGW) { const f32x4* zr = (const f32x4*)(Z + (size_t)m * D) + lane; f32x4 v[8]; float s = 0.f;
#pragma unroll
        for (int j = 0; j < 8; ++j) { v[j] = zr[64 * j]; s += (v[j].x + v[j].y) + (v[j].z + v[j].w); }
        const float mean = wave_sum(s) * (1.f / D); float s2 = 0.f;
#pragma unroll
        for (int j = 0; j < 8; ++j) { v[j] = v[j] - mean; s2 += (v[j].x * v[j].x + v[j].y * v[j].y) + (v[j].z * v[j].z + v[j].w * v[j].w); }
        const float rstd = 1.f / sqrtf(wave_sum(s2) * (1.f / D) + LN_EPS);
#pragma unroll
        for (int j = 0; j < 8; ++j) { const f32x4 g = ((const f32x4*)A.in[I_LN1G])[64 * j + lane], bb = ((const f32x4*)A.in[I_LN1B])[64 * j + lane]; const f32x4 y = v[j] * rstd * g + bb;
            ((f32x4*)(H1 + (size_t)m * D))[64 * j + lane] = y;
            unsigned long long pk = (unsigned long long)pk2(y.x, y.y) | ((unsigned long long)pk2(y.z, y.w) << 32); ((unsigned long long*)(H1B + (size_t)m * D))[64 * j + lane] = pk; } }
}

__device__ __forceinline__ void ins16(float (&tv)[16], float x) {
#pragma unroll
    for (int k = 15; k >= 1; --k) tv[k] = __builtin_amdgcn_fmed3f(tv[k - 1], tv[k], x);
    tv[0] = fmaxf(tv[0], x);
}
__device__ __forceinline__ void topk_phase(Frame& F, const Args& A) {
    const float* SCp = (const float*)(A.ws + WS_SC); int* IDX = (int*)(A.ws + WS_IDX); float* GATE = (float*)(A.ws + WS_GATE);
    LAS float* scr = (LAS float*)(F.lds + F.wave * 8448); LAS unsigned* scu = (LAS unsigned*)scr;
    const int gw = F.bid * NWAVES + F.wave, NGW = F.G * NWAVES, lane = F.lane;
    for (int grp = gw; grp < M / 4; grp += NGW) { const float* base = SCp + (size_t)grp * 4 * 2048;
        float tv[16];
#pragma unroll
        for (int k = 0; k < 16; ++k) tv[k] = -INFINITY;
        for (int q = 0; q < 4; ++q) {
#pragma unroll
            for (int k = 0; k < 8; ++k) { const int rowl = k * 8 + (lane >> 3), c4 = (lane & 7) * 4; const f32x4 x = *(const f32x4*)(base + rowl * 128 + q * 32 + c4);
                scr[rowl * 33 + c4] = x[0]; scr[rowl * 33 + c4 + 1] = x[1]; scr[rowl * 33 + c4 + 2] = x[2]; scr[rowl * 33 + c4 + 3] = x[3]; }
            LDS_WAIT(); asm volatile("" ::: "memory");
#pragma unroll
            for (int i = 0; i < 32; ++i) { const unsigned key = (scu[lane * 33 + i] & ~127u) | (unsigned)(q * 32 + i); ins16(tv, __uint_as_float(key)); }
            LDS_WAIT(); asm volatile("" ::: "memory");
        }
        const int jb = lane & 1; float Av[16], Bv[16];
#pragma unroll
        for (int k = 0; k < 16; ++k) { const float ot = __shfl_xor(tv[k], 1); Av[k] = jb ? ot : tv[k]; Bv[k] = jb ? tv[k] : ot; }
#pragma unroll
        for (int k = 0; k < 16; ++k) { scu[lane * 33 + k] = __float_as_uint(Av[k]) & 127u; scu[lane * 33 + 16 + k] = __float_as_uint(Bv[k]) & 127u; }
        float tw[16];
#pragma unroll
        for (int k = 0; k < 16; ++k) tw[k] = -INFINITY;
#define CROW(i, n) _Pragma("unroll") for (int jj = 0; jj < (n); ++jj) { const float c = Av[i] + Bv[jj]; ins16(tw, __uint_as_float((__float_as_uint(c) & ~255u) | (unsigned)((i) * 16 + jj))); }
        CROW(0, 16) CROW(1, 8) CROW(2, 5) CROW(3, 4) CROW(4, 3) CROW(5, 2) CROW(6, 2) CROW(7, 2) CROW(8, 1) CROW(9, 1) CROW(10, 1) CROW(11, 1) CROW(12, 1) CROW(13, 1) CROW(14, 1) CROW(15, 1)
#undef CROW
        LDS_WAIT(); asm volatile("" ::: "memory");
        float ex[16]; float sum = 0.f;
#pragma unroll
        for (int k = 0; k < 16; ++k) { ex[k] = __expf(tw[k] - tw[0]); sum += ex[k]; }
        const float rs = 1.f / sum; int eid[16];
#pragma unroll
        for (int k = 0; k < 16; ++k) { const unsigned pos = __float_as_uint(tw[k]) & 255u; const unsigned ia = scu[lane * 33 + (pos >> 4)], ib = scu[lane * 33 + 16 + (pos & 15u)]; eid[k] = (int)(ia * 128u + ib); }
        const int token = grp * 4 + (lane >> 4), head = (lane >> 1) & 7; const size_t ob = (size_t)token * 128 + head * 16;
        if (jb == 0) {
#pragma unroll
            for (int k = 0; k < 16; k += 4) { *(int4*)(IDX + ob + k) = make_int4(eid[k], eid[k + 1], eid[k + 2], eid[k + 3]); *(f32x4*)(GATE + ob + k) = (f32x4){ex[k] * rs, ex[k + 1] * rs, ex[k + 2] * rs, ex[k + 3] * rs}; } }
        LDS_WAIT(); asm volatile("" ::: "memory");
    }
}

constexpr int PNT = 2, PNP = PNT * 128, PRD = 6, PNPAD = ((PNP + PRD - 1) / PRD) * PRD, PEER_WAVE_LDS = 4096;
__device__ __forceinline__ int dpp_i(int v, const int sel) {
    switch (sel) { case 0: return __builtin_amdgcn_update_dpp(0, v, 0x111, 0xf, 0xf, true);
                   case 1: return __builtin_amdgcn_update_dpp(0, v, 0x112, 0xf, 0xf, true);
                   case 2: return __builtin_amdgcn_update_dpp(0, v, 0x114, 0xf, 0xf, true);
                   case 3: return __builtin_amdgcn_update_dpp(0, v, 0x118, 0xf, 0xf, true);
                   case 4: return __builtin_amdgcn_update_dpp(0, v, 0x142, 0xa, 0xf, false);
                   default: return __builtin_amdgcn_update_dpp(0, v, 0x143, 0xc, 0xf, false); }
}
__device__ __forceinline__ int wave_total_i32(int v) {
    v += dpp_i(v, 0); v += dpp_i(v, 1); v += dpp_i(v, 2); v += dpp_i(v, 3); v += dpp_i(v, 4); v += dpp_i(v, 5);
    return __builtin_amdgcn_readlane(v, 63);
}
template <bool DUMMY> __device__ __forceinline__ void peer_phase(Frame& F, const Args& A) {
    const float* H1 = (const float*)(A.ws + WS_H1); const unsigned char* U8 = A.ws + WS_UTAB; const unsigned char* V8 = A.ws + WS_VTAB; const float* SU = (const float*)(A.ws + WS_SU);
    const int* IDX = (const int*)(A.ws + WS_IDX); const float* GATE = (const float*)(A.ws + WS_GATE);
    const int gw = F.bid * NWAVES + F.wave, NGW = F.G * NWAVES;
    LAS unsigned char* wl = F.lds + F.wave * PEER_WAVE_LDS;
    LAS unsigned* list = (LAS unsigned*)wl;
    LAS unsigned* cnt = (LAS unsigned*)(wl + PNPAD * 8);
    for (int grp = gw; grp < M / PNT; grp += NGW) { const int tok0 = grp * PNT; int lane = (int)__builtin_amdgcn_mbcnt_hi(~0u, __builtin_amdgcn_mbcnt_lo(~0u, 0u)); asm volatile("" : "+v"(lane));
        cnt[lane] = 0u; cnt[64 + lane] = 0u;
        int ev[2 * PNT]; float gv[2 * PNT], sv[2 * PNT];
#pragma unroll
        for (int q = 0; q < 2 * PNT; ++q) { ev[q] = IDX[(size_t)(tok0 + (q >> 1)) * 128 + (q & 1) * 64 + lane]; gv[q] = GATE[(size_t)(tok0 + (q >> 1)) * 128 + (q & 1) * 64 + lane]; }
#pragma unroll
        for (int q = 0; q < 2 * PNT; ++q) sv[q] = SU[ev[q]];
        LDS_WAIT(); asm volatile("" ::: "memory");
#pragma unroll
        for (int q = 0; q < 2 * PNT; ++q) __hip_atomic_fetch_add(cnt + (ev[q] >> 7), 1u, __ATOMIC_RELAXED, __HIP_MEMORY_SCOPE_WORKGROUP);
        LDS_WAIT(); asm volatile("" ::: "memory");
        { const unsigned a = cnt[2 * lane], b = cnt[2 * lane + 1]; unsigned inc = a + b;
#pragma unroll
          for (int o = 1; o < 64; o <<= 1) { const unsigned t = __shfl_up(inc, o); if (lane >= o) inc += t; }
          const unsigned ex = inc - (a + b); cnt[2 * lane] = ex; cnt[2 * lane + 1] = ex + a; }
        LDS_WAIT(); asm volatile("" ::: "memory");
#pragma unroll
        for (int q = 0; q < 2 * PNT; ++q) { const unsigned pos = __hip_atomic_fetch_add(cnt + (ev[q] >> 7), 1u, __ATOMIC_RELAXED, __HIP_MEMORY_SCOPE_WORKGROUP);
            const unsigned short gh = __builtin_bit_cast(unsigned short, (_Float16)gv[q]);
            list[2 * pos] = (unsigned)ev[q] | ((unsigned)(q >> 1) << 14) | ((unsigned)gh << 16); list[2 * pos + 1] = __float_as_uint(sv[q]); }
        if (lane < PNPAD - PNP) { list[2 * (PNP + lane)] = 0u; list[2 * (PNP + lane) + 1] = 0u; }
        LDS_WAIT(); asm volatile("" ::: "memory");
        unsigned xq[PNT][8]; float sx[PNT];
#pragma unroll
        for (int k = 0; k < PNT; ++k) { const float* hr = H1 + (size_t)(tok0 + k) * D + lane * 16; f32x4 x[8]; float am = 0.f;
#pragma unroll
            for (int i = 0; i < 8; ++i) { x[i] = *(const f32x4*)(hr + (i >> 2) * 1024 + (i & 3) * 4); am = fmaxf(am, fmaxf(fmaxf(fabsf(x[i].x), fabsf(x[i].y)), fmaxf(fabsf(x[i].z), fabsf(x[i].w)))); }
#pragma unroll
            for (int o = 1; o < 64; o <<= 1) am = fmaxf(am, __shfl_xor(am, o));
            const float sc = (am > 0.f) ? am * (1.f / 127.f) : 1.f, inv = 1.f / sc; sx[k] = __builtin_bit_cast(float, __builtin_amdgcn_readfirstlane(__builtin_bit_cast(int, sc)));
#pragma unroll
            for (int i = 0; i < 8; ++i) { const int a = (int)rintf(x[i].x * inv), b = (int)rintf(x[i].y * inv), c = (int)rintf(x[i].z * inv), d = (int)rintf(x[i].w * inv);
                xq[k][i] = (unsigned)(a & 255) | ((unsigned)(b & 255) << 8) | ((unsigned)(c & 255) << 16) | ((unsigned)(d & 255) << 24); }
            asm volatile("" ::: "memory"); }
        float acc[PNT][32];
#pragma unroll
        for (int k = 0; k < PNT; ++k)
#pragma unroll
            for (int i = 0; i < 32; ++i) acc[k][i] = 0.f;
        v4u ru0[PRD], ru1[PRD], rv0[PRD], rv1[PRD];
#define PEER_LOAD(slot, n) do { const unsigned e_ = (unsigned)__builtin_amdgcn_readfirstlane((int)list[2 * (n)]) & (DUMMY ? 0xffu : 0x3fffu); \
        const unsigned char* up_ = U8 + (size_t)e_ * D + lane * 16; const unsigned char* vp_ = V8 + (size_t)e_ * D + lane * 16; \
        ru0[slot] = *(const v4u*)up_; ru1[slot] = *(const v4u*)(up_ + 1024); rv0[slot] = *(const v4u*)vp_; rv1[slot] = *(const v4u*)(vp_ + 1024); } while (0)
#define PEER_CORE(k, slot) do { int d_ = 0; \
        d_ = __builtin_amdgcn_sdot4((int)ru0[slot].x, (int)xq[k][0], d_, false); d_ = __builtin_amdgcn_sdot4((int)ru0[slot].y, (int)xq[k][1], d_, false); d_ = __builtin_amdgcn_sdot4((int)ru0[slot].z, (int)xq[k][2], d_, false); d_ = __builtin_amdgcn_sdot4((int)ru0[slot].w, (int)xq[k][3], d_, false); \
        d_ = __builtin_amdgcn_sdot4((int)ru1[slot].x, (int)xq[k][4], d_, false); d_ = __builtin_amdgcn_sdot4((int)ru1[slot].y, (int)xq[k][5], d_, false); d_ = __builtin_amdgcn_sdot4((int)ru1[slot].z, (int)xq[k][6], d_, false); d_ = __builtin_amdgcn_sdot4((int)ru1[slot].w, (int)xq[k][7], d_, false); \
        d_ = wave_total_i32(d_); const float z_ = (float)d_ * su * sx[k]; const float s_ = gate * gelu_tanh(z_); \
        v4u v0 = rv0[slot], v1 = rv1[slot]; asm volatile("" : "+v"(v0), "+v"(v1));     \
        _Pragma("unroll") for (int i = 0; i < 4; ++i) { const f32x2 a_ = __builtin_amdgcn_cvt_pk_f32_fp8((int)v0[i], false), b_ = __builtin_amdgcn_cvt_pk_f32_fp8((int)v0[i], true); \
            acc[k][4 * i] += s_ * a_.x; acc[k][4 * i + 1] += s_ * a_.y; acc[k][4 * i + 2] += s_ * b_.x; acc[k][4 * i + 3] += s_ * b_.y; } \
        _Pragma("unroll") for (int i = 0; i < 4; ++i) { const f32x2 a_ = __builtin_amdgcn_cvt_pk_f32_fp8((int)v1[i], false), b_ = __builtin_amdgcn_cvt_pk_f32_fp8((int)v1[i], true); \
            acc[k][16 + 4 * i] += s_ * a_.x; acc[k][16 + 4 * i + 1] += s_ * a_.y; acc[k][16 + 4 * i + 2] += s_ * b_.x; acc[k][16 + 4 * i + 3] += s_ * b_.y; } } while (0)
#pragma unroll
        for (int s_i = 0; s_i < PRD; ++s_i) PEER_LOAD(s_i, s_i);
        for (int n0 = 0; n0 < PNPAD; n0 += PRD) {
#pragma unroll
            for (int s_i = 0; s_i < PRD; ++s_i) { const int n = n0 + s_i;
                const unsigned ent = (unsigned)__builtin_amdgcn_readfirstlane((int)list[2 * n]); const float su = __builtin_bit_cast(float, __builtin_amdgcn_readfirstlane((int)list[2 * n + 1]));
                const int tk = (int)((ent >> 14) & 3u); const float gate = (float)__builtin_bit_cast(_Float16, (unsigned short)(ent >> 16));
                if (tk == 0) PEER_CORE(0, s_i); else PEER_CORE(1, s_i);
                const int nn = (n + PRD < PNPAD) ? (n + PRD) : (PNPAD - 1);
                PEER_LOAD(s_i, nn); } }
#undef PEER_LOAD
#undef PEER_CORE
        asm volatile("" : "+v"(lane));
#pragma unroll
        for (int k = 0; k < PNT; ++k) { const size_t ro = (size_t)(tok0 + k) * D + lane * 16; float y[32]; float s1 = 0.f;
#pragma unroll
            for (int i = 0; i < 8; ++i) { const f32x4 h = *(const f32x4*)(H1 + ro + (i >> 2) * 1024 + (i & 3) * 4);
#pragma unroll
                for (int c = 0; c < 4; ++c) { y[4 * i + c] = ALPHA * h[c] + acc[k][4 * i + c]; s1 += y[4 * i + c]; } }
            const float mean = wave_sum(s1) * (1.f / D); float s2 = 0.f;
#pragma unroll
            for (int i = 0; i < 32; ++i) { y[i] -= mean; s2 += y[i] * y[i]; }
            const float rstd = 1.f / sqrtf(wave_sum(s2) * (1.f / D) + LN_EPS);
#pragma unroll
            for (int i = 0; i < 8; ++i) { const int co = lane * 16 + (i >> 2) * 1024 + (i & 3) * 4; const f32x4 g = *(const f32x4*)(A.in[I_LN2G] + co), bb = *(const f32x4*)(A.in[I_LN2B] + co); f32x4 r;
#pragma unroll
                for (int c = 0; c < 4; ++c) r[c] = y[4 * i + c] * rstd * g[c] + bb[c];
                if (!DUMMY) *(f32x4*)(A.out + (size_t)(tok0 + k) * D + co) = r; else asm volatile("" :: "v"(r)); }
            asm volatile("" ::: "memory"); }
        asm volatile("s_waitcnt vmcnt(0) lgkmcnt(0)" ::: "memory");
    }
}

__global__ void __launch_bounds__(NWAVES * 64, 2) fwd_kernel(Args args) {
    extern __shared__ __attribute__((aligned(16))) unsigned char lds[];
    Frame F;
    F.lds = (LAS unsigned char*)lds;
    F.MISC = (volatile LAS unsigned*)(F.lds + MISC_OFF);
    F.tid = threadIdx.x; F.lane = F.tid & 63; F.wave = __builtin_amdgcn_readfirstlane(F.tid >> 6);
    F.G = gridDim.x; F.bid = blockIdx.x;
    unsigned char* ws = args.ws;
    F.ctl = (gu32*)(ws + WS_CTL);
    for (int u = F.tid; u < (LDS_BYTES - LDSCTL_OFF) / 4; u += NWAVES * 64) ((LAS unsigned*)(F.lds + LDSCTL_OFF))[u] = 0u;
    __syncthreads();
    XcdBarrier bar; bar.bar = (unsigned*)(F.ctl + CW_BAR); bar.x = 0; bar.st = nullptr;
    if (!MK_PER_PHASE) bar = xcd_barrier_post((unsigned*)(F.ctl + CW_BAR), F.MISC + 8);
    const int lo = args.ph_lo, hi = args.ph_hi;
#ifndef PHMASK
#define PHMASK 0xFFFF
#endif
#define IN(k) (((PHMASK >> (k)) & 1) && lo <= (k) && (k) < hi)
#ifndef PROBE_DUP
#define PROBE_DUP -1
#endif
#define SEAM(k) do { if (IN(k) && IN((k) + 1)) xcd_barrier(bar); } while (0)
#define REP(k) for (int rep_ = 0; rep_ < ((PROBE_DUP == (k)) ? 2 : 1); ++rep_, ((PROBE_DUP == (k) && rep_ == 1) ? xcd_barrier(bar) : (void)0))
    typedef pg8::bf16_t pb;
    pb* XB = (pb*)(ws + WS_XB); pb* WIN = (pb*)(ws + WS_WIN); pb* U = (pb*)(ws + WS_U); pb* Gt = (pb*)(ws + WS_G); pb* MT = (pb*)(ws + WS_MT);
    pb* PRW = (pb*)(ws + WS_PRW); pb* YS = (pb*)(ws + WS_YS); pb* CAT = (pb*)(ws + WS_CAT); pb* AL = (pb*)(ws + WS_ALORA); pb* LO = (pb*)(ws + WS_LORA);
    pb* WGLU = (pb*)(ws + WS_WGLU); pb* WOUT = (pb*)(ws + WS_WOUT); pb* WQK = (pb*)(ws + WS_WQK); pb* WL = (pb*)(ws + WS_WLORA); pb* H1B = (pb*)(ws + WS_H1B);

    if (IN(0)) REP(0) { p0_prologue(F, args); } SEAM(0);
    if (IN(1)) REP(1) {
        pg8::Gemm g{XB, WIN, 2048, 2048, 2048}; pg8::StaticOrder S; S.init(M, INP, F.G, F.bid); pg8::EpiProj E{U, PRW};
        pg8::gemm_phase<pg8::EpiProj, pg8::StaticOrder, true, true>(F.lds + RING_OFF, g, S, E);
        s5_params(F, args, 64); } SEAM(1);
    if (IN(2)) REP(2) {
        pg8::Gemm g{U, Gt, 512, 640, 512}; pg8::OneUnit S{F.bid < 64 ? F.bid : -1, F.bid >> 1}; pg8::EpiSa E{U, (const float*)(ws + WS_A32)};
        pg8::gemm_phase<pg8::EpiSa, pg8::OneUnit, false, true>(F.lds + RING_OFF, g, S, E);
        r1_lora_in(F, args); } SEAM(2);
    if (IN(3)) REP(3) {
        { pg8::Gemm g{U, MT, 640, 640, 640}; pg8::OneUnit S{F.bid < 128 ? (F.bid >> 1) : -1, F.bid}; pg8::EpiY E{YS};
          pg8::gemm_phase<pg8::EpiY, pg8::OneUnit, false, true>(F.lds + RING_OFF, g, S, E); }
        { pg8::Gemm g{AL, WL, 384, 384, 384}; pg8::ListOrder S{F.bid < 128 ? 256 + F.bid : F.bid - 128, F.bid < 128 ? -1 : F.bid, 32}; pg8::EpiStoreBf16 E{LO, 3072};
          pg8::gemm_phase<pg8::EpiStoreBf16, pg8::ListOrder, true, true>(F.lds + RING_OFF, g, S, E); } } SEAM(3);
    if (IN(4)) REP(4) { r3_prep(F, args); } SEAM(4);
    if (IN(5)) REP(5) {
        { const int L = F.bid - 128; pg8::Gemm g{YS, WGLU, 1024, 1024, 1024}; pg8::OneUnit S{L >= 0 ? (L & 31) : -1, L >> 5}; pg8::EpiGLU E{YS, args.in[I_BGLU], CAT};
          pg8::gemm_phase<pg8::EpiGLU, pg8::OneUnit, false, true>(F.lds + RING_OFF, g, S, E); }
        r4_scan(F, args); peer_tables(F, args, 128, F.G - 128); deferred_weights(F, args, 128, F.G - 128); } SEAM(5);
    if (IN(6)) REP(6) { r5_post(F, args); } SEAM(6);
    if (IN(7)) REP(7) {
        pg8::Gemm g{CAT, WOUT, 2048, 2048, 2048}; pg8::StaticOrder S; S.init(M, D, F.G, F.bid); pg8::EpiF32 E{(float*)(ws + WS_Z), args.in[I_X], D, ALPHA};
        pg8::gemm_phase<pg8::EpiF32, pg8::StaticOrder, true, true>(F.lds + RING_OFF, g, S, E); } SEAM(7);
    if (IN(8)) REP(8) { ln1_rows(F, args); } SEAM(8);
    if (IN(9)) REP(9) {
        pg8::Gemm g{H1B, WQK, 2048, 2048, 2048}; pg8::StaticOrder S; S.init(M, D, F.G, F.bid); pg8::EpiF32 E{(float*)(ws + WS_SC), nullptr, D, 0.f};
        pg8::gemm_phase<pg8::EpiF32, pg8::StaticOrder, true, true>(F.lds + RING_OFF, g, S, E); } SEAM(9);
    if (IN(10)) REP(10) { topk_phase(F, args); } SEAM(10);
    if (IN(11)) REP(11) { peer_phase<false>(F, args); }
#undef IN
#undef SEAM
}

extern "C" void kernel_launch(void* const* d_in, const int* in_sizes, int n_in, void* d_out, int out_size, void* d_ws, size_t ws_size, hipStream_t stream) {
    static int grid = 0;
    if (grid == 0) {
        if (n_in != 33 || in_sizes[0] != M * D || out_size != M * D || ws_size < WS_END) { fprintf(stderr, "kernel_launch: unexpected shapes (n_in %d, in0 %d, out %d, ws %zu)\n", n_in, n_in > 0 ? in_sizes[0] : -1, out_size, ws_size); grid = -1; return; }
        int dev = 0, cus = 0, per_cu = 0;
        if (hipGetDevice(&dev) != hipSuccess || hipDeviceGetAttribute(&cus, hipDeviceAttributeMultiprocessorCount, dev) != hipSuccess) { grid = -1; return; }
        if (hipFuncSetAttribute((const void*)fwd_kernel, hipFuncAttributeMaxDynamicSharedMemorySize, LDS_BYTES) != hipSuccess) { fprintf(stderr, "kernel_launch: hipFuncSetAttribute failed\n"); grid = -1; return; }
        if (hipOccupancyMaxActiveBlocksPerMultiprocessor(&per_cu, (const void*)fwd_kernel, NWAVES * 64, LDS_BYTES) != hipSuccess || per_cu < 1) { fprintf(stderr, "kernel_launch: occupancy query says %d blocks per CU\n", per_cu); per_cu = 1; }
        (void)hipGetLastError();
        grid = cus;
        if (grid != 256) fprintf(stderr, "kernel_launch: %d CUs (built for 256)\n", grid);
    }
    if (grid < 0) return;
    (void)hipMemsetAsync((char*)d_ws + WS_CTL, 0, CTL_ZERO_BYTES, stream);
    Args a{};
    for (int i = 0; i < 33; ++i) a.in[i] = (const float*)d_in[i];
    a.out = (float*)d_out; a.ws = (unsigned char*)d_ws; a.dup = PROBE_DUP;
#if MK_PER_PHASE
    for (int li = 0; li < NPHASE; ++li) { a.ph_lo = li; a.ph_hi = li + 1; a.li = li; hipLaunchKernelGGL(fwd_kernel, dim3(grid), dim3(NWAVES * 64), LDS_BYTES, stream, a); }
#else
    a.ph_lo = 0; a.ph_hi = NPHASE; a.li = 0;
    void* kargs[] = {(void*)&a};
    hipError_t e = hipLaunchCooperativeKernel((const void*)fwd_kernel, dim3(grid), dim3(NWAVES * 64), kargs, LDS_BYTES, stream);
    if (e != hipSuccess) fprintf(stderr, "kernel_launch: cooperative launch failed: %s\n", hipGetErrorString(e));
#endif
}
```

```cpp
#include <hip/hip_runtime.h>
#include <cstdio>
#include <cstdint>
#include <cmath>
namespace pg8 {
#define PG8_LAS __attribute__((address_space(3)))
typedef unsigned short bf16_t;
typedef short bf16x8 __attribute__((ext_vector_type(8)));
typedef float f32x4 __attribute__((ext_vector_type(4)));
typedef float f32x2 __attribute__((ext_vector_type(2)));
typedef unsigned u32x4 __attribute__((ext_vector_type(4)));
constexpr int BM = 256, BK = 64, HALF = 128, HTB = HALF * BK * 2  , STAGE_BYTES = 8 * HTB, NXCD = 8, WGM = 8;

__host__ __device__ __forceinline__ int lds_byte(int r, int c) { const int st = (r >> 4) * 2 + (c >> 5), rr = r & 15, cc = c & 31, ob = rr * 64 + cc * 2; return st * 1024 + (ob ^ (((ob >> 9) & 1) << 5)); }
__host__ __device__ __forceinline__ void stage_rc(int b, int& R, int& C) { const int st = b / 1024, sb = b % 1024, swz = sb ^ (((sb >> 9) & 1) << 5); R = (st >> 1) * 16 + swz / 64; C = (st & 1) * 32 + (swz % 64) / 2; }
__host__ __device__ __forceinline__ int perm32(int rho) { const int n = rho >> 4, i = rho & 15; return 8 * (i >> 2) + 4 * n + (i & 3); }

struct Unit { int pm, pn; };
struct Gemm { const bf16_t* A; const bf16_t* Bt; int K, lda, ldb; };

struct StaticOrder {
    int nM, nN, nwg, G, c;
    __host__ __device__ void init(int M, int N, int G_, int c_) { nM = M / BM; nN = N / BM; nwg = nM * nN; G = G_; c = c_; }
    __host__ __device__ bool next(int i, Unit& u) const {
        const long L = (long)i * G + c; if (L >= nwg) return false;
        int wgid = (int)L; { const int q = nwg / NXCD, r = nwg % NXCD, xcd = wgid % NXCD, off = wgid / NXCD; wgid = (xcd < r ? xcd * (q + 1) : r * (q + 1) + (xcd - r) * q) + off; }
        const int nig = WGM * nN, gid = wgid / nig, fm = gid * WGM, gsz = (nM - fm) < WGM ? (nM - fm) : WGM;
        u.pm = fm + ((wgid % nig) % gsz); u.pn = (wgid % nig) / gsz; return true;
    }
    __device__ __forceinline__ void a_ready(const Unit&) const {}
    __device__ __forceinline__ void done(const Unit&) const {}
};
struct ListOrder {
    int L0, L1, nM;
    __device__ bool next(int i, Unit& u) const { const int L = (i == 0) ? L0 : ((i == 1) ? L1 : -1); if (L < 0) return false; u.pm = L % nM; u.pn = L / nM; return true; }
    __device__ __forceinline__ void a_ready(const Unit&) const {}
    __device__ __forceinline__ void done(const Unit&) const {}
};
struct OneUnit {
    int pm, pn;
    __device__ bool next(int i, Unit& u) const { if (i != 0 || pm < 0) return false; u.pm = pm; u.pn = pn; return true; }
    __device__ __forceinline__ void a_ready(const Unit&) const {}
    __device__ __forceinline__ void done(const Unit&) const {}
};

__device__ __forceinline__ unsigned cvt_pk_bf16(float lo, float hi) { unsigned r; asm volatile("v_cvt_pk_bf16_f32 %0, %1, %2" : "=v"(r) : "v"(lo), "v"(hi)); return r; }
__device__ __forceinline__ float bf_lo(unsigned w) { return __uint_as_float(w << 16); }
__device__ __forceinline__ float bf_hi(unsigned w) { return __uint_as_float(w & 0xffff0000u); }
__device__ __forceinline__ float gelu_tanh(float x) { const float y = 0.7978845608f * (x + 0.044715f * x * x * x); return x * __builtin_amdgcn_rcpf(1.0f + __expf(-2.0f * y)); }
__device__ __forceinline__ float sigmoidf(float x) { return __builtin_amdgcn_rcpf(1.0f + __expf(-x)); }

__device__ __forceinline__ u32x4 pack8(const f32x4 v0, const f32x4 v1) { u32x4 w; w.x = cvt_pk_bf16(v0[0], v0[1]); w.y = cvt_pk_bf16(v0[2], v0[3]); w.z = cvt_pk_bf16(v1[0], v1[1]); w.w = cvt_pk_bf16(v1[2], v1[3]); return w; }

struct EpiStoreBf16 {
    static constexpr bool PERM = true, AFTER_DRAIN = false;
    bf16_t* O; int ldc;
    __device__ __forceinline__ void operator()(const f32x4 (&acc)[2][2][4][2], const Unit& u, int wr, int wc, int fr, int fq) const {
        const int row0 = u.pm * BM + wr * 64 + fr, col0 = u.pn * BM + wc * 32 + 8 * fq;
#pragma unroll
        for (int ai = 0; ai < 2; ++ai)
#pragma unroll
            for (int m = 0; m < 4; ++m) { bf16_t* rowp = O + (size_t)(row0 + ai * HALF + m * 16) * ldc + col0;
#pragma unroll
                for (int bj = 0; bj < 2; ++bj) *(u32x4*)(rowp + bj * HALF) = pack8(acc[ai][bj][m][0], acc[ai][bj][m][1]); }
    }
};
struct EpiProj {
    static constexpr bool PERM = true, AFTER_DRAIN = false;
    bf16_t* U; bf16_t* PRW;
    __device__ __forceinline__ void operator()(const f32x4 (&acc)[2][2][4][2], const Unit& u, int wr, int wc, int fr, int fq) const {
        const int row0 = u.pm * BM + wr * 64 + fr, col0 = u.pn * BM + wc * 32 + 8 * fq;
#pragma unroll
        for (int ai = 0; ai < 2; ++ai)
#pragma unroll
            for (int m = 0; m < 4; ++m) { const int row = row0 + ai * HALF + m * 16;
#pragma unroll
                for (int bj = 0; bj < 2; ++bj) { const int col = col0 + bj * HALF; const u32x4 w = pack8(acc[ai][bj][m][0], acc[ai][bj][m][1]);
                    if (u.pn < 4) { const int g = col >> 4, h0 = col & 15, b = row >> 11, t = row & 2047, c = t >> 5, s = t & 31;
                        *(u32x4*)(U + (size_t)(g * 256 + b * 64 + c) * 640 + s * 16 + h0) = w; }
                    else *(u32x4*)(PRW + (size_t)row * 3584 + (col - 1024)) = w; } }
    }
};
struct EpiY {
    static constexpr bool PERM = true, AFTER_DRAIN = false;
    bf16_t* YS;
    __device__ __forceinline__ void operator()(const f32x4 (&acc)[2][2][4][2], const Unit& u, int wr, int wc, int fr, int fq) const {
        const int g = u.pm, j = u.pn & 1;
#pragma unroll
        for (int ai = 0; ai < 2; ++ai)
#pragma unroll
            for (int m = 0; m < 4; ++m) { const int rowl = ai * HALF + wr * 64 + m * 16 + fr, b = rowl >> 6, c = rowl & 63;
#pragma unroll
                for (int bj = 0; bj < 2; ++bj) { const int n = 256 * j + bj * HALF + wc * 32 + 8 * fq, tl = n >> 4, h0 = n & 15;
                    f32x4 v0 = acc[ai][bj][m][0], v1 = acc[ai][bj][m][1];
#pragma unroll
                    for (int e = 0; e < 4; ++e) { v0[e] = gelu_tanh(v0[e]); v1[e] = gelu_tanh(v1[e]); }
                    *(u32x4*)(YS + (size_t)(b * 2048 + c * 32 + tl) * 1024 + g * 16 + h0) = pack8(v0, v1); }
                asm volatile("" ::: "memory"); }
    }
};
struct EpiGLU {
    static constexpr bool PERM = true, AFTER_DRAIN = false;
    const bf16_t* YS; const float* bglu; bf16_t* CAT;
    __device__ __forceinline__ void operator()(const f32x4 (&acc)[2][2][4][2], const Unit& u, int wr, int wc, int fr, int fq) const {
        const int row0 = u.pm * BM + wr * 64 + fr, col0 = u.pn * BM + wc * 32 + 8 * fq;
#pragma unroll
        for (int bj = 0; bj < 2; ++bj) { const int col = col0 + bj * HALF; const f32x4 b0 = *(const f32x4*)(bglu + col), b1 = *(const f32x4*)(bglu + col + 4);
#pragma unroll
            for (int ai = 0; ai < 2; ++ai)
#pragma unroll
                for (int m = 0; m < 4; ++m) { const int row = row0 + ai * HALF + m * 16; const u32x4 y = *(const u32x4*)(YS + (size_t)row * 1024 + col);
                    const f32x4 a0 = acc[ai][bj][m][0] + b0, a1 = acc[ai][bj][m][1] + b1; f32x4 o0, o1;
                    o0[0] = bf_lo(y.x) * sigmoidf(a0[0]); o0[1] = bf_hi(y.x) * sigmoidf(a0[1]); o0[2] = bf_lo(y.y) * sigmoidf(a0[2]); o0[3] = bf_hi(y.y) * sigmoidf(a0[3]);
                    o1[0] = bf_lo(y.z) * sigmoidf(a1[0]); o1[1] = bf_hi(y.z) * sigmoidf(a1[1]); o1[2] = bf_lo(y.w) * sigmoidf(a1[2]); o1[3] = bf_hi(y.w) * sigmoidf(a1[3]);
                    *(u32x4*)(CAT + (size_t)row * 2048 + col) = pack8(o0, o1); } }
    }
};
struct EpiF32 {
    static constexpr bool PERM = false, AFTER_DRAIN = false;
    float* O; const float* R; int ldc; float alpha;
    __device__ __forceinline__ void operator()(const f32x4 (&acc)[2][2][4][2], const Unit& u, int wr, int wc, int fr, int fq) const {
        const int row0 = u.pm * BM + wr * 64 + fr, col0 = u.pn * BM + wc * 32 + 4 * fq;
#pragma unroll
        for (int ai = 0; ai < 2; ++ai)
#pragma unroll
            for (int m = 0; m < 4; ++m) { const size_t off = (size_t)(row0 + ai * HALF + m * 16) * ldc + col0;
#pragma unroll
                for (int bj = 0; bj < 2; ++bj)
#pragma unroll
                    for (int n = 0; n < 2; ++n) { f32x4 o = acc[ai][bj][m][n]; if (R) { const f32x4 r = *(const f32x4*)(R + off + bj * HALF + n * 16); o = o + r * alpha; }
                        *(f32x4*)(O + off + bj * HALF + n * 16) = o; } }
    }
};
struct EpiSa {
    static constexpr bool PERM = false, AFTER_DRAIN = true;
    bf16_t* U; const float* A32;
    __device__ __forceinline__ void fused(const f32x4 (&acc)[2][2][4][2], const Unit& u, int wr, int wc, int fr, int fq, PG8_LAS unsigned char* lds, int wid, int lane) const {
        const int g = u.pm, gb = g & 1;
        PG8_LAS float* SL = (PG8_LAS float*)lds;
#pragma unroll
        for (int ai = 0; ai < 2; ++ai)
#pragma unroll
            for (int m = 0; m < 4; ++m) { const int rowl = ai * HALF + wr * 64 + m * 16 + fr;
#pragma unroll
                for (int bj = 0; bj < 2; ++bj) if (bj == gb) {
#pragma unroll
                    for (int n = 0; n < 2; ++n) *(PG8_LAS f32x4*)(SL + rowl * 128 + wc * 32 + n * 16 + 4 * fq) = acc[ai][bj][m][n]; } }
        asm volatile("s_waitcnt lgkmcnt(0)" ::: "memory"); __builtin_amdgcn_s_barrier(); asm volatile("" ::: "memory");
        const int tid = wid * 64 + lane;
        if (tid < 256) { const int b = tid >> 6, p = tid & 63; const float ar = A32[(g * 64 + p) * 2], ai_ = A32[(g * 64 + p) * 2 + 1]; float hr = 0.f, hi = 0.f;
            for (int c = 0; c < 64; ++c) { bf16_t* up = U + (size_t)(g * 256 + b * 64 + c) * 640 + 512 + p;
                const unsigned pk = cvt_pk_bf16(hr, hi); up[0] = (bf16_t)(pk & 0xffffu); up[64] = (bf16_t)(pk >> 16);
                const float sr = SL[(b * 64 + c) * 128 + p], si = SL[(b * 64 + c) * 128 + 64 + p];
                const float nr = ar * hr - ai_ * hi + sr, ni = ar * hi + ai_ * hr + si; hr = nr; hi = ni; } }
    }
};

template <class Epi, class Sched, bool ALIGN_EPI = false, bool SP2 = false>
__device__ __forceinline__ void gemm_phase(PG8_LAS unsigned char* lds, const Gemm g, const Sched& S, const Epi& E) {
    const int tid = threadIdx.x, wid = __builtin_amdgcn_readfirstlane(tid >> 6), lane = tid & 63, wr = wid >> 2, wc = wid & 3, fr = lane & 15, fq = lane >> 4;
    const int K = g.K, nt = K / BK;
    unsigned voffA[2], voffB[2];
#pragma unroll
    for (int i = 0; i < 2; ++i) { int R, C; stage_rc(tid * 16 + i * 8192, R, C); const int Rb = Epi::PERM ? ((R & ~31) + perm32(R & 31)) : R;
        voffA[i] = (unsigned)(R * g.lda + C) * 2u; voffB[i] = (unsigned)(Rb * g.ldb + C) * 2u; }
    const size_t kstep = (size_t)(BK * 2);
    const size_t hsA = (size_t)HALF * g.lda * 2, hsB = (size_t)HALF * g.ldb * 2;
    const size_t tsA = 2 * hsA, tsB = 2 * hsB;
    const unsigned ldsw = (unsigned)wid * 1024u;
    const int aoff = lds_byte(wr * 64 + fr, fq * 8), boff = lds_byte(wc * 32 + fr, fq * 8);
#define PG8_SA(b, h) (((b) * 2 + (h)) * HTB)
#define PG8_SB(b, h) ((4 + (b) * 2 + (h)) * HTB)
#define PG8_STAGE(bufoff, gbase, voff) do { _Pragma("unroll") for (int _i = 0; _i < 2; ++_i) \
        __builtin_amdgcn_global_load_lds((const unsigned*)((const char*)(gbase) + (voff)[_i]), (PG8_LAS unsigned*)(lds + (bufoff) + ldsw + _i * 8192), 16, 0, 0); } while (0)
#define PG8_LDA(dst, b, h) do { _Pragma("unroll") for (int m = 0; m < 4; ++m) _Pragma("unroll") for (int k = 0; k < 2; ++k) dst[m][k] = *(const PG8_LAS bf16x8*)(lds + PG8_SA(b, h) + aoff + m * 2048 + k * 1024); } while (0)
#define PG8_LDB(dst, b, h) do { _Pragma("unroll") for (int n = 0; n < 2; ++n) _Pragma("unroll") for (int k = 0; k < 2; ++k) dst[n][k] = *(const PG8_LAS bf16x8*)(lds + PG8_SB(b, h) + boff + n * 2048 + k * 1024); } while (0)
#define PG8_MMA(ai, bj, At, Bt) do { __builtin_amdgcn_s_setprio(1); _Pragma("unroll") for (int m = 0; m < 4; ++m) _Pragma("unroll") for (int n = 0; n < 2; ++n) _Pragma("unroll") for (int k = 0; k < 2; ++k) \
        acc[ai][bj][m][n] = __builtin_amdgcn_mfma_f32_16x16x32_bf16(Bt[n][k], At[m][k], acc[ai][bj][m][n], 0, 0, 0); __builtin_amdgcn_s_setprio(0); } while (0)
#define PG8_WAIT_V(n) asm volatile("s_waitcnt vmcnt(" #n ")" ::: "memory")
#define PG8_WAIT_L(n) asm volatile("s_waitcnt lgkmcnt(" #n ")" ::: "memory")
#define PG8_BAR __builtin_amdgcn_s_barrier()
#define PG8_SCHED __builtin_amdgcn_sched_barrier(0)
    Unit cur, nxt; int ui = 0;
    if (!S.next(0, cur)) return;
    f32x4 acc[2][2][4][2];
#pragma unroll
    for (int a = 0; a < 2; ++a)
#pragma unroll
        for (int b = 0; b < 2; ++b)
#pragma unroll
            for (int m = 0; m < 4; ++m)
#pragma unroll
                for (int n = 0; n < 2; ++n) acc[a][b][m][n] = (f32x4){0.f, 0.f, 0.f, 0.f};
    bf16x8 At[4][2], B0[2][2], B1[2][2];
    const char* cA = (const char*)g.A + (size_t)cur.pm * tsA; const char* cB = (const char*)g.Bt + (size_t)cur.pn * tsB;
    S.a_ready(cur);
    if constexpr (SP2) {
        PG8_STAGE(PG8_SB(0, 0), cB, voffB); PG8_STAGE(PG8_SB(0, 1), cB + hsB, voffB); PG8_STAGE(PG8_SA(0, 0), cA, voffA); PG8_STAGE(PG8_SA(0, 1), cA + hsA, voffA);
        if (wr == 1) PG8_BAR;
        PG8_WAIT_V(2); PG8_BAR;
        PG8_STAGE(PG8_SB(1, 0), cB + kstep, voffB); PG8_STAGE(PG8_SA(1, 0), cA + kstep, voffA); PG8_STAGE(PG8_SB(1, 1), cB + hsB + kstep, voffB);
        PG8_WAIT_V(6); PG8_BAR;
    } else {
        PG8_STAGE(PG8_SB(0, 0), cB, voffB); PG8_STAGE(PG8_SA(0, 0), cA, voffA); PG8_STAGE(PG8_SB(0, 1), cB + hsB, voffB); PG8_STAGE(PG8_SA(0, 1), cA + hsA, voffA);
        if (wr == 1) PG8_BAR;
        PG8_WAIT_V(4); PG8_BAR;
        PG8_STAGE(PG8_SB(1, 0), cB + kstep, voffB); PG8_STAGE(PG8_SA(1, 0), cA + kstep, voffA); PG8_STAGE(PG8_SB(1, 1), cB + hsB + kstep, voffB);
        PG8_WAIT_V(6); PG8_BAR;
    }
    for (;;) {
        const bool has_next = S.next(ui + 1, nxt);
        const char* nA = has_next ? (const char*)g.A + (size_t)nxt.pm * tsA : cA; const char* nB = has_next ? (const char*)g.Bt + (size_t)nxt.pn * tsB : cB;
#pragma nounroll
        for (int t = 0; t < nt; t += 2) {
            const bool last = (t == nt - 2);
            const char* a1 = cA + (size_t)(t + 1) * kstep;
            const char* a2 = last ? nA : cA + (size_t)(t + 2) * kstep; const char* b2 = last ? nB : cB + (size_t)(t + 2) * kstep;
            const char* a3 = a2 + kstep; const char* b3 = b2 + kstep;
            if (last && has_next) S.a_ready(nxt);
            if constexpr (SP2) {
            PG8_LDB(B0, 0, 0); PG8_LDB(B1, 0, 1); PG8_SCHED; PG8_LDA(At, 0, 0); PG8_STAGE(PG8_SA(1, 1), a1 + hsA, voffA);
            PG8_WAIT_V(8); PG8_WAIT_L(0); PG8_BAR; PG8_MMA(0, 0, At, B0); PG8_MMA(0, 1, At, B1); PG8_BAR; PG8_SCHED;
            PG8_LDA(At, 0, 1); PG8_STAGE(PG8_SB(0, 0), b2, voffB); PG8_STAGE(PG8_SB(0, 1), b2 + hsB, voffB); PG8_STAGE(PG8_SA(0, 0), a2, voffA);
            PG8_WAIT_V(8); PG8_WAIT_L(0); PG8_BAR; PG8_MMA(1, 0, At, B0); PG8_MMA(1, 1, At, B1); PG8_BAR; PG8_SCHED;
            PG8_LDB(B0, 1, 0); PG8_LDB(B1, 1, 1); PG8_SCHED; PG8_LDA(At, 1, 0); PG8_STAGE(PG8_SA(0, 1), a2 + hsA, voffA);
            PG8_WAIT_V(8); PG8_WAIT_L(0); PG8_BAR; PG8_MMA(0, 0, At, B0); PG8_MMA(0, 1, At, B1); PG8_BAR; PG8_SCHED;
            PG8_LDA(At, 1, 1); PG8_STAGE(PG8_SB(1, 0), b3, voffB); PG8_STAGE(PG8_SB(1, 1), b3 + hsB, voffB); PG8_STAGE(PG8_SA(1, 0), a3, voffA);
            PG8_WAIT_V(8); PG8_WAIT_L(0); PG8_BAR; PG8_MMA(1, 0, At, B0); PG8_MMA(1, 1, At, B1); PG8_BAR; PG8_SCHED;
            } else {
            PG8_LDB(B0, 0, 0); PG8_SCHED; PG8_LDA(At, 0, 0); PG8_STAGE(PG8_SA(1, 1), a1 + hsA, voffA);
            PG8_WAIT_L(8); PG8_BAR; PG8_WAIT_L(0); PG8_MMA(0, 0, At, B0); PG8_BAR; PG8_SCHED;
            PG8_LDB(B1, 0, 1); PG8_STAGE(PG8_SB(0, 0), b2, voffB);
            PG8_BAR; PG8_WAIT_L(0); PG8_MMA(0, 1, At, B1); PG8_BAR;
            PG8_LDA(At, 0, 1); PG8_STAGE(PG8_SA(0, 0), a2, voffA);
            PG8_BAR; PG8_WAIT_L(0); PG8_MMA(1, 0, At, B0); PG8_BAR; PG8_SCHED;
            PG8_STAGE(PG8_SB(0, 1), b2 + hsB, voffB);
            PG8_WAIT_V(6); PG8_BAR; PG8_MMA(1, 1, At, B1); PG8_BAR;
            PG8_LDB(B0, 1, 0); PG8_SCHED; PG8_LDA(At, 1, 0); PG8_STAGE(PG8_SA(0, 1), a2 + hsA, voffA);
            PG8_WAIT_L(8); PG8_BAR; PG8_WAIT_L(0); PG8_MMA(0, 0, At, B0); PG8_BAR; PG8_SCHED;
            PG8_LDB(B1, 1, 1); PG8_STAGE(PG8_SB(1, 0), b3, voffB);
            PG8_BAR; PG8_WAIT_L(0); PG8_MMA(0, 1, At, B1); PG8_BAR;
            PG8_LDA(At, 1, 1); PG8_STAGE(PG8_SA(1, 0), a3, voffA);
            PG8_BAR; PG8_WAIT_L(0); PG8_MMA(1, 0, At, B0); PG8_BAR; PG8_SCHED;
            PG8_STAGE(PG8_SB(1, 1), b3 + hsB, voffB);
            PG8_WAIT_V(6); PG8_BAR; PG8_MMA(1, 1, At, B1); PG8_BAR;
            }
        }
        if constexpr (ALIGN_EPI) { if (wr == 0) PG8_BAR; }
        if constexpr (!Epi::AFTER_DRAIN) { E(acc, cur, wr, wc, fr, fq); S.done(cur); }
        if (!has_next) break;
#pragma unroll
        for (int a = 0; a < 2; ++a)
#pragma unroll
            for (int b = 0; b < 2; ++b)
#pragma unroll
                for (int m = 0; m < 4; ++m)
#pragma unroll
                    for (int n = 0; n < 2; ++n) acc[a][b][m][n] = (f32x4){0.f, 0.f, 0.f, 0.f};
        cur = nxt; cA = nA; cB = nB; ++ui;
        if constexpr (ALIGN_EPI) { if (wr == 1) PG8_BAR; }
    }
    PG8_WAIT_V(0);
    if constexpr (!ALIGN_EPI) { if (wr == 0) PG8_BAR; }
    PG8_BAR;
    if constexpr (Epi::AFTER_DRAIN) { E.fused(acc, cur, wr, wc, fr, fq, lds, wid, lane); S.done(cur); }
#undef PG8_SA
#undef PG8_SB
#undef PG8_STAGE
#undef PG8_LDA
#undef PG8_LDB
#undef PG8_MMA
#undef PG8_WAIT_V
#undef PG8_WAIT_L
#undef PG8_BAR
#undef PG8_SCHED
}
}

constexpr int NWAVES = 8;
#ifndef MK_PER_PHASE
#define MK_PER_PHASE 0
#endif
constexpr int NPHASE = 12;
constexpr int M = 8192, D = 2048, SEQ = 2048;
constexpr int INC = 4384, INP = 4608;
constexpr float ALPHA = 1.189207115f;
constexpr float LN_EPS = 1e-5f, GN_EPS = 64e-5f;
constexpr size_t MiB = 1u << 20;
constexpr size_t WS_CTL = 0, CTL_ZERO_BYTES = 1 * MiB;
constexpr size_t WS_WGLU = 1 * MiB, WS_WOUT = 3 * MiB, WS_WQK = 11 * MiB, WS_WLORA = 19 * MiB, WS_IDX = 22 * MiB, WS_GATE = 26 * MiB, WS_A32 = 30 * MiB;
constexpr size_t WS_UTAB = 32 * MiB, WS_VTAB = 64 * MiB;
constexpr size_t WS_SU = 31 * MiB;
constexpr size_t WS_XB = 160 * MiB, WS_WIN = 192 * MiB, WS_U = 210 * MiB, WS_G = 230 * MiB, WS_MT = 238 * MiB;
constexpr size_t WS_SCAN = 160 * MiB;
constexpr size_t WS_PRW = 286 * MiB, WS_YS = 342 * MiB, WS_CAT = 358 * MiB, WS_ALORA = 390 * MiB, WS_LORA = 396 * MiB, WS_ORW = 444 * MiB;
constexpr size_t WS_Z = 160 * MiB, WS_H1 = 224 * MiB, WS_H1B = 288 * MiB, WS_SC = 390 * MiB;
constexpr size_t WS_END = 492 * MiB;
constexpr size_t WS_PHI = 272 * MiB, WS_PSI = 96 * MiB, WS_OM = 336 * MiB, WS_O0 = 476 * MiB, WS_G15 = 352 * MiB;
constexpr int RW_NC = SEQ / 16;
constexpr int SCAN_REC = 896;
constexpr int CW_BAR = 4096;
constexpr int RING_OFF = 0, RING_BYTES = 131072;
constexpr int LDS_BYTES = 147456;
constexpr int LDSCTL_OFF = LDS_BYTES - 1024, MISC_OFF = LDSCTL_OFF + 320;

#define GAS __attribute__((address_space(1)))
#define LAS __attribute__((address_space(3)))
typedef unsigned short bf16;
typedef unsigned v4u __attribute__((ext_vector_type(4)));
typedef float f32x4 __attribute__((ext_vector_type(4)));
typedef float f32x2 __attribute__((ext_vector_type(2)));
typedef _Float16 h16x2 __attribute__((ext_vector_type(2)));
typedef __bf16 bf16x2v __attribute__((ext_vector_type(2)));
typedef GAS unsigned gu32;
#define RLX_AGENT __ATOMIC_RELAXED, __HIP_MEMORY_SCOPE_AGENT
#define LDS_WAIT() asm volatile("s_waitcnt lgkmcnt(0)" ::: "memory")
#define VM_WAIT() asm volatile("s_waitcnt vmcnt(0)" ::: "memory")
__device__ __forceinline__ unsigned f2bf(float f) { unsigned u = __builtin_bit_cast(unsigned, f); return (u + 0x7fffu + ((u >> 16) & 1u)) >> 16; }
__device__ __forceinline__ unsigned pk2(float lo, float hi) { return f2bf(lo) | (f2bf(hi) << 16); }
__device__ __forceinline__ float bflo(unsigned w) { return __uint_as_float(w << 16); }
__device__ __forceinline__ float bfhi(unsigned w) { return __uint_as_float(w & 0xffff0000u); }
__device__ __forceinline__ float bf1(bf16 h) { return __uint_as_float((unsigned)h << 16); }
__device__ __forceinline__ unsigned pkh(float lo, float hi) { h16x2 v; v.x = (_Float16)lo; v.y = (_Float16)hi; return __builtin_bit_cast(unsigned, v); }
__device__ __forceinline__ float hlo(unsigned w) { return (float)__builtin_bit_cast(h16x2, w).x; }
__device__ __forceinline__ float hhi(unsigned w) { return (float)__builtin_bit_cast(h16x2, w).y; }
__device__ __forceinline__ float wave_sum(float v) {
#pragma unroll
    for (int o = 1; o < 64; o <<= 1) v += __shfl_xor(v, o);
    return v;
}
using pg8::gelu_tanh; using pg8::sigmoidf; using pg8::pack8;

#define XB_TMO      128
#define XB_XCNT(j)  (256  + 64 * (j))
#define XB_XSUB(j)  (1280 + 64 * (j))
#define XB_XGEN(j)  (2304 + 64 * (j))
#define XB_TOP      3328
#define XB_TOPGEN   3392
#define XCD_BAR_WORDS 3456
#define XB_SPIN_CAP (1u << 18)

__device__ __forceinline__ unsigned xb_ld(unsigned* p)              { return __hip_atomic_load(p, __ATOMIC_RELAXED, __HIP_MEMORY_SCOPE_AGENT); }
__device__ __forceinline__ unsigned xb_add(unsigned* p, unsigned v) { return __hip_atomic_fetch_add(p, v, __ATOMIC_RELAXED, __HIP_MEMORY_SCOPE_AGENT); }
__device__ __forceinline__ unsigned xb_xcc_id() { return (unsigned)__builtin_amdgcn_s_getreg((3 << 11) | 20) & 0xFu; }
#define XB_SPIN(cond, bar) do { unsigned _sp = 0; while (cond) { __builtin_amdgcn_s_sleep(1); \
    if ((++_sp & 255u) == 0u) { if (xb_ld(&(bar)[XB_TMO])) break; if (_sp > XB_SPIN_CAP) { atomicAdd(&(bar)[XB_TMO], 1u); break; } } } } while (0)

struct XcdBarrier {
    unsigned* bar; unsigned x;
    volatile LAS unsigned* st;
};

__device__ __forceinline__ XcdBarrier xcd_barrier_post(unsigned* bar, volatile LAS unsigned* st) {
    XcdBarrier b; b.bar = bar; b.x = xb_xcc_id(); b.st = st;
    if (threadIdx.x == 0) (void)xb_add(&bar[XB_XCNT(b.x)], 1u);
    return b;
}
__device__ __forceinline__ void xcd_barrier_complete(unsigned* bar, unsigned x, unsigned& nloc, unsigned& nx) {
    const unsigned G = gridDim.x * gridDim.y * gridDim.z;
    unsigned sum, cnt, mine, sp = 0u;
    for (;;) {
        sum = 0u; cnt = 0u; mine = 0u;
#pragma unroll
        for (unsigned j = 0; j < 16; ++j) { const unsigned c = xb_ld(&bar[XB_XCNT(j)]); sum += c; cnt += (c > 0u) ? 1u : 0u; mine = (j == x) ? c : mine; }
        if (sum == G) break;
        __builtin_amdgcn_s_sleep(1);
        if ((++sp & 255u) == 0u) { if (xb_ld(&bar[XB_TMO])) break; if (sp > XB_SPIN_CAP) { atomicAdd(&bar[XB_TMO], 1u); break; } }
    }
    nloc = mine > 0u ? mine : 1u; nx = cnt > 0u ? cnt : 1u;
}

__device__ __forceinline__ void xcd_barrier(const XcdBarrier& b) {
    asm volatile("s_waitcnt vmcnt(0)" ::: "memory");
    __syncthreads();
    if (threadIdx.x == 0) {
        unsigned* bar = b.bar;
        __builtin_amdgcn_s_waitcnt(0);
        unsigned nloc = b.st[0], nx = b.st[1];
        if (nloc == 0u) { xcd_barrier_complete(bar, b.x, nloc, nx); b.st[0] = nloc; b.st[1] = nx; }
        const unsigned old = xb_add(&bar[XB_XSUB(b.x)], 1u);
        const unsigned gen = old / nloc;
        if (old + 1u == (gen + 1u) * nloc) {
            __builtin_amdgcn_fence(__ATOMIC_RELEASE, "agent");
            asm volatile("s_waitcnt vmcnt(0)" ::: "memory");
            const unsigned og = xb_add(&bar[XB_TOP], 1u);
            const unsigned tg = og / nx;
            if (og + 1u == (tg + 1u) * nx) xb_add(&bar[XB_TOPGEN], 1u);
            else XB_SPIN(xb_ld(&bar[XB_TOPGEN]) == tg, bar);
            __builtin_amdgcn_fence(__ATOMIC_ACQUIRE, "agent");
            xb_add(&bar[XB_XGEN(b.x)], 1u);
            asm volatile("s_waitcnt vmcnt(0)" ::: "memory");
        } else {
            XB_SPIN(xb_ld(&bar[XB_XGEN(b.x)]) == gen, bar);
            __builtin_amdgcn_fence(__ATOMIC_ACQUIRE, "agent");
            asm volatile("s_waitcnt vmcnt(0)" ::: "memory");
        }
    }
    __syncthreads();
}

struct Args { const float* in[33]; float* out; unsigned char* ws; int ph_lo, ph_hi, li, dup; };
struct Frame {
    LAS unsigned char* lds;
    volatile LAS unsigned* MISC;
    gu32* ctl;
    int tid, lane, wave, bid, G;
};
enum { I_X = 0, I_WIN, I_LAMRE, I_LAMIM, I_LOGSTEP, I_BRE, I_BIM, I_CRE, I_CIM, I_SD, I_WGLU, I_BGLU, I_MU, I_W0, I_WUP, I_A0, I_AUP, I_GUP, I_KK, I_KA, I_RK, I_GNG, I_GNB,
       I_WOUT, I_LN1G, I_LN1B, I_WQ, I_KEYS1, I_KEYS2, I_PU, I_PV, I_LN2G, I_LN2B };

__device__ __forceinline__ void p0_transpose_item(const float* W, int K, int N, bf16* WT, int row_off, LAS float* scr, int item, int lane) {
    const int nblk = N / 32, kb = item / nblk, nb = item % nblk, k0 = 64 * kb, n0 = 32 * nb;
#pragma unroll 8
    for (int i = 0; i < 32; ++i) { const int kk = 2 * i + (lane >> 5); scr[kk * 33 + (lane & 31)] = W[(size_t)(k0 + kk) * N + n0 + (lane & 31)]; }
    LDS_WAIT(); asm volatile("" ::: "memory");
    const int c = lane & 7;
#pragma unroll
    for (int j = 0; j < 4; ++j) { const int n = (lane >> 3) + 8 * j; const LAS float* s = scr + (8 * c) * 33 + n;
        v4u o; o.x = pk2(s[0 * 33], s[1 * 33]); o.y = pk2(s[2 * 33], s[3 * 33]); o.z = pk2(s[4 * 33], s[5 * 33]); o.w = pk2(s[6 * 33], s[7 * 33]);
        *(GAS v4u*)(WT + (size_t)(row_off + n0 + n) * K + k0 + 8 * c) = o; }
    LDS_WAIT(); asm volatile("" ::: "memory");
}
__device__ __forceinline__ void cvt_stream(const float* src, bf16* dst, size_t n8, size_t gtid, size_t nt) {
    for (size_t i = gtid; i < n8; i += nt) { const f32x4 a = ((const f32x4*)src)[2 * i], b = ((const f32x4*)src)[2 * i + 1]; ((v4u*)dst)[i] = pack8(a, b); }
}

__device__ __forceinline__ void peer_tables(Frame& F, const Args& A, int gw, int NGW) {
    if (gw < 0) return;
    const int lane = F.lane;
    unsigned char* U8 = A.ws + WS_UTAB; unsigned char* V8 = A.ws + WS_VTAB; float* SU = (float*)(A.ws + WS_SU);
    for (int e = gw; e < 16384; e += NGW) {
        const f32x4* ur = (const f32x4*)(A.in[I_PU] + (size_t)e * D) + lane; const f32x4* vr = (const f32x4*)(A.in[I_PV] + (size_t)e * D) + lane; f32x4 x[8], y[8]; float am = 0.f;
#pragma unroll
        for (int i = 0; i < 8; ++i) { x[i] = ur[64 * i]; y[i] = vr[64 * i]; }
#pragma unroll
        for (int i = 0; i < 8; ++i) am = fmaxf(am, fmaxf(fmaxf(fabsf(x[i].x), fabsf(x[i].y)), fmaxf(fabsf(x[i].z), fabsf(x[i].w))));
#pragma unroll
        for (int o = 1; o < 64; o <<= 1) am = fmaxf(am, __shfl_xor(am, o));
        const float sc = (am > 0.f) ? am * (1.f / 127.f) : 1.f, inv = 1.f / sc;
        if (lane == 0) SU[e] = sc;
        unsigned* ud = (unsigned*)(U8 + (size_t)e * D) + lane; unsigned* vd = (unsigned*)(V8 + (size_t)e * D) + lane;
#pragma unroll
        for (int i = 0; i < 8; ++i) { const int a = (int)rintf(x[i].x * inv), b = (int)rintf(x[i].y * inv), c = (int)rintf(x[i].z * inv), d = (int)rintf(x[i].w * inv);
            ud[64 * i] = (unsigned)(a & 255) | ((unsigned)(b & 255) << 8) | ((unsigned)(c & 255) << 16) | ((unsigned)(d & 255) << 24);
            int w = 0; w = __builtin_amdgcn_cvt_pk_fp8_f32(y[i].x, y[i].y, w, false); w = __builtin_amdgcn_cvt_pk_fp8_f32(y[i].z, y[i].w, w, true); vd[64 * i] = (unsigned)w; }
    }
}

__device__ __forceinline__ void s5_params(Frame& F, const Args& A, int first_blk) {
    unsigned char* ws = A.ws;
    if (F.bid >= first_blk && F.bid < first_blk + 64) {
        const int g = F.bid - first_blk, tid = F.tid;
        LAS f32x2* AP = (LAS f32x2*)(F.lds);
        LAS f32x2* BB = (LAS f32x2*)(F.lds + 16896);
        LAS float* KJ = (LAS float*)(F.lds + 16896 + 8192);
        const float* lam_re = A.in[I_LAMRE] + g * 64; const float* lam_im = A.in[I_LAMIM] + g * 64;
        const float step = __expf(A.in[I_LOGSTEP][g]);
        for (int idx = tid; idx < 33 * 64; idx += 512) { const int j = idx >> 6, p = idx & 63; const float lr = lam_re[p], li = lam_im[p];
            const float mag = __expf(lr * step * (float)j); float rev = (li * step * 0.15915494309f) * (float)j; rev -= floorf(rev);
            AP[idx] = (f32x2){mag * __builtin_amdgcn_cosf(rev), mag * __builtin_amdgcn_sinf(rev)}; }
        LDS_WAIT(); __syncthreads();
        for (int idx = tid; idx < 64 * 16; idx += 512) { const int p = idx >> 4, h = idx & 15; const float lr = lam_re[p], li = lam_im[p]; const f32x2 a = AP[64 + p];
            const float den = lr * lr + li * li, fr = ((a.x - 1.f) * lr + a.y * li) / den, fi = (a.y * lr - (a.x - 1.f) * li) / den;
            const float br = A.in[I_BRE][(g * 64 + p) * 16 + h], bi = A.in[I_BIM][(g * 64 + p) * 16 + h];
            BB[idx] = (f32x2){fr * br - fi * bi, fr * bi + fi * br}; }
        if (tid < 64) { const f32x2 a = AP[32 * 64 + tid]; float* a32 = (float*)(ws + WS_A32); a32[(g * 64 + tid) * 2] = a.x; a32[(g * 64 + tid) * 2 + 1] = a.y; }
        LDS_WAIT(); __syncthreads();
        const float* cre = A.in[I_CRE] + (size_t)g * 16 * 64; const float* cim = A.in[I_CIM] + (size_t)g * 16 * 64;
        for (int idx = tid; idx < 32 * 256; idx += 512) { const int j = idx >> 8, h = (idx >> 4) & 15, hp = idx & 15; float s = 0.f;
            for (int p = 0; p < 64; ++p) { const f32x2 a = AP[j * 64 + p], bb = BB[p * 16 + hp]; const float wr = a.x * bb.x - a.y * bb.y, wi = a.x * bb.y + a.y * bb.x;
                s += cre[h * 64 + p] * wr - cim[h * 64 + p] * wi; }
            KJ[idx] = s; }
        LDS_WAIT(); __syncthreads();
        bf16* Gt = (bf16*)(ws + WS_G); bf16* MT = (bf16*)(ws + WS_MT);
        for (int it = tid; it < 8192; it += 512) { const int row = it >> 6, cb = (it & 63) * 8, s = cb >> 4, h0 = cb & 15, p = row & 63, im = row >> 6; const f32x2 a = AP[(31 - s) * 64 + p];
            float v[8];
#pragma unroll
            for (int e = 0; e < 8; ++e) { const f32x2 bb = BB[p * 16 + h0 + e]; v[e] = im ? (a.x * bb.y + a.y * bb.x) : (a.x * bb.x - a.y * bb.y); }
            v4u o; o.x = pk2(v[0], v[1]); o.y = pk2(v[2], v[3]); o.z = pk2(v[4], v[5]); o.w = pk2(v[6], v[7]);
            *(v4u*)(Gt + (size_t)(g * 128 + row) * 512 + cb) = o; }
        const float* dsk = A.in[I_SD] + g * 16;
        for (int it = tid; it < 40960; it += 512) { const int n = it / 80, kb = (it % 80) * 8, t = n >> 4, h = n & 15; float v[8];
            if (kb < 512) { const int s = kb >> 4, h0 = kb & 15;
#pragma unroll
                for (int e = 0; e < 8; ++e) { const int hp = h0 + e; float x = 0.f; if (s <= t) { x = KJ[(t - s) * 256 + h * 16 + hp]; if (s == t && hp == h) x += dsk[h]; } v[e] = x; } }
            else { const int p0 = (kb < 576) ? (kb - 512) : (kb - 576);
#pragma unroll
                for (int e = 0; e < 8; ++e) { const int p = p0 + e; const f32x2 a = AP[(t + 1) * 64 + p]; const float cr = cre[h * 64 + p], ci = cim[h * 64 + p];
                    v[e] = (kb < 576) ? (cr * a.x - ci * a.y) : -(cr * a.y + ci * a.x); } }
            v4u o; o.x = pk2(v[0], v[1]); o.y = pk2(v[2], v[3]); o.z = pk2(v[4], v[5]); o.w = pk2(v[6], v[7]);
            *(v4u*)(MT + (size_t)(g * 512 + n) * 640 + kb) = o; }
        LDS_WAIT(); __syncthreads();
    }
}

__device__ __forceinline__ void p0_prologue(Frame& F, const Args& A) {
    unsigned char* ws = A.ws;
    const size_t gtid = (size_t)F.bid * 512 + F.tid, NT = (size_t)F.G * 512;
    const int gw = F.bid * NWAVES + F.wave, NGW = F.G * NWAVES;
    cvt_stream(A.in[I_X], (bf16*)(ws + WS_XB), (size_t)M * D / 8, gtid, NT);
    {
        LAS float* scr = (LAS float*)(F.lds + RING_OFF + F.wave * 16384);
        constexpr int I_IN = (2048 / 64) * (INC / 32), I_GL = (1024 / 64) * (1024 / 32);
        for (int it = gw; it < I_IN + I_GL; it += NGW) { int r = it;
            if (r < I_IN) { p0_transpose_item(A.in[I_WIN], 2048, INC, (bf16*)(ws + WS_WIN), 0, scr, r, F.lane); continue; } r -= I_IN;
            p0_transpose_item(A.in[I_WGLU], 1024, 1024, (bf16*)(ws + WS_WGLU), 0, scr, r, F.lane); }
        v4u* z = (v4u*)((bf16*)(ws + WS_WIN) + (size_t)INC * 2048);
        for (size_t i = gtid; i < (size_t)(INP - INC) * 2048 / 8; i += NT) z[i] = (v4u){0u, 0u, 0u, 0u};
    }
    {
        bf16* WL = (bf16*)(ws + WS_WLORA);
        for (size_t i = gtid; i < (size_t)3072 * 384; i += NT) { const int n = (int)(i / 384), k = (int)(i % 384); float v = 0.f;
            if (n < 1024) { if (k < 64) v = A.in[I_WUP][k * 1024 + n]; }
            else if (n < 2048) { if (k >= 64 && k < 128) v = A.in[I_AUP][(k - 64) * 1024 + (n - 1024)]; }
            else { if (k >= 128 && k < 288) v = A.in[I_GUP][(k - 128) * 1024 + (n - 2048)]; }
            WL[i] = (bf16)f2bf(v); }
    }
}

__device__ __forceinline__ void wout_transpose(Frame& F, const Args& A, int gw, int NGW, LAS float* scr) {
    if (gw < 0) return;
    constexpr int I_OU = (2048 / 64) * (2048 / 32);
    for (int it = gw; it < I_OU; it += NGW) p0_transpose_item(A.in[I_WOUT], 2048, 2048, (bf16*)(A.ws + WS_WOUT), 0, scr, it, F.lane);
}
__device__ __forceinline__ void wqk_units(Frame& F, const Args& A, int rb, int nblk, int unit_lo, int unit_hi) {
    if (rb < 0) return;
    unsigned char* ws = A.ws;
    {
        LAS float* Ks = (LAS float*)(F.lds); LAS float* Ws = (LAS float*)(F.lds + 128 * 129 * 4);
        bf16* WQK = (bf16*)(ws + WS_WQK); const int tid = F.tid;
        for (int unit = unit_lo + rb; unit < unit_hi; unit += nblk) { const int hj = unit >> 5, dblk = unit & 31, h = hj >> 1, j = hj & 1;
            const float* keys = (j ? A.in[I_KEYS2] : A.in[I_KEYS1]) + (size_t)h * 128 * 128;
            for (int idx = tid; idx < 16384; idx += 512) Ks[(idx >> 7) * 129 + (idx & 127)] = keys[idx];
            for (int idx = tid; idx < 8192; idx += 512) Ws[(idx >> 7) * 129 + (idx & 127)] = A.in[I_WQ][(size_t)(dblk * 64 + (idx >> 7)) * 2048 + hj * 128 + (idx & 127)];
            LDS_WAIT(); __syncthreads();
            const int key = tid & 127, dq = tid >> 7; float acc[16];
#pragma unroll
            for (int i = 0; i < 16; ++i) acc[i] = 0.f;
            for (int c = 0; c < 128; ++c) { const float a = Ks[key * 129 + c];
#pragma unroll
                for (int i = 0; i < 16; ++i) acc[i] += a * Ws[(dq * 16 + i) * 129 + c]; }
            v4u o0, o1; o0.x = pk2(acc[0], acc[1]); o0.y = pk2(acc[2], acc[3]); o0.z = pk2(acc[4], acc[5]); o0.w = pk2(acc[6], acc[7]);
            o1.x = pk2(acc[8], acc[9]); o1.y = pk2(acc[10], acc[11]); o1.z = pk2(acc[12], acc[13]); o1.w = pk2(acc[14], acc[15]);
            v4u* dst = (v4u*)(WQK + (size_t)(hj * 128 + key) * 2048 + dblk * 64 + dq * 16); dst[0] = o0; dst[1] = o1;
            LDS_WAIT(); __syncthreads(); }
    }
}

__device__ __forceinline__ void r1_lora_in(Frame& F, const Args& A) {
    const bf16* PRW = (const bf16*)(A.ws + WS_PRW); bf16* AL = (bf16*)(A.ws + WS_ALORA); const float* mu = A.in[I_MU];
    const int gw = F.bid * NWAVES + F.wave, NGW = F.G * NWAVES;
    for (int m = gw; m < M; m += NGW) { const int t = m & (SEQ - 1);
#pragma unroll
        for (int q = 0; q < 6; ++q) { const int idx = q * 64 + F.lane; float val = 0.f;
            if (idx < 288) { const int col = 3072 + idx; const float cur = bf1(PRW[(size_t)m * 3584 + col]); const float prev = (t > 0) ? bf1(PRW[(size_t)(m - 1) * 3584 + col]) : 0.f;
                const float s = cur + mu[col] * (prev - cur);
                val = (idx < 64) ? (1.f - 2.f / (1.f + __expf(2.f * s))) : ((idx < 128) ? s : sigmoidf(s)); }
            AL[(size_t)m * 384 + idx] = (bf16)f2bf(val); } }
}

__device__ __forceinline__ void r3_prep(Frame& F, const Args& A) {
    const bf16* PRW = (const bf16*)(A.ws + WS_PRW); const bf16* LO = (const bf16*)(A.ws + WS_LORA); unsigned char* SC = A.ws + WS_SCAN;
    const float* mu = A.in[I_MU]; const int lane = F.lane, head = lane >> 2, j0 = (lane & 3) * 16, ch = lane * 16;
    const int gw = F.bid * NWAVES + F.wave, NGW = F.G * NWAVES;
    for (int m = gw; m < M; m += NGW) { const int t = m & (SEQ - 1), b = m >> 11;
        float rs[16], ks[16], vs[16];
#pragma unroll
        for (int part = 0; part < 3; ++part) { const int col = part * 1024 + ch; const v4u c0 = *(const v4u*)(PRW + (size_t)m * 3584 + col), c1 = *(const v4u*)(PRW + (size_t)m * 3584 + col + 8);
            v4u p0 = (v4u){0u, 0u, 0u, 0u}, p1 = p0; if (t > 0) { p0 = *(const v4u*)(PRW + (size_t)(m - 1) * 3584 + col); p1 = *(const v4u*)(PRW + (size_t)(m - 1) * 3584 + col + 8); }
            float cu[16], pr[16];
#pragma unroll
            for (int e = 0; e < 4; ++e) { cu[2 * e] = bflo(c0[e]); cu[2 * e + 1] = bfhi(c0[e]); cu[8 + 2 * e] = bflo(c1[e]); cu[8 + 2 * e + 1] = bfhi(c1[e]);
                pr[2 * e] = bflo(p0[e]); pr[2 * e + 1] = bfhi(p0[e]); pr[8 + 2 * e] = bflo(p1[e]); pr[8 + 2 * e + 1] = bfhi(p1[e]); }
#pragma unroll
            for (int e = 0; e < 16; ++e) { const float s = cu[e] + mu[col + e] * (pr[e] - cu[e]); if (part == 0) rs[e] = s; else if (part == 1) ks[e] = s; else vs[e] = s; } }
        const v4u wl0 = *(const v4u*)(LO + (size_t)m * 3072 + ch), wl1 = *(const v4u*)(LO + (size_t)m * 3072 + ch + 8);
        const v4u al0 = *(const v4u*)(LO + (size_t)m * 3072 + 1024 + ch), al1 = *(const v4u*)(LO + (size_t)m * 3072 + 1024 + ch + 8);
        float wl[16], al[16];
#pragma unroll
        for (int e = 0; e < 4; ++e) { wl[2 * e] = bflo(wl0[e]); wl[2 * e + 1] = bfhi(wl0[e]); wl[8 + 2 * e] = bflo(wl1[e]); wl[8 + 2 * e + 1] = bfhi(wl1[e]);
            al[2 * e] = bflo(al0[e]); al[2 * e + 1] = bfhi(al0[e]); al[8 + 2 * e] = bflo(al1[e]); al[8 + 2 * e + 1] = bfhi(al1[e]); }
        float dec[16], kp[16], kk[16], aa[16]; float n2 = 0.f;
#pragma unroll
        for (int e = 0; e < 16; ++e) { const float x = A.in[I_W0][ch + e] + wl[e]; const float y = -x; const float sp = fmaxf(y, 0.f) + __logf(1.f + __expf(-fabsf(y)));
            const float w = -sp - 0.5f; dec[e] = -__expf(w);
            const float a = sigmoidf(A.in[I_A0][ch + e] + al[e]); aa[e] = a;
            kk[e] = ks[e] * A.in[I_KK][ch + e]; n2 += kk[e] * kk[e];
            kp[e] = ks[e] * (1.f + (a - 1.f) * A.in[I_KA][ch + e]); }
        n2 += __shfl_xor(n2, 1); n2 += __shfl_xor(n2, 2);
        const float inv = 1.f / fmaxf(sqrtf(n2), 1e-12f);
        unsigned char* rec = SC + ((size_t)(b * 16 + head) * SEQ + t) * SCAN_REC;
        float kap[16], bet[16];
#pragma unroll
        for (int e = 0; e < 16; ++e) { kap[e] = kk[e] * inv; bet[e] = kap[e] * aa[e]; }
#define R3_ST(off, arr) do { v4u a_, b_; a_.x = pkh(arr[0], arr[1]); a_.y = pkh(arr[2], arr[3]); a_.z = pkh(arr[4], arr[5]); a_.w = pkh(arr[6], arr[7]); \
        b_.x = pkh(arr[8], arr[9]); b_.y = pkh(arr[10], arr[11]); b_.z = pkh(arr[12], arr[13]); b_.w = pkh(arr[14], arr[15]); *(v4u*)(rec + (off) + j0 * 2) = a_; *(v4u*)(rec + (off) + j0 * 2 + 16) = b_; } while (0)
        R3_ST(0, rs); R3_ST(128, kp); R3_ST(256, kap); R3_ST(384, bet); R3_ST(512, vs);
#undef R3_ST
#pragma unroll
        for (int q = 0; q < 4; ++q) *(f32x4*)(rec + 640 + (j0 + 4 * q) * 4) = (f32x4){dec[4 * q], dec[4 * q + 1], dec[4 * q + 2], dec[4 * q + 3]}; }
}

typedef short rwbf8 __attribute__((ext_vector_type(8)));
constexpr int RW_WLDS = 17408 + 14336, RL_RAW = 17408;
constexpr int RL_A1 = 0, RL_A43 = 1024, RL_QT = 0, RL_RT = 2304, RL_BK = 4608, RL_XV = 4608, RL_WJ = 4608, RL_A2 = 8704, RL_GM = 9216, RL_WI = 13312;
static_assert(4 * RW_WLDS <= LDSCTL_OFF && RL_WI + 4096 <= RL_RAW, "RWKV chunk LDS map");
__device__ __forceinline__ unsigned long long pk4bf(const f32x4 v) { return (unsigned long long)pk2(v[0], v[1]) | ((unsigned long long)pk2(v[2], v[3]) << 32); }
__device__ __forceinline__ f32x4 up4bf(unsigned long long w) { const unsigned lo = (unsigned)w, hi = (unsigned)(w >> 32); return (f32x4){bflo(lo), bfhi(lo), bflo(hi), bfhi(hi)}; }
__device__ __forceinline__ float pair_swap(float v) { return __builtin_bit_cast(float, __builtin_amdgcn_update_dpp(0, __builtin_bit_cast(int, v), 0xB1, 0xf, 0xf, false)); }
__device__ __forceinline__ void rw_chunk_pre(Frame& F, const Args& A) {
    const int lane = F.lane, c = lane & 15, q = lane >> 4; const bool odd = (lane & 1) != 0;
    LAS unsigned char* wl = F.lds + F.wave * RW_WLDS;
    const unsigned char* SC = A.ws + WS_SCAN; unsigned char* PHI = A.ws + WS_PHI; unsigned char* PSI = A.ws + WS_PSI; unsigned char* OM = A.ws + WS_OM; unsigned char* O0 = A.ws + WS_O0; float* G15 = (float*)(A.ws + WS_G15);
    if (F.wave >= 4) return;
    const int gw = F.bid * 4 + F.wave, NGW = F.G * 4;
    const f32x4 zero4 = (f32x4){0.f, 0.f, 0.f, 0.f}; const v4u z4 = (v4u){0u, 0u, 0u, 0u};
#define RW_STAGE(i_) do { const unsigned char* g_ = SC + (size_t)(i_) * 16 * SCAN_REC + lane * 16; _Pragma("unroll") for (int k_ = 0; k_ < 14; ++k_) \
        __builtin_amdgcn_global_load_lds((const unsigned*)(g_ + k_ * 1024), (LAS unsigned*)(wl + RL_RAW + k_ * 1024), 16, 0, 0); } while (0)
    if (gw < 64 * RW_NC) RW_STAGE(gw);
    for (int inst = gw; inst < 64 * RW_NC; inst += NGW) {
        asm volatile("s_waitcnt vmcnt(0)" ::: "memory");
        const LAS unsigned char* raw = wl + RL_RAW + (lane & ~1) * 2; const int hsel = (lane & 1) * 16;
        *(LAS v4u*)(wl + RL_WI + lane * 64 + 32) = z4; *(LAS v4u*)(wl + RL_WI + lane * 64 + 48) = z4;
        float Qt[16], Kt[16], Bt[16], vv[16]; float cum = 0.f;
#pragma unroll
        for (int t = 0; t < 16; ++t) { const LAS unsigned char* rec = raw + t * SCAN_REC;
#define RW_H(off) ((float)__builtin_bit_cast(_Float16, (unsigned short)(*(const LAS unsigned*)(rec + (off)) >> hsel)))
            const float r = RW_H(0), kp = RW_H(128), ka = RW_H(256), be = RW_H(384);
            vv[t] = RW_H(512); const float ld = *(const LAS float*)(wl + RL_RAW + t * SCAN_REC + 640 + lane * 4);
#undef RW_H
            const float gm1 = __expf(cum); cum += ld; const float g = __expf(cum), inv = __expf(-cum);
            Qt[t] = ka * gm1; const float Rt = r * g; Kt[t] = kp * inv; Bt[t] = be * inv;
            { const float qp = pair_swap(Qt[t]), rp = pair_swap(Rt), bp = pair_swap(Bt[t]), kq = pair_swap(Kt[t]); const int le = lane & ~1;
              *(LAS unsigned*)(wl + (odd ? RL_RT : RL_QT) + t * 144 + le * 2) = odd ? pk2(rp, Rt) : pk2(Qt[t], qp);
              *(LAS unsigned*)(wl + RL_BK + (odd ? 16 + t : t) * 144 + le * 2) = odd ? pk2(kq, Kt[t]) : pk2(Bt[t], bp); } }
        const float gl = __expf(cum); G15[(size_t)inst * 64 + lane] = gl;
        { v4u g0, g1, g2, g3, w0, w1;
#pragma unroll
          for (int e = 0; e < 4; ++e) { g0[e] = pk2(Kt[2 * e] * gl, Kt[2 * e + 1] * gl); g1[e] = pk2(Kt[8 + 2 * e] * gl, Kt[8 + 2 * e + 1] * gl);
              g2[e] = pk2(-Bt[2 * e] * gl, -Bt[2 * e + 1] * gl); g3[e] = pk2(-Bt[8 + 2 * e] * gl, -Bt[8 + 2 * e + 1] * gl); w0[e] = pk2(vv[2 * e], vv[2 * e + 1]); w1[e] = pk2(vv[8 + 2 * e], vv[8 + 2 * e + 1]); }
          LAS v4u* gp = (LAS v4u*)(wl + RL_GM + lane * 64); gp[0] = g0; gp[1] = g1; gp[2] = g2; gp[3] = g3;
          LAS v4u* wp = (LAS v4u*)(wl + RL_WI + lane * 64); wp[0] = w0; wp[1] = w1; }
        LDS_WAIT(); asm volatile("" ::: "memory");
        if (inst + NGW < 64 * RW_NC) RW_STAGE(inst + NGW);
        { f32x4 acc[2][2];
#pragma unroll
          for (int mi = 0; mi < 2; ++mi)
#pragma unroll
              for (int ni = 0; ni < 2; ++ni) acc[mi][ni] = zero4;
#pragma unroll
          for (int ks = 0; ks < 2; ++ks) { rwbf8 af[2], bfv[2];
#pragma unroll
              for (int mi = 0; mi < 2; ++mi) { af[mi] = *(const LAS rwbf8*)(wl + RL_QT + (16 * mi + c) * 144 + (32 * ks + 8 * q) * 2); bfv[mi] = *(const LAS rwbf8*)(wl + RL_BK + (16 * mi + c) * 144 + (32 * ks + 8 * q) * 2); }
#pragma unroll
              for (int mi = 0; mi < 2; ++mi)
#pragma unroll
                  for (int ni = 0; ni < 2; ++ni) acc[mi][ni] = __builtin_amdgcn_mfma_f32_16x16x32_bf16(af[mi], bfv[ni], acc[mi][ni], 0, 0, 0); }
          LDS_WAIT(); asm volatile("" ::: "memory");
#pragma unroll
          for (int r = 0; r < 4; ++r) { const int t = 4 * q + r;
              *(LAS float*)(wl + RL_A1 + (t * 16 + c) * 4) = (c < t) ? acc[0][0][r] : 0.f;
              const float a2 = (c < t) ? acc[0][1][r] : 0.f, a4 = (c <= t) ? acc[1][1][r] : 0.f, a3n = (c <= t) ? -acc[1][0][r] : 0.f;
              const float a2p = pair_swap(a2), a4p = pair_swap(a4), a3p = pair_swap(a3n); const int ce = c & ~1;
              if (!odd) { *(LAS unsigned*)(wl + RL_A2 + t * 32 + ce * 2) = pk2(a2, a2p); *(LAS unsigned*)(wl + RL_A43 + t * 64 + ce * 2) = pk2(a4, a4p); }
              else *(LAS unsigned*)(wl + RL_A43 + t * 64 + (16 + ce) * 2) = pk2(a3p, a3n); } }
        LDS_WAIT(); asm volatile("" ::: "memory");
        { const rwbf8 a2f = *(const LAS rwbf8*)(wl + RL_A2 + c * 32 + q * 16);
#pragma unroll
          for (int ni = 0; ni < 4; ++ni) { const rwbf8 bv = *(const LAS rwbf8*)(wl + RL_WI + (16 * ni + c) * 64 + q * 16); const f32x4 d = __builtin_amdgcn_mfma_f32_16x16x32_bf16(a2f, bv, zero4, 0, 0, 0);
#pragma unroll
              for (int r = 0; r < 4; ++r) *(LAS float*)(wl + RL_XV + ((4 * q + r) * 64 + 16 * ni + c) * 4) = d[r]; } }
        LDS_WAIT(); asm volatile("" ::: "memory");
        float y[16];
#pragma unroll
        for (int t = 0; t < 16; ++t) y[t] = *(const LAS float*)(wl + RL_XV + (t * 64 + lane) * 4);
#pragma unroll
        for (int t = 1; t < 16; ++t) {
#pragma unroll
            for (int s4 = 0; s4 <= (t - 1) / 4; ++s4) { const f32x4 a = *(const LAS f32x4*)(wl + RL_A1 + (t * 16 + 4 * s4) * 4);
#pragma unroll
                for (int e = 0; e < 4; ++e) if (4 * s4 + e < t) { Qt[t] -= a[e] * Qt[4 * s4 + e]; y[t] -= a[e] * y[4 * s4 + e]; } } }
        LDS_WAIT(); asm volatile("" ::: "memory");
        { v4u u0, u1, p0, p1;
#pragma unroll
          for (int e = 0; e < 4; ++e) { u0[e] = pk2(y[2 * e], y[2 * e + 1]); u1[e] = pk2(y[8 + 2 * e], y[8 + 2 * e + 1]); p0[e] = pk2(Qt[2 * e], Qt[2 * e + 1]); p1[e] = pk2(Qt[8 + 2 * e], Qt[8 + 2 * e + 1]); }
          LAS v4u* wp = (LAS v4u*)(wl + RL_WI + lane * 64); wp[2] = u0; wp[3] = u1;
          LAS v4u* jp = (LAS v4u*)(wl + RL_WJ + lane * 64); jp[0] = z4; jp[1] = z4; jp[2] = p0; jp[3] = p1; }
        LDS_WAIT(); asm volatile("" ::: "memory");
        { rwbf8 gmf[4], wif[4], wjf[4];
#pragma unroll
          for (int i = 0; i < 4; ++i) { gmf[i] = *(const LAS rwbf8*)(wl + RL_GM + (16 * i + c) * 64 + q * 16); wif[i] = *(const LAS rwbf8*)(wl + RL_WI + (16 * i + c) * 64 + q * 16); wjf[i] = *(const LAS rwbf8*)(wl + RL_WJ + (16 * i + c) * 64 + q * 16); }
          const rwbf8 a43f = *(const LAS rwbf8*)(wl + RL_A43 + c * 64 + q * 16);
#pragma unroll
          for (int mi = 0; mi < 4; ++mi)
#pragma unroll
              for (int ni = 0; ni < 4; ++ni) { const f32x4 d = __builtin_amdgcn_mfma_f32_16x16x32_bf16(gmf[mi], wif[ni], zero4, 0, 0, 0);
                  *(unsigned long long*)(PSI + ((size_t)inst * 16 + mi * 4 + ni) * 512 + lane * 8) = pk4bf(d); }
#pragma unroll
          for (int nj = 0; nj < 4; ++nj) { const int pos = (nj >> 1) * 32 + q * 8 + (nj & 1) * 4;
#pragma unroll
              for (int mj = 0; mj < 4; ++mj) { const f32x4 d = __builtin_amdgcn_mfma_f32_16x16x32_bf16(wjf[nj], gmf[mj], zero4, 0, 0, 0);
                  *(unsigned long long*)(PHI + (size_t)inst * 8192 + ((16 * mj + c) * 64 + pos) * 2) = pk4bf(d); } }
#pragma unroll
          for (int ni = 0; ni < 4; ++ni) { const f32x4 d = __builtin_amdgcn_mfma_f32_16x16x32_bf16(a43f, wif[ni], zero4, 0, 0, 0);
              *(unsigned long long*)(O0 + ((size_t)inst * 4 + ni) * 512 + lane * 8) = pk4bf(d); }
#pragma unroll
          for (int nj = 0; nj < 4; ++nj) { const int pos = (nj >> 1) * 32 + q * 8 + (nj & 1) * 4;
              f32x4 d = __builtin_amdgcn_mfma_f32_16x16x32_bf16(wjf[nj], a43f, zero4, 0, 0, 0);
              const f32x4 rr = up4bf(*(const LAS unsigned long long*)(wl + RL_RT + c * 144 + (16 * nj + 4 * q) * 2)); d = d + rr;
              *(unsigned long long*)(OM + (size_t)inst * 2048 + (c * 64 + pos) * 2) = pk4bf(d); } }
        LDS_WAIT(); asm volatile("" ::: "memory");
    }
#undef RW_STAGE
}
constexpr int RB_GS = 4, RB_STEP = 13056, RB_PIECES = RB_STEP / 16, RB_BUF = RB_GS * RB_STEP;
static_assert(2 * RB_BUF <= LDSCTL_OFF, "recurrence LDS map");
__device__ __forceinline__ const unsigned char* rb_src(const unsigned char* ws, int inst, int w, int p) {
    if (p < 512) { const int L = p >> 6, l = p & 63, mi = L >> 1, ks = L & 1; return ws + WS_PHI + (size_t)inst * 8192 + ((16 * mi + (l & 15)) * 64 + ks * 32 + (l >> 4) * 8) * 2; }
    if (p < 640) { const int pp = p - 512; return ws + WS_PSI + ((size_t)inst * 16 + (pp >> 5) * 4 + w) * 512 + (pp & 31) * 16; }
    if (p < 768) { const int pp = p - 640, ks = pp >> 6, l = pp & 63; return ws + WS_OM + (size_t)inst * 2048 + ((l & 15) * 64 + ks * 32 + (l >> 4) * 8) * 2; }
    if (p < 800) return ws + WS_O0 + ((size_t)inst * 4 + w) * 512 + (p - 768) * 16;
    return ws + WS_G15 + (size_t)inst * 256 + (p - 800) * 16;
}
__device__ __forceinline__ void rw_recur(Frame& F, const Args& A) {
    if (F.bid >= 256) return;
    const int bh = F.bid >> 2, w = F.bid & 3, lane = F.lane, c = lane & 15, q = lane >> 4, tid = F.tid;
    float* O = (float*)(A.ws + WS_ORW) + (size_t)(bh >> 4) * SEQ * 1024 + (bh & 15) * 64 + 16 * w + c;
    f32x4 H[4];
#pragma unroll
    for (int mi = 0; mi < 4; ++mi) H[mi] = (f32x4){0.f, 0.f, 0.f, 0.f};
    for (int it = tid; it < RB_GS * RB_PIECES; it += NWAVES * 64) { const int st = it / RB_PIECES, p = it % RB_PIECES;
        *(LAS v4u*)(F.lds + st * RB_STEP + p * 16) = *(const v4u*)rb_src(A.ws, bh * RW_NC + st, w, p); }
    LDS_WAIT(); __syncthreads();
    for (int g = 0; g < RW_NC / RB_GS; ++g) {
        if (F.wave != 0) {
            if (g + 1 < RW_NC / RB_GS) { LAS unsigned char* db = F.lds + ((g + 1) & 1) * RB_BUF; const int t7 = tid - 64; v4u v[8];
#pragma unroll
                for (int k = 0; k < 8; ++k) { const int it = t7 + k * 448; if (it < RB_GS * RB_PIECES) v[k] = *(const v4u*)rb_src(A.ws, bh * RW_NC + (g + 1) * RB_GS + it / RB_PIECES, w, it % RB_PIECES); }
#pragma unroll
                for (int k = 0; k < 8; ++k) { const int it = t7 + k * 448; if (it < RB_GS * RB_PIECES) *(LAS v4u*)(db + (it / RB_PIECES) * RB_STEP + (it % RB_PIECES) * 16) = v[k]; } }
        } else {
            const LAS unsigned char* gb = F.lds + (g & 1) * RB_BUF;
#pragma unroll
            for (int st = 0; st < RB_GS; ++st) { const LAS unsigned char* sb = gb + st * RB_STEP; const int ch = g * RB_GS + st;
                rwbf8 hb[2];
#pragma unroll
                for (int ks = 0; ks < 2; ++ks) { const unsigned a0 = pk2(H[2 * ks][0], H[2 * ks][1]), a1 = pk2(H[2 * ks][2], H[2 * ks][3]), b0 = pk2(H[2 * ks + 1][0], H[2 * ks + 1][1]), b1 = pk2(H[2 * ks + 1][2], H[2 * ks + 1][3]);
                    const v4u pk = (v4u){a0, a1, b0, b1}; hb[ks] = __builtin_bit_cast(rwbf8, pk); }
                f32x4 o = up4bf(*(const LAS unsigned long long*)(sb + 12288 + lane * 8));
                o = __builtin_amdgcn_mfma_f32_16x16x32_bf16(*(const LAS rwbf8*)(sb + 10240 + lane * 16), hb[0], o, 0, 0, 0);
                o = __builtin_amdgcn_mfma_f32_16x16x32_bf16(*(const LAS rwbf8*)(sb + 10240 + 1024 + lane * 16), hb[1], o, 0, 0, 0);
#pragma unroll
                for (int r = 0; r < 4; ++r) O[(size_t)(ch * 16 + 4 * q + r) * 1024] = o[r];
#pragma unroll
                for (int mi = 0; mi < 4; ++mi) { f32x4 hn = H[mi] * *(const LAS f32x4*)(sb + 12800 + (16 * mi + 4 * q) * 4) + up4bf(*(const LAS unsigned long long*)(sb + 8192 + mi * 512 + lane * 8));
                    hn = __builtin_amdgcn_mfma_f32_16x16x32_bf16(*(const LAS rwbf8*)(sb + (mi * 2) * 1024 + lane * 16), hb[0], hn, 0, 0, 0);
                    hn = __builtin_amdgcn_mfma_f32_16x16x32_bf16(*(const LAS rwbf8*)(sb + (mi * 2 + 1) * 1024 + lane * 16), hb[1], hn, 0, 0, 0); H[mi] = hn; } }
        }
        LDS_WAIT(); __syncthreads();
    }
}

__device__ __forceinline__ void r5_post(Frame& F, const Args& A) {
    const float* ORW = (const float*)(A.ws + WS_ORW); const bf16* LO = (const bf16*)(A.ws + WS_LORA); const unsigned char* SC = A.ws + WS_SCAN; bf16* CAT = (bf16*)(A.ws + WS_CAT);
    const int lane = F.lane, head = lane >> 2, j0 = (lane & 3) * 16, ch = lane * 16;
    const int gw = F.bid * NWAVES + F.wave, NGW = F.G * NWAVES;
    for (int m = gw; m < M; m += NGW) { const int t = m & (SEQ - 1), b = m >> 11;
        float o[16];
#pragma unroll
        for (int q = 0; q < 4; ++q) { const f32x4 x = *(const f32x4*)(ORW + (size_t)m * 1024 + ch + 4 * q); o[4 * q] = x[0]; o[4 * q + 1] = x[1]; o[4 * q + 2] = x[2]; o[4 * q + 3] = x[3]; }
        float s = 0.f;
#pragma unroll
        for (int e = 0; e < 16; ++e) s += o[e];
        s += __shfl_xor(s, 1); s += __shfl_xor(s, 2); const float mean = s * (1.f / 64.f); float q2 = 0.f;
#pragma unroll
        for (int e = 0; e < 16; ++e) { const float d = o[e] - mean; q2 += d * d; }
        q2 += __shfl_xor(q2, 1); q2 += __shfl_xor(q2, 2); const float rstd = 1.f / sqrtf(q2 * (1.f / 64.f) + GN_EPS);
        const unsigned char* rec = SC + ((size_t)(b * 16 + head) * SEQ + t) * SCAN_REC; float dp = 0.f;
#pragma unroll
        for (int q = 0; q < 2; ++q) { const v4u rr = *(const v4u*)(rec + j0 * 2 + 16 * q), kq = *(const v4u*)(rec + 128 + j0 * 2 + 16 * q); const float* rkp = A.in[I_RK] + head * 64 + j0 + 8 * q;
#pragma unroll
            for (int e = 0; e < 4; ++e) dp += hlo(rr[e]) * hlo(kq[e]) * rkp[2 * e] + hhi(rr[e]) * hhi(kq[e]) * rkp[2 * e + 1]; }
        dp += __shfl_xor(dp, 1); dp += __shfl_xor(dp, 2);
        const v4u v0 = *(const v4u*)(rec + 512 + j0 * 2), v1 = *(const v4u*)(rec + 512 + j0 * 2 + 16);
        const v4u g0 = *(const v4u*)(LO + (size_t)m * 3072 + 2048 + ch), g1 = *(const v4u*)(LO + (size_t)m * 3072 + 2048 + ch + 8);
        float vv[16], gg[16];
#pragma unroll
        for (int e = 0; e < 4; ++e) { vv[2 * e] = hlo(v0[e]); vv[2 * e + 1] = hhi(v0[e]); vv[8 + 2 * e] = hlo(v1[e]); vv[8 + 2 * e + 1] = hhi(v1[e]);
            gg[2 * e] = bflo(g0[e]); gg[2 * e + 1] = bfhi(g0[e]); gg[8 + 2 * e] = bflo(g1[e]); gg[8 + 2 * e + 1] = bfhi(g1[e]); }
        float r[16];
#pragma unroll
        for (int e = 0; e < 16; ++e) r[e] = ((o[e] - mean) * rstd * A.in[I_GNG][ch + e] + A.in[I_GNB][ch + e] + dp * vv[e]) * gg[e];
        v4u w0, w1; w0.x = pk2(r[0], r[1]); w0.y = pk2(r[2], r[3]); w0.z = pk2(r[4], r[5]); w0.w = pk2(r[6], r[7]); w1.x = pk2(r[8], r[9]); w1.y = pk2(r[10], r[11]); w1.z = pk2(r[12], r[13]); w1.w = pk2(r[14], r[15]);
        *(v4u*)(CAT + (size_t)m * 2048 + 1024 + ch) = w0; *(v4u*)(CAT + (size_t)m * 2048 + 1024 + ch + 8) = w1; }
}

__device__ __forceinline__ void ln1_rows(Frame& F, const Args& A) {
    const float* Z = (const float*)(A.ws + WS_Z); float* H1 = (float*)(A.ws + WS_H1); bf16* H1B = (bf16*)(A.ws + WS_H1B);
    const int gw = F.bid * NWAVES + F.wave, NGW = F.G * NWAVES, lane = F.lane;
    for (int m = gw; m < M; m += NGW) { const f32x4* zr = (const f32x4*)(Z + (size_t)m * D) + lane; f32x4 v[8]; float s = 0.f;
#pragma unroll
        for (int j = 0; j < 8; ++j) { v[j] = zr[64 * j]; s += (v[j].x + v[j].y) + (v[j].z + v[j].w); }
        const float mean = wave_sum(s) * (1.f / D); float s2 = 0.f;
#pragma unroll
        for (int j = 0; j < 8; ++j) { v[j] = v[j] - mean; s2 += (v[j].x * v[j].x + v[j].y * v[j].y) + (v[j].z * v[j].z + v[j].w * v[j].w); }
        const float rstd = 1.f / sqrtf(wave_sum(s2) * (1.f / D) + LN_EPS);
#pragma unroll
        for (int j = 0; j < 8; ++j) { const f32x4 g = ((const f32x4*)A.in[I_LN1G])[64 * j + lane], bb = ((const f32x4*)A.in[I_LN1B])[64 * j + lane]; const f32x4 y = v[j] * rstd * g + bb;
            ((f32x4*)(H1 + (size_t)m * D))[64 * j + lane] = y;
            unsigned long long pk = (unsigned long long)pk2(y.x, y.y) | ((unsigned long long)pk2(y.z, y.w) << 32); ((unsigned long long*)(H1B + (size_t)m * D))[64 * j + lane] = pk; } }
}

__device__ __forceinline__ void ins16(float (&tv)[16], float x) {
#pragma unroll
    for (int k = 15; k >= 1; --k) tv[k] = __builtin_amdgcn_fmed3f(tv[k - 1], tv[k], x);
    tv[0] = fmaxf(tv[0], x);
}
__device__ __forceinline__ void topk_phase(Frame& F, const Args& A) {
    const float* SCp = (const float*)(A.ws + WS_SC); int* IDX = (int*)(A.ws + WS_IDX); float* GATE = (float*)(A.ws + WS_GATE);
    LAS float* scr = (LAS float*)(F.lds + F.wave * 8448); LAS unsigned* scu = (LAS unsigned*)scr;
    const int gw = F.bid * NWAVES + F.wave, NGW = F.G * NWAVES, lane = F.lane;
    for (int grp = gw; grp < M / 4; grp += NGW) { const float* base = SCp + (size_t)grp * 4 * 2048;
        float tv[16];
#pragma unroll
        for (int k = 0; k < 16; ++k) tv[k] = -INFINITY;
        for (int q = 0; q < 4; ++q) {
#pragma unroll
            for (int k = 0; k < 8; ++k) { const int rowl = k * 8 + (lane >> 3), c4 = (lane & 7) * 4; const f32x4 x = *(const f32x4*)(base + rowl * 128 + q * 32 + c4);
                scr[rowl * 33 + c4] = x[0]; scr[rowl * 33 + c4 + 1] = x[1]; scr[rowl * 33 + c4 + 2] = x[2]; scr[rowl * 33 + c4 + 3] = x[3]; }
            LDS_WAIT(); asm volatile("" ::: "memory");
#pragma unroll
            for (int i = 0; i < 32; ++i) { const unsigned key = (scu[lane * 33 + i] & ~127u) | (unsigned)(q * 32 + i); ins16(tv, __uint_as_float(key)); }
            LDS_WAIT(); asm volatile("" ::: "memory");
        }
        const int jb = lane & 1; float Av[16], Bv[16];
#pragma unroll
        for (int k = 0; k < 16; ++k) { const float ot = __shfl_xor(tv[k], 1); Av[k] = jb ? ot : tv[k]; Bv[k] = jb ? tv[k] : ot; }
#pragma unroll
        for (int k = 0; k < 16; ++k) { scu[lane * 33 + k] = __float_as_uint(Av[k]) & 127u; scu[lane * 33 + 16 + k] = __float_as_uint(Bv[k]) & 127u; }
        float tw[16];
#pragma unroll
        for (int k = 0; k < 16; ++k) tw[k] = -INFINITY;
#define CROW(i, n) _Pragma("unroll") for (int jj = 0; jj < (n); ++jj) { const float c = Av[i] + Bv[jj]; ins16(tw, __uint_as_float((__float_as_uint(c) & ~255u) | (unsigned)((i) * 16 + jj))); }
        CROW(0, 16) CROW(1, 8) CROW(2, 5) CROW(3, 4) CROW(4, 3) CROW(5, 2) CROW(6, 2) CROW(7, 2) CROW(8, 1) CROW(9, 1) CROW(10, 1) CROW(11, 1) CROW(12, 1) CROW(13, 1) CROW(14, 1) CROW(15, 1)
#undef CROW
        LDS_WAIT(); asm volatile("" ::: "memory");
        float ex[16]; float sum = 0.f;
#pragma unroll
        for (int k = 0; k < 16; ++k) { ex[k] = __expf(tw[k] - tw[0]); sum += ex[k]; }
        const float rs = 1.f / sum; int eid[16];
#pragma unroll
        for (int k = 0; k < 16; ++k) { const unsigned pos = __float_as_uint(tw[k]) & 255u; const unsigned ia = scu[lane * 33 + (pos >> 4)], ib = scu[lane * 33 + 16 + (pos & 15u)]; eid[k] = (int)(ia * 128u + ib); }
        const int token = grp * 4 + (lane >> 4), head = (lane >> 1) & 7; const size_t ob = (size_t)token * 128 + head * 16;
        if (jb == 0) {
#pragma unroll
            for (int k = 0; k < 16; k += 4) { *(int4*)(IDX + ob + k) = make_int4(eid[k], eid[k + 1], eid[k + 2], eid[k + 3]); *(f32x4*)(GATE + ob + k) = (f32x4){ex[k] * rs, ex[k + 1] * rs, ex[k + 2] * rs, ex[k + 3] * rs}; } }
        LDS_WAIT(); asm volatile("" ::: "memory");
    }
}

constexpr int PNT = 4, PNP = PNT * 128, PR = 3, PNPAD = PNP + 4, PEER_WAVE_LDS = 17408;
static_assert(NWAVES * PEER_WAVE_LDS <= LDSCTL_OFF && PR * 4096 + PNPAD * 8 + 512 <= PEER_WAVE_LDS, "PEER LDS map");
__device__ __forceinline__ int dpp_i(int v, const int sel) {
    switch (sel) { case 0: return __builtin_amdgcn_update_dpp(0, v, 0x111, 0xf, 0xf, true);
                   case 1: return __builtin_amdgcn_update_dpp(0, v, 0x112, 0xf, 0xf, true);
                   case 2: return __builtin_amdgcn_update_dpp(0, v, 0x114, 0xf, 0xf, true);
                   case 3: return __builtin_amdgcn_update_dpp(0, v, 0x118, 0xf, 0xf, true);
                   case 4: return __builtin_amdgcn_update_dpp(0, v, 0x142, 0xa, 0xf, false);
                   default: return __builtin_amdgcn_update_dpp(0, v, 0x143, 0xc, 0xf, false); }
}
__device__ __forceinline__ int wave_total_i32(int v) {
    v += dpp_i(v, 0); v += dpp_i(v, 1); v += dpp_i(v, 2); v += dpp_i(v, 3); v += dpp_i(v, 4); v += dpp_i(v, 5);
    return __builtin_amdgcn_readlane(v, 63);
}
template <bool DUMMY> __device__ __forceinline__ void peer_phase(Frame& F, const Args& A) {
    const float* H1 = (const float*)(A.ws + WS_H1); const unsigned char* U8 = A.ws + WS_UTAB; const unsigned char* V8 = A.ws + WS_VTAB; const float* SU = (const float*)(A.ws + WS_SU);
    const int* IDX = (const int*)(A.ws + WS_IDX); const float* GATE = (const float*)(A.ws + WS_GATE);
    const int gw = F.bid * NWAVES + F.wave, NGW = F.G * NWAVES;
    LAS unsigned char* wl = F.lds + F.wave * PEER_WAVE_LDS;
    LAS unsigned char* ring = wl;
    LAS unsigned* list = (LAS unsigned*)(wl + PR * 4096);
    LAS unsigned* cnt = (LAS unsigned*)(wl + PR * 4096 + PNPAD * 8);
    for (int grp = gw; grp < M / PNT; grp += NGW) { const int tok0 = grp * PNT; int lane = (int)__builtin_amdgcn_mbcnt_hi(~0u, __builtin_amdgcn_mbcnt_lo(~0u, 0u)); asm volatile("" : "+v"(lane));
        cnt[lane] = 0u; cnt[64 + lane] = 0u;
        int ev[2 * PNT]; float gv[2 * PNT], sv[2 * PNT];
#pragma unroll
        for (int q = 0; q < 2 * PNT; ++q) { ev[q] = IDX[(size_t)(tok0 + (q >> 1)) * 128 + (q & 1) * 64 + lane]; gv[q] = GATE[(size_t)(tok0 + (q >> 1)) * 128 + (q & 1) * 64 + lane]; }
#pragma unroll
        for (int q = 0; q < 2 * PNT; ++q) sv[q] = SU[ev[q]];
        LDS_WAIT(); asm volatile("" ::: "memory");
#pragma unroll
        for (int q = 0; q < 2 * PNT; ++q) __hip_atomic_fetch_add(cnt + (ev[q] >> 7), 1u, __ATOMIC_RELAXED, __HIP_MEMORY_SCOPE_WORKGROUP);
        LDS_WAIT(); asm volatile("" ::: "memory");
        { const unsigned a = cnt[2 * lane], b = cnt[2 * lane + 1]; int inc = (int)(a + b);
          inc += dpp_i(inc, 0); inc += dpp_i(inc, 1); inc += dpp_i(inc, 2); inc += dpp_i(inc, 3); inc += dpp_i(inc, 4); inc += dpp_i(inc, 5);
          const unsigned ex = (unsigned)inc - (a + b); cnt[2 * lane] = ex; cnt[2 * lane + 1] = ex + a; }
        LDS_WAIT(); asm volatile("" ::: "memory");
#pragma unroll
        for (int q = 0; q < 2 * PNT; ++q) { const unsigned pos = __hip_atomic_fetch_add(cnt + (ev[q] >> 7), 1u, __ATOMIC_RELAXED, __HIP_MEMORY_SCOPE_WORKGROUP);
            const unsigned short gh = __builtin_bit_cast(unsigned short, (_Float16)gv[q]);
            list[2 * pos] = (unsigned)ev[q] | ((unsigned)(q >> 1) << 14) | ((unsigned)gh << 16); list[2 * pos + 1] = __float_as_uint(sv[q]); }
        if (lane < PNPAD - PNP) { unsigned z_ = 0u; asm volatile("" : "+v"(z_)); list[2 * (PNP + lane)] = z_; list[2 * (PNP + lane) + 1] = z_; }
        LDS_WAIT(); asm volatile("" ::: "memory");
        unsigned xq[PNT][8]; float sx[PNT];
#pragma unroll
        for (int k = 0; k < PNT; ++k) { const float* hr = H1 + (size_t)(tok0 + k) * D + lane * 16; f32x4 x[8]; float am = 0.f;
#pragma unroll
            for (int i = 0; i < 8; ++i) { x[i] = *(const f32x4*)(hr + (i >> 2) * 1024 + (i & 3) * 4); am = fmaxf(am, fmaxf(fmaxf(fabsf(x[i].x), fabsf(x[i].y)), fmaxf(fabsf(x[i].z), fabsf(x[i].w)))); }
#pragma unroll
            for (int o = 1; o < 64; o <<= 1) am = fmaxf(am, __shfl_xor(am, o));
            const float sc = (am > 0.f) ? am * (1.f / 127.f) : 1.f, inv = 1.f / sc; sx[k] = __builtin_bit_cast(float, __builtin_amdgcn_readfirstlane(__builtin_bit_cast(int, sc)));
#pragma unroll
            for (int i = 0; i < 8; ++i) { const int a = (int)rintf(x[i].x * inv), b = (int)rintf(x[i].y * inv), c = (int)rintf(x[i].z * inv), d = (int)rintf(x[i].w * inv);
                xq[k][i] = (unsigned)(a & 255) | ((unsigned)(b & 255) << 8) | ((unsigned)(c & 255) << 16) | ((unsigned)(d & 255) << 24); }
            asm volatile("" ::: "memory"); }
        float acc[PNT][32];
#pragma unroll
        for (int k = 0; k < PNT; ++k)
#pragma unroll
            for (int i = 0; i < 32; ++i) acc[k][i] = 0.f;
#define PEER_ISSUE(n) do { const unsigned e_ = (unsigned)__builtin_amdgcn_readfirstlane((int)list[2 * (n)]) & (DUMMY ? 0xffu : 0x3fffu); LAS unsigned char* sl_ = ring + ((n) % PR) * 4096; \
        const unsigned char* up_ = U8 + (size_t)e_ * D + lane * 16; const unsigned char* vp_ = V8 + (size_t)e_ * D + lane * 16; \
        __builtin_amdgcn_global_load_lds((const unsigned*)up_, (LAS unsigned*)sl_, 16, 0, 0); __builtin_amdgcn_global_load_lds((const unsigned*)(up_ + 1024), (LAS unsigned*)(sl_ + 1024), 16, 0, 0); \
        __builtin_amdgcn_global_load_lds((const unsigned*)vp_, (LAS unsigned*)(sl_ + 2048), 16, 0, 0); __builtin_amdgcn_global_load_lds((const unsigned*)(vp_ + 1024), (LAS unsigned*)(sl_ + 3072), 16, 0, 0); } while (0)
#define PEER_CORE(k) do { int d_ = 0; \
        d_ = __builtin_amdgcn_sdot4((int)u0.x, (int)xq[k][0], d_, false); d_ = __builtin_amdgcn_sdot4((int)u0.y, (int)xq[k][1], d_, false); d_ = __builtin_amdgcn_sdot4((int)u0.z, (int)xq[k][2], d_, false); d_ = __builtin_amdgcn_sdot4((int)u0.w, (int)xq[k][3], d_, false); \
        d_ = __builtin_amdgcn_sdot4((int)u1.x, (int)xq[k][4], d_, false); d_ = __builtin_amdgcn_sdot4((int)u1.y, (int)xq[k][5], d_, false); d_ = __builtin_amdgcn_sdot4((int)u1.z, (int)xq[k][6], d_, false); d_ = __builtin_amdgcn_sdot4((int)u1.w, (int)xq[k][7], d_, false); \
        d_ = wave_total_i32(d_); const float z_ = (float)d_ * su * sx[k]; const float s_ = gate * gelu_tanh(z_); \
        v4u v0 = *(const LAS v4u*)(sl + 2048 + lane * 16), v1 = *(const LAS v4u*)(sl + 3072 + lane * 16); asm volatile("s_waitcnt lgkmcnt(0)" : "+v"(v0), "+v"(v1) :: "memory");     \
        _Pragma("unroll") for (int i = 0; i < 4; ++i) { const f32x2 a_ = __builtin_amdgcn_cvt_pk_f32_fp8((int)v0[i], false), b_ = __builtin_amdgcn_cvt_pk_f32_fp8((int)v0[i], true); \
            acc[k][4 * i] += s_ * a_.x; acc[k][4 * i + 1] += s_ * a_.y; acc[k][4 * i + 2] += s_ * b_.x; acc[k][4 * i + 3] += s_ * b_.y; } \
        _Pragma("unroll") for (int i = 0; i < 4; ++i) { const f32x2 a_ = __builtin_amdgcn_cvt_pk_f32_fp8((int)v1[i], false), b_ = __builtin_amdgcn_cvt_pk_f32_fp8((int)v1[i], true); \
            acc[k][16 + 4 * i] += s_ * a_.x; acc[k][16 + 4 * i + 1] += s_ * a_.y; acc[k][16 + 4 * i + 2] += s_ * b_.x; acc[k][16 + 4 * i + 3] += s_ * b_.y; } } while (0)
        PEER_ISSUE(0); PEER_ISSUE(1);
        for (int n = 0; n < PNP; ++n) {
            asm volatile("s_waitcnt vmcnt(4)" ::: "memory");
            const LAS unsigned char* sl = ring + (n % PR) * 4096;
            const v4u u0 = *(const LAS v4u*)(sl + lane * 16), u1 = *(const LAS v4u*)(sl + 1024 + lane * 16);
            const unsigned ent = (unsigned)__builtin_amdgcn_readfirstlane((int)list[2 * n]); const float su = __builtin_bit_cast(float, __builtin_amdgcn_readfirstlane((int)list[2 * n + 1]));
            const int tk = (int)((ent >> 14) & 3u); const float gate = (float)__builtin_bit_cast(_Float16, (unsigned short)(ent >> 16));
            if (tk == 0) PEER_CORE(0); else if (tk == 1) PEER_CORE(1); else if (tk == 2) PEER_CORE(2); else PEER_CORE(3);
            PEER_ISSUE(n + 2);
        }
        asm volatile("s_waitcnt vmcnt(0)" ::: "memory");
#undef PEER_ISSUE
#undef PEER_CORE
        asm volatile("" : "+v"(lane));
#pragma unroll
        for (int k = 0; k < PNT; ++k) { const size_t ro = (size_t)(tok0 + k) * D + lane * 16; float y[32]; float s1 = 0.f;
#pragma unroll
            for (int i = 0; i < 8; ++i) { const f32x4 h = *(const f32x4*)(H1 + ro + (i >> 2) * 1024 + (i & 3) * 4);
#pragma unroll
                for (int c = 0; c < 4; ++c) { y[4 * i + c] = ALPHA * h[c] + acc[k][4 * i + c]; s1 += y[4 * i + c]; } }
            const float mean = wave_sum(s1) * (1.f / D); float s2 = 0.f;
#pragma unroll
            for (int i = 0; i < 32; ++i) { y[i] -= mean; s2 += y[i] * y[i]; }
            const float rstd = 1.f / sqrtf(wave_sum(s2) * (1.f / D) + LN_EPS);
#pragma unroll
            for (int i = 0; i < 8; ++i) { const int co = lane * 16 + (i >> 2) * 1024 + (i & 3) * 4; const f32x4 g = *(const f32x4*)(A.in[I_LN2G] + co), bb = *(const f32x4*)(A.in[I_LN2B] + co); f32x4 r;
#pragma unroll
                for (int c = 0; c < 4; ++c) r[c] = y[4 * i + c] * rstd * g[c] + bb[c];
                if (!DUMMY) *(f32x4*)(A.out + (size_t)(tok0 + k) * D + co) = r; else asm volatile("" :: "v"(r)); }
            asm volatile("" ::: "memory"); }
        asm volatile("s_waitcnt vmcnt(0) lgkmcnt(0)" ::: "memory");
    }
}

__global__ void __launch_bounds__(NWAVES * 64, 2) fwd_kernel(Args args) {
    extern __shared__ __attribute__((aligned(16))) unsigned char lds[];
    Frame F;
    F.lds = (LAS unsigned char*)lds;
    F.MISC = (volatile LAS unsigned*)(F.lds + MISC_OFF);
    F.tid = threadIdx.x; F.lane = F.tid & 63; F.wave = __builtin_amdgcn_readfirstlane(F.tid >> 6);
    F.G = gridDim.x; F.bid = blockIdx.x;
    unsigned char* ws = args.ws;
    F.ctl = (gu32*)(ws + WS_CTL);
    for (int u = F.tid; u < (LDS_BYTES - LDSCTL_OFF) / 4; u += NWAVES * 64) ((LAS unsigned*)(F.lds + LDSCTL_OFF))[u] = 0u;
    __syncthreads();
    XcdBarrier bar; bar.bar = (unsigned*)(F.ctl + CW_BAR); bar.x = 0; bar.st = nullptr;
    if (!MK_PER_PHASE) bar = xcd_barrier_post((unsigned*)(F.ctl + CW_BAR), F.MISC + 8);
    const int lo = args.ph_lo, hi = args.ph_hi;
#ifndef PHMASK
#define PHMASK 0xFFFF
#endif
#define IN(k) (((PHMASK >> (k)) & 1) && lo <= (k) && (k) < hi)
#ifndef PROBE_DUP
#define PROBE_DUP -1
#endif
#define SEAM(k) do { if (IN(k) && IN((k) + 1)) xcd_barrier(bar); } while (0)
#define REP(k) for (int rep_ = 0; rep_ < ((PROBE_DUP == (k)) ? 2 : 1); ++rep_, ((PROBE_DUP == (k) && rep_ == 1) ? xcd_barrier(bar) : (void)0))
    typedef pg8::bf16_t pb;
    pb* XB = (pb*)(ws + WS_XB); pb* WIN = (pb*)(ws + WS_WIN); pb* U = (pb*)(ws + WS_U); pb* Gt = (pb*)(ws + WS_G); pb* MT = (pb*)(ws + WS_MT);
    pb* PRW = (pb*)(ws + WS_PRW); pb* YS = (pb*)(ws + WS_YS); pb* CAT = (pb*)(ws + WS_CAT); pb* AL = (pb*)(ws + WS_ALORA); pb* LO = (pb*)(ws + WS_LORA);
    pb* WGLU = (pb*)(ws + WS_WGLU); pb* WOUT = (pb*)(ws + WS_WOUT); pb* WQK = (pb*)(ws + WS_WQK); pb* WL = (pb*)(ws + WS_WLORA); pb* H1B = (pb*)(ws + WS_H1B);

    if (IN(0)) REP(0) { p0_prologue(F, args); } SEAM(0);
    if (IN(1)) REP(1) {
        pg8::Gemm g{XB, WIN, 2048, 2048, 2048}; pg8::StaticOrder S; S.init(M, INP, F.G, F.bid); pg8::EpiProj E{U, PRW};
        pg8::gemm_phase<pg8::EpiProj, pg8::StaticOrder, true, true>(F.lds + RING_OFF, g, S, E);
        s5_params(F, args, 64); wqk_units(F, args, F.bid >= 128 ? F.bid - 128 : -1, F.G - 128, 0, 256); } SEAM(1);
    if (IN(2)) REP(2) {
        pg8::Gemm g{U, Gt, 512, 640, 512}; pg8::OneUnit S{F.bid < 64 ? F.bid : -1, F.bid >> 1}; pg8::EpiSa E{U, (const float*)(ws + WS_A32)};
        pg8::gemm_phase<pg8::EpiSa, pg8::OneUnit, false, true>(F.lds + RING_OFF, g, S, E);
        r1_lora_in(F, args); wqk_units(F, args, F.bid >= 64 ? F.bid - 64 : -1, F.G - 64, 256, 512); } SEAM(2);
    if (IN(3)) REP(3) {
        { pg8::Gemm g{U, MT, 640, 640, 640}; pg8::OneUnit S{F.bid < 128 ? (F.bid >> 1) : -1, F.bid}; pg8::EpiY E{YS};
          pg8::gemm_phase<pg8::EpiY, pg8::OneUnit, false, true>(F.lds + RING_OFF, g, S, E); }
        { pg8::Gemm g{AL, WL, 384, 384, 384}; pg8::ListOrder S{F.bid < 128 ? 256 + F.bid : F.bid - 128, F.bid < 128 ? -1 : F.bid, 32}; pg8::EpiStoreBf16 E{LO, 3072};
          pg8::gemm_phase<pg8::EpiStoreBf16, pg8::ListOrder, true, true>(F.lds + RING_OFF, g, S, E); } } SEAM(3);
    if (IN(4)) REP(4) {
        { const int L = F.bid - 128; pg8::Gemm g{YS, WGLU, 1024, 1024, 1024}; pg8::OneUnit S{L >= 0 ? (L & 31) : -1, L >> 5}; pg8::EpiGLU E{YS, args.in[I_BGLU], CAT};
          pg8::gemm_phase<pg8::EpiGLU, pg8::OneUnit, false, true>(F.lds + RING_OFF, g, S, E); }
        wout_transpose(F, args, F.bid * NWAVES + F.wave, F.G * NWAVES, (LAS float*)(F.lds + F.wave * 16384)); r3_prep(F, args); } SEAM(4);
    if (IN(5)) REP(5) {
        if (F.wave < 4) rw_chunk_pre(F, args);
        else { const int g4 = F.bid * 4 + F.wave - 4, n4 = F.G * 4; peer_tables(F, args, g4, n4); }
        xcd_barrier(bar);
        rw_recur(F, args);
        if (PROBE_DUP == 51) { xcd_barrier(bar); rw_recur(F, args); }
        if (PROBE_DUP == 52) { xcd_barrier(bar); if (F.wave < 4) rw_chunk_pre(F, args); } } SEAM(5);
    if (IN(6)) REP(6) { r5_post(F, args); } SEAM(6);
    if (IN(7)) REP(7) {
        pg8::Gemm g{CAT, WOUT, 2048, 2048, 2048}; pg8::StaticOrder S; S.init(M, D, F.G, F.bid); pg8::EpiF32 E{(float*)(ws + WS_Z), args.in[I_X], D, ALPHA};
        pg8::gemm_phase<pg8::EpiF32, pg8::StaticOrder, true, true>(F.lds + RING_OFF, g, S, E); } SEAM(7);
    if (IN(8)) REP(8) { ln1_rows(F, args); } SEAM(8);
    if (IN(9)) REP(9) {
        pg8::Gemm g{H1B, WQK, 2048, 2048, 2048}; pg8::StaticOrder S; S.init(M, D, F.G, F.bid); pg8::EpiF32 E{(float*)(ws + WS_SC), nullptr, D, 0.f};
        pg8::gemm_phase<pg8::EpiF32, pg8::StaticOrder, true, true>(F.lds + RING_OFF, g, S, E); } SEAM(9);
    if (IN(10)) REP(10) { topk_phase(F, args); } SEAM(10);
    if (IN(11)) REP(11) { peer_phase<false>(F, args); }
#undef IN
#undef SEAM
}

extern "C" void kernel_launch(void* const* d_in, const int* in_sizes, int n_in, void* d_out, int out_size, void* d_ws, size_t ws_size, hipStream_t stream) {
    static int grid = 0;
    if (grid == 0) {
        if (n_in != 33 || in_sizes[0] != M * D || out_size != M * D || ws_size < WS_END) { fprintf(stderr, "kernel_launch: unexpected shapes (n_in %d, in0 %d, out %d, ws %zu)\n", n_in, n_in > 0 ? in_sizes[0] : -1, out_size, ws_size); grid = -1; return; }
        int dev = 0, cus = 0, per_cu = 0;
        if (hipGetDevice(&dev) != hipSuccess || hipDeviceGetAttribute(&cus, hipDeviceAttributeMultiprocessorCount, dev) != hipSuccess) { grid = -1; return; }
        if (hipFuncSetAttribute((const void*)fwd_kernel, hipFuncAttributeMaxDynamicSharedMemorySize, LDS_BYTES) != hipSuccess) { fprintf(stderr, "kernel_launch: hipFuncSetAttribute failed\n"); grid = -1; return; }
        if (hipOccupancyMaxActiveBlocksPerMultiprocessor(&per_cu, (const void*)fwd_kernel, NWAVES * 64, LDS_BYTES) != hipSuccess || per_cu < 1) { fprintf(stderr, "kernel_launch: occupancy query says %d blocks per CU\n", per_cu); per_cu = 1; }
        (void)hipGetLastError();
        grid = cus;
        if (grid != 256) fprintf(stderr, "kernel_launch: %d CUs (built for 256)\n", grid);
    }
    if (grid < 0) return;
    (void)hipMemsetAsync((char*)d_ws + WS_CTL, 0, CTL_ZERO_BYTES, stream);
    Args a{};
    for (int i = 0; i < 33; ++i) a.in[i] = (const float*)d_in[i];
    a.out = (float*)d_out; a.ws = (unsigned char*)d_ws; a.dup = PROBE_DUP;
#if MK_PER_PHASE
    for (int li = 0; li < NPHASE; ++li) { a.ph_lo = li; a.ph_hi = li + 1; a.li = li; hipLaunchKernelGGL(fwd_kernel, dim3(grid), dim3(NWAVES * 64), LDS_BYTES, stream, a); }
#else
    a.ph_lo = 0; a.ph_hi = NPHASE; a.li = 0;
    void* kargs[] = {(void*)&a};
    hipError_t e = hipLaunchCooperativeKernel((const void*)fwd_kernel, dim3(grid), dim3(NWAVES * 64), kargs, LDS_BYTES, stream);
    if (e != hipSuccess) fprintf(stderr, "kernel_launch: cooperative launch failed: %s\n", hipGetErrorString(e));
#endif
}
```

```cpp
#include <hip/hip_runtime.h>
#include <cstdio>
#include <cstdint>
#include <cmath>
#ifndef PROBE_DUP
#define PROBE_DUP -1
#endif
namespace pg8 {
#define PG8_LAS __attribute__((address_space(3)))
typedef unsigned short bf16_t;
typedef short bf16x8 __attribute__((ext_vector_type(8)));
typedef float f32x4 __attribute__((ext_vector_type(4)));
typedef float f32x2 __attribute__((ext_vector_type(2)));
typedef unsigned u32x4 __attribute__((ext_vector_type(4)));
constexpr int BM = 256, BK = 64, HALF = 128, HTB = HALF * BK * 2  , STAGE_BYTES = 8 * HTB, NXCD = 8, WGM = 8;

__host__ __device__ __forceinline__ int lds_byte(int r, int c) { const int st = (r >> 4) * 2 + (c >> 5), rr = r & 15, cc = c & 31, ob = rr * 64 + cc * 2; return st * 1024 + (ob ^ (((ob >> 9) & 1) << 5)); }
__host__ __device__ __forceinline__ void stage_rc(int b, int& R, int& C) { const int st = b / 1024, sb = b % 1024, swz = sb ^ (((sb >> 9) & 1) << 5); R = (st >> 1) * 16 + swz / 64; C = (st & 1) * 32 + (swz % 64) / 2; }
__host__ __device__ __forceinline__ int perm32(int rho) { const int n = rho >> 4, i = rho & 15; return 8 * (i >> 2) + 4 * n + (i & 3); }

struct Unit { int pm, pn; };
struct Gemm { const bf16_t* A; const bf16_t* Bt; int K, lda, ldb; };

struct StaticOrder {
    int nM, nN, nwg, G, c;
    __host__ __device__ void init(int M, int N, int G_, int c_) { nM = M / BM; nN = N / BM; nwg = nM * nN; G = G_; c = c_; }
    __host__ __device__ bool next(int i, Unit& u) const {
        const long L = (long)i * G + c; if (L >= nwg) return false;
        int wgid = (int)L; { const int q = nwg / NXCD, r = nwg % NXCD, xcd = wgid % NXCD, off = wgid / NXCD; wgid = (xcd < r ? xcd * (q + 1) : r * (q + 1) + (xcd - r) * q) + off; }
        const int nig = WGM * nN, gid = wgid / nig, fm = gid * WGM, gsz = (nM - fm) < WGM ? (nM - fm) : WGM;
        u.pm = fm + ((wgid % nig) % gsz); u.pn = (wgid % nig) / gsz; return true;
    }
    __device__ __forceinline__ void a_ready(const Unit&) const {}
    __device__ __forceinline__ void done(const Unit&) const {}
};
struct ListOrder {
    int L0, L1, nM;
    __device__ bool next(int i, Unit& u) const { const int L = (i == 0) ? L0 : ((i == 1) ? L1 : -1); if (L < 0) return false; u.pm = L % nM; u.pn = L / nM; return true; }
    __device__ __forceinline__ void a_ready(const Unit&) const {}
    __device__ __forceinline__ void done(const Unit&) const {}
};
struct OneUnit {
    int pm, pn;
    __device__ bool next(int i, Unit& u) const { if (i != 0 || pm < 0) return false; u.pm = pm; u.pn = pn; return true; }
    __device__ __forceinline__ void a_ready(const Unit&) const {}
    __device__ __forceinline__ void done(const Unit&) const {}
};

__device__ __forceinline__ unsigned cvt_pk_bf16(float lo, float hi) { unsigned r; asm volatile("v_cvt_pk_bf16_f32 %0, %1, %2" : "=v"(r) : "v"(lo), "v"(hi)); return r; }
__device__ __forceinline__ float bf_lo(unsigned w) { return __uint_as_float(w << 16); }
__device__ __forceinline__ float bf_hi(unsigned w) { return __uint_as_float(w & 0xffff0000u); }
__device__ __forceinline__ float gelu_tanh(float x) { const float y = 0.7978845608f * (x + 0.044715f * x * x * x); return x * __builtin_amdgcn_rcpf(1.0f + __expf(-2.0f * y)); }
__device__ __forceinline__ float sigmoidf(float x) { return __builtin_amdgcn_rcpf(1.0f + __expf(-x)); }

__device__ __forceinline__ u32x4 pack8(const f32x4 v0, const f32x4 v1) { u32x4 w; w.x = cvt_pk_bf16(v0[0], v0[1]); w.y = cvt_pk_bf16(v0[2], v0[3]); w.z = cvt_pk_bf16(v1[0], v1[1]); w.w = cvt_pk_bf16(v1[2], v1[3]); return w; }

struct EpiStoreBf16 {
    static constexpr bool PERM = true, AFTER_DRAIN = false;
    bf16_t* O; int ldc;
    __device__ __forceinline__ void operator()(const f32x4 (&acc)[2][2][4][2], const Unit& u, int wr, int wc, int fr, int fq) const {
        const int row0 = u.pm * BM + wr * 64 + fr, col0 = u.pn * BM + wc * 32 + 8 * fq;
#pragma unroll
        for (int ai = 0; ai < 2; ++ai)
#pragma unroll
            for (int m = 0; m < 4; ++m) { bf16_t* rowp = O + (size_t)(row0 + ai * HALF + m * 16) * ldc + col0;
#pragma unroll
                for (int bj = 0; bj < 2; ++bj) *(u32x4*)(rowp + bj * HALF) = pack8(acc[ai][bj][m][0], acc[ai][bj][m][1]); }
    }
};
struct EpiProj {
    static constexpr bool PERM = true, AFTER_DRAIN = false;
    bf16_t* U; bf16_t* PRW;
    __device__ __forceinline__ void operator()(const f32x4 (&acc)[2][2][4][2], const Unit& u, int wr, int wc, int fr, int fq) const {
        const int row0 = u.pm * BM + wr * 64 + fr, col0 = u.pn * BM + wc * 32 + 8 * fq;
#pragma unroll
        for (int ai = 0; ai < 2; ++ai)
#pragma unroll
            for (int m = 0; m < 4; ++m) { const int row = row0 + ai * HALF + m * 16;
#pragma unroll
                for (int bj = 0; bj < 2; ++bj) { const int col = col0 + bj * HALF; const u32x4 w = pack8(acc[ai][bj][m][0], acc[ai][bj][m][1]);
                    if (u.pn < 4) { const int g = col >> 4, h0 = col & 15, b = row >> 11, t = row & 2047, c = t >> 5, s = t & 31;
                        *(u32x4*)(U + (size_t)(g * 256 + b * 64 + c) * 640 + s * 16 + h0) = w; }
                    else *(u32x4*)(PRW + (size_t)row * 3584 + (col - 1024)) = w; } }
    }
};
struct EpiY {
    static constexpr bool PERM = true, AFTER_DRAIN = false;
    bf16_t* YS;
    __device__ __forceinline__ void operator()(const f32x4 (&acc)[2][2][4][2], const Unit& u, int wr, int wc, int fr, int fq) const {
        const int g = u.pm, j = u.pn & 1;
#pragma unroll
        for (int ai = 0; ai < 2; ++ai)
#pragma unroll
            for (int m = 0; m < 4; ++m) { const int rowl = ai * HALF + wr * 64 + m * 16 + fr, b = rowl >> 6, c = rowl & 63;
#pragma unroll
                for (int bj = 0; bj < 2; ++bj) { const int n = 256 * j + bj * HALF + wc * 32 + 8 * fq, tl = n >> 4, h0 = n & 15;
                    f32x4 v0 = acc[ai][bj][m][0], v1 = acc[ai][bj][m][1];
#pragma unroll
                    for (int e = 0; e < 4; ++e) { v0[e] = gelu_tanh(v0[e]); v1[e] = gelu_tanh(v1[e]); }
                    *(u32x4*)(YS + (size_t)(b * 2048 + c * 32 + tl) * 1024 + g * 16 + h0) = pack8(v0, v1); }
                asm volatile("" ::: "memory"); }
    }
};
struct EpiGLU {
    static constexpr bool PERM = true, AFTER_DRAIN = false;
    const bf16_t* YS; const float* bglu; bf16_t* CAT;
    __device__ __forceinline__ void operator()(const f32x4 (&acc)[2][2][4][2], const Unit& u, int wr, int wc, int fr, int fq) const {
        const int row0 = u.pm * BM + wr * 64 + fr, col0 = u.pn * BM + wc * 32 + 8 * fq;
#pragma unroll
        for (int bj = 0; bj < 2; ++bj) { const int col = col0 + bj * HALF; const f32x4 b0 = *(const f32x4*)(bglu + col), b1 = *(const f32x4*)(bglu + col + 4);
#pragma unroll
            for (int ai = 0; ai < 2; ++ai)
#pragma unroll
                for (int m = 0; m < 4; ++m) { const int row = row0 + ai * HALF + m * 16; const u32x4 y = *(const u32x4*)(YS + (size_t)row * 1024 + col);
                    const f32x4 a0 = acc[ai][bj][m][0] + b0, a1 = acc[ai][bj][m][1] + b1; f32x4 o0, o1;
                    o0[0] = bf_lo(y.x) * sigmoidf(a0[0]); o0[1] = bf_hi(y.x) * sigmoidf(a0[1]); o0[2] = bf_lo(y.y) * sigmoidf(a0[2]); o0[3] = bf_hi(y.y) * sigmoidf(a0[3]);
                    o1[0] = bf_lo(y.z) * sigmoidf(a1[0]); o1[1] = bf_hi(y.z) * sigmoidf(a1[1]); o1[2] = bf_lo(y.w) * sigmoidf(a1[2]); o1[3] = bf_hi(y.w) * sigmoidf(a1[3]);
                    *(u32x4*)(CAT + (size_t)row * 2048 + col) = pack8(o0, o1); } }
    }
};
struct EpiF32 {
    static constexpr bool PERM = false, AFTER_DRAIN = false;
    float* O; const float* R; int ldc; float alpha;
    __device__ __forceinline__ void operator()(const f32x4 (&acc)[2][2][4][2], const Unit& u, int wr, int wc, int fr, int fq) const {
        const int row0 = u.pm * BM + wr * 64 + fr, col0 = u.pn * BM + wc * 32 + 4 * fq;
#pragma unroll
        for (int ai = 0; ai < 2; ++ai)
#pragma unroll
            for (int m = 0; m < 4; ++m) { const size_t off = (size_t)(row0 + ai * HALF + m * 16) * ldc + col0;
#pragma unroll
                for (int bj = 0; bj < 2; ++bj)
#pragma unroll
                    for (int n = 0; n < 2; ++n) { f32x4 o = acc[ai][bj][m][n]; if (R) { const f32x4 r = *(const f32x4*)(R + off + bj * HALF + n * 16); o = o + r * alpha; }
                        *(f32x4*)(O + off + bj * HALF + n * 16) = o; } }
    }
};
struct EpiSa {
    static constexpr bool PERM = false, AFTER_DRAIN = true;
    bf16_t* U; const float* A32;
    __device__ __forceinline__ void fused(const f32x4 (&acc)[2][2][4][2], const Unit& u, int wr, int wc, int fr, int fq, PG8_LAS unsigned char* lds, int wid, int lane) const {
        const int g = u.pm, gb = g & 1;
        PG8_LAS float* SL = (PG8_LAS float*)lds;
#pragma unroll
        for (int ai = 0; ai < 2; ++ai)
#pragma unroll
            for (int m = 0; m < 4; ++m) { const int rowl = ai * HALF + wr * 64 + m * 16 + fr;
#pragma unroll
                for (int bj = 0; bj < 2; ++bj) if (bj == gb) {
#pragma unroll
                    for (int n = 0; n < 2; ++n) *(PG8_LAS f32x4*)(SL + rowl * 128 + wc * 32 + n * 16 + 4 * fq) = acc[ai][bj][m][n]; } }
        asm volatile("s_waitcnt lgkmcnt(0)" ::: "memory"); __builtin_amdgcn_s_barrier(); asm volatile("" ::: "memory");
        const int tid = wid * 64 + lane;
        if (tid < 256) { const int b = tid >> 6, p = tid & 63; const float ar = A32[(g * 64 + p) * 2], ai_ = A32[(g * 64 + p) * 2 + 1]; float hr = 0.f, hi = 0.f;
            for (int c = 0; c < 64; ++c) { bf16_t* up = U + (size_t)(g * 256 + b * 64 + c) * 640 + 512 + p;
                const unsigned pk = cvt_pk_bf16(hr, hi); up[0] = (bf16_t)(pk & 0xffffu); up[64] = (bf16_t)(pk >> 16);
                const float sr = SL[(b * 64 + c) * 128 + p], si = SL[(b * 64 + c) * 128 + 64 + p];
                const float nr = ar * hr - ai_ * hi + sr, ni = ar * hi + ai_ * hr + si; hr = nr; hi = ni; } }
    }
};

template <class Epi, class Sched, bool ALIGN_EPI = false, bool SP2 = false>
__device__ __forceinline__ void gemm_phase(PG8_LAS unsigned char* lds, const Gemm g, const Sched& S, const Epi& E) {
    const int tid = threadIdx.x, wid = __builtin_amdgcn_readfirstlane(tid >> 6), lane = tid & 63, wr = wid >> 2, wc = wid & 3, fr = lane & 15, fq = lane >> 4;
    const int K = g.K, nt = K / BK;
    unsigned voffA[2], voffB[2];
#pragma unroll
    for (int i = 0; i < 2; ++i) { int R, C; stage_rc(tid * 16 + i * 8192, R, C); const int Rb = Epi::PERM ? ((R & ~31) + perm32(R & 31)) : R;
        voffA[i] = (unsigned)(R * g.lda + C) * 2u; voffB[i] = (unsigned)(Rb * g.ldb + C) * 2u; }
    const size_t kstep = (size_t)(BK * 2);
    const size_t hsA = (size_t)HALF * g.lda * 2, hsB = (size_t)HALF * g.ldb * 2;
    const size_t tsA = 2 * hsA, tsB = 2 * hsB;
    const unsigned ldsw = (unsigned)wid * 1024u;
    const int aoff = lds_byte(wr * 64 + fr, fq * 8), boff = lds_byte(wc * 32 + fr, fq * 8);
#define PG8_SA(b, h) (((b) * 2 + (h)) * HTB)
#define PG8_SB(b, h) ((4 + (b) * 2 + (h)) * HTB)
#define PG8_STAGE(bufoff, gbase, voff) do { _Pragma("unroll") for (int _i = 0; _i < 2; ++_i) \
        __builtin_amdgcn_global_load_lds((const unsigned*)((const char*)(gbase) + (voff)[_i]), (PG8_LAS unsigned*)(lds + (bufoff) + ldsw + _i * 8192), 16, 0, 0); } while (0)
#define PG8_LDA(dst, b, h) do { _Pragma("unroll") for (int m = 0; m < 4; ++m) _Pragma("unroll") for (int k = 0; k < 2; ++k) dst[m][k] = *(const PG8_LAS bf16x8*)(lds + PG8_SA(b, h) + aoff + m * 2048 + k * 1024); } while (0)
#define PG8_LDB(dst, b, h) do { _Pragma("unroll") for (int n = 0; n < 2; ++n) _Pragma("unroll") for (int k = 0; k < 2; ++k) dst[n][k] = *(const PG8_LAS bf16x8*)(lds + PG8_SB(b, h) + boff + n * 2048 + k * 1024); } while (0)
#define PG8_MMA(ai, bj, At, Bt) do { __builtin_amdgcn_s_setprio(1); _Pragma("unroll") for (int m = 0; m < 4; ++m) _Pragma("unroll") for (int n = 0; n < 2; ++n) _Pragma("unroll") for (int k = 0; k < 2; ++k) \
        acc[ai][bj][m][n] = __builtin_amdgcn_mfma_f32_16x16x32_bf16(Bt[n][k], At[m][k], acc[ai][bj][m][n], 0, 0, 0); __builtin_amdgcn_s_setprio(0); } while (0)
#define PG8_WAIT_V(n) asm volatile("s_waitcnt vmcnt(" #n ")" ::: "memory")
#define PG8_WAIT_L(n) asm volatile("s_waitcnt lgkmcnt(" #n ")" ::: "memory")
#define PG8_BAR __builtin_amdgcn_s_barrier()
#define PG8_SCHED __builtin_amdgcn_sched_barrier(0)
    Unit cur, nxt; int ui = 0;
    if (!S.next(0, cur)) return;
    f32x4 acc[2][2][4][2];
#pragma unroll
    for (int a = 0; a < 2; ++a)
#pragma unroll
        for (int b = 0; b < 2; ++b)
#pragma unroll
            for (int m = 0; m < 4; ++m)
#pragma unroll
                for (int n = 0; n < 2; ++n) acc[a][b][m][n] = (f32x4){0.f, 0.f, 0.f, 0.f};
    bf16x8 At[4][2], B0[2][2], B1[2][2];
    const char* cA = (const char*)g.A + (size_t)cur.pm * tsA; const char* cB = (const char*)g.Bt + (size_t)cur.pn * tsB;
    S.a_ready(cur);
    if constexpr (SP2) {
        PG8_STAGE(PG8_SB(0, 0), cB, voffB); PG8_STAGE(PG8_SB(0, 1), cB + hsB, voffB); PG8_STAGE(PG8_SA(0, 0), cA, voffA); PG8_STAGE(PG8_SA(0, 1), cA + hsA, voffA);
        if (wr == 1) PG8_BAR;
        PG8_WAIT_V(2); PG8_BAR;
        PG8_STAGE(PG8_SB(1, 0), cB + kstep, voffB); PG8_STAGE(PG8_SA(1, 0), cA + kstep, voffA); PG8_STAGE(PG8_SB(1, 1), cB + hsB + kstep, voffB);
        PG8_WAIT_V(6); PG8_BAR;
    } else {
        PG8_STAGE(PG8_SB(0, 0), cB, voffB); PG8_STAGE(PG8_SA(0, 0), cA, voffA); PG8_STAGE(PG8_SB(0, 1), cB + hsB, voffB); PG8_STAGE(PG8_SA(0, 1), cA + hsA, voffA);
        if (wr == 1) PG8_BAR;
        PG8_WAIT_V(4); PG8_BAR;
        PG8_STAGE(PG8_SB(1, 0), cB + kstep, voffB); PG8_STAGE(PG8_SA(1, 0), cA + kstep, voffA); PG8_STAGE(PG8_SB(1, 1), cB + hsB + kstep, voffB);
        PG8_WAIT_V(6); PG8_BAR;
    }
    for (;;) {
        const bool has_next = S.next(ui + 1, nxt);
        const char* nA = has_next ? (const char*)g.A + (size_t)nxt.pm * tsA : cA; const char* nB = has_next ? (const char*)g.Bt + (size_t)nxt.pn * tsB : cB;
#pragma nounroll
        for (int t = 0; t < nt; t += 2) {
            const bool last = (t == nt - 2);
            const char* a1 = cA + (size_t)(t + 1) * kstep;
            const char* a2 = last ? nA : cA + (size_t)(t + 2) * kstep; const char* b2 = last ? nB : cB + (size_t)(t + 2) * kstep;
            const char* a3 = a2 + kstep; const char* b3 = b2 + kstep;
            if (last && has_next) S.a_ready(nxt);
            if constexpr (SP2) {
            PG8_LDB(B0, 0, 0); PG8_LDB(B1, 0, 1); PG8_SCHED; PG8_LDA(At, 0, 0); PG8_STAGE(PG8_SA(1, 1), a1 + hsA, voffA);
            PG8_WAIT_V(8); PG8_WAIT_L(0); PG8_BAR; PG8_MMA(0, 0, At, B0); PG8_MMA(0, 1, At, B1); PG8_BAR; PG8_SCHED;
            PG8_LDA(At, 0, 1); PG8_STAGE(PG8_SB(0, 0), b2, voffB); PG8_STAGE(PG8_SB(0, 1), b2 + hsB, voffB); PG8_STAGE(PG8_SA(0, 0), a2, voffA);
            PG8_WAIT_V(8); PG8_WAIT_L(0); PG8_BAR; PG8_MMA(1, 0, At, B0); PG8_MMA(1, 1, At, B1); PG8_BAR; PG8_SCHED;
            PG8_LDB(B0, 1, 0); PG8_LDB(B1, 1, 1); PG8_SCHED; PG8_LDA(At, 1, 0); PG8_STAGE(PG8_SA(0, 1), a2 + hsA, voffA);
            PG8_WAIT_V(8); PG8_WAIT_L(0); PG8_BAR; PG8_MMA(0, 0, At, B0); PG8_MMA(0, 1, At, B1); PG8_BAR; PG8_SCHED;
            PG8_LDA(At, 1, 1); PG8_STAGE(PG8_SB(1, 0), b3, voffB); PG8_STAGE(PG8_SB(1, 1), b3 + hsB, voffB); PG8_STAGE(PG8_SA(1, 0), a3, voffA);
            PG8_WAIT_V(8); PG8_WAIT_L(0); PG8_BAR; PG8_MMA(1, 0, At, B0); PG8_MMA(1, 1, At, B1); PG8_BAR; PG8_SCHED;
            } else {
            PG8_LDB(B0, 0, 0); PG8_SCHED; PG8_LDA(At, 0, 0); PG8_STAGE(PG8_SA(1, 1), a1 + hsA, voffA);
            PG8_WAIT_L(8); PG8_BAR; PG8_WAIT_L(0); PG8_MMA(0, 0, At, B0); PG8_BAR; PG8_SCHED;
            PG8_LDB(B1, 0, 1); PG8_STAGE(PG8_SB(0, 0), b2, voffB);
            PG8_BAR; PG8_WAIT_L(0); PG8_MMA(0, 1, At, B1); PG8_BAR;
            PG8_LDA(At, 0, 1); PG8_STAGE(PG8_SA(0, 0), a2, voffA);
            PG8_BAR; PG8_WAIT_L(0); PG8_MMA(1, 0, At, B0); PG8_BAR; PG8_SCHED;
            PG8_STAGE(PG8_SB(0, 1), b2 + hsB, voffB);
            PG8_WAIT_V(6); PG8_BAR; PG8_MMA(1, 1, At, B1); PG8_BAR;
            PG8_LDB(B0, 1, 0); PG8_SCHED; PG8_LDA(At, 1, 0); PG8_STAGE(PG8_SA(0, 1), a2 + hsA, voffA);
            PG8_WAIT_L(8); PG8_BAR; PG8_WAIT_L(0); PG8_MMA(0, 0, At, B0); PG8_BAR; PG8_SCHED;
            PG8_LDB(B1, 1, 1); PG8_STAGE(PG8_SB(1, 0), b3, voffB);
            PG8_BAR; PG8_WAIT_L(0); PG8_MMA(0, 1, At, B1); PG8_BAR;
            PG8_LDA(At, 1, 1); PG8_STAGE(PG8_SA(1, 0), a3, voffA);
            PG8_BAR; PG8_WAIT_L(0); PG8_MMA(1, 0, At, B0); PG8_BAR; PG8_SCHED;
            PG8_STAGE(PG8_SB(1, 1), b3 + hsB, voffB);
            PG8_WAIT_V(6); PG8_BAR; PG8_MMA(1, 1, At, B1); PG8_BAR;
            }
        }
        if constexpr (ALIGN_EPI) { if (wr == 0) PG8_BAR; }
        if constexpr (!Epi::AFTER_DRAIN) { E(acc, cur, wr, wc, fr, fq); S.done(cur); }
        if (!has_next) break;
#pragma unroll
        for (int a = 0; a < 2; ++a)
#pragma unroll
            for (int b = 0; b < 2; ++b)
#pragma unroll
                for (int m = 0; m < 4; ++m)
#pragma unroll
                    for (int n = 0; n < 2; ++n) acc[a][b][m][n] = (f32x4){0.f, 0.f, 0.f, 0.f};
        cur = nxt; cA = nA; cB = nB; ++ui;
        if constexpr (ALIGN_EPI) { if (wr == 1) PG8_BAR; }
    }
    PG8_WAIT_V(0);
    if constexpr (!ALIGN_EPI) { if (wr == 0) PG8_BAR; }
    PG8_BAR;
    if constexpr (Epi::AFTER_DRAIN) { E.fused(acc, cur, wr, wc, fr, fq, lds, wid, lane); S.done(cur); }
#undef PG8_SA
#undef PG8_SB
#undef PG8_STAGE
#undef PG8_LDA
#undef PG8_LDB
#undef PG8_MMA
#undef PG8_WAIT_V
#undef PG8_WAIT_L
#undef PG8_BAR
#undef PG8_SCHED
}
}

constexpr int NWAVES = 8;
#ifndef MK_PER_PHASE
#define MK_PER_PHASE 0
#endif
constexpr int NPHASE = 12;
constexpr int M = 8192, D = 2048, SEQ = 2048;
constexpr int INC = 4384, INP = 4608;
constexpr float ALPHA = 1.189207115f;
constexpr float LN_EPS = 1e-5f, GN_EPS = 64e-5f;
constexpr size_t MiB = 1u << 20;
constexpr size_t WS_CTL = 0, CTL_ZERO_BYTES = 1 * MiB;
constexpr size_t WS_WGLU = 1 * MiB, WS_WOUT = 3 * MiB, WS_WQK = 11 * MiB, WS_WLORA = 19 * MiB, WS_IDX = 22 * MiB, WS_GATE = 26 * MiB, WS_A32 = 30 * MiB;
constexpr size_t WS_UTAB = 32 * MiB, WS_VTAB = 64 * MiB;
constexpr size_t WS_SU = 31 * MiB;
constexpr size_t WS_XB = 160 * MiB, WS_WIN = 192 * MiB, WS_U = 210 * MiB, WS_G = 230 * MiB, WS_MT = 238 * MiB;
constexpr size_t WS_SCAN = 160 * MiB;
constexpr size_t WS_PRW = 286 * MiB, WS_YS = 342 * MiB, WS_CAT = 358 * MiB, WS_ALORA = 390 * MiB, WS_LORA = 396 * MiB, WS_ORW = 444 * MiB;
constexpr size_t WS_Z = 160 * MiB, WS_H1 = 224 * MiB, WS_H1B = 288 * MiB, WS_SC = 390 * MiB;
constexpr size_t WS_END = 492 * MiB;
constexpr size_t WS_PHI = 272 * MiB, WS_PSI = 96 * MiB, WS_OM = 336 * MiB, WS_O0 = 476 * MiB, WS_G15 = 352 * MiB;
constexpr int RW_NC = SEQ / 16;
constexpr int SCAN_REC = 896;
constexpr int CW_BAR = 4096;
constexpr int RING_OFF = 0, RING_BYTES = 131072;
constexpr int LDS_BYTES = 147456;
constexpr int LDSCTL_OFF = LDS_BYTES - 1024, MISC_OFF = LDSCTL_OFF + 320;

#define GAS __attribute__((address_space(1)))
#define LAS __attribute__((address_space(3)))
typedef unsigned short bf16;
typedef unsigned v4u __attribute__((ext_vector_type(4)));
typedef float f32x4 __attribute__((ext_vector_type(4)));
typedef float f32x2 __attribute__((ext_vector_type(2)));
typedef _Float16 h16x2 __attribute__((ext_vector_type(2)));
typedef __bf16 bf16x2v __attribute__((ext_vector_type(2)));
typedef GAS unsigned gu32;
#define RLX_AGENT __ATOMIC_RELAXED, __HIP_MEMORY_SCOPE_AGENT
#define LDS_WAIT() asm volatile("s_waitcnt lgkmcnt(0)" ::: "memory")
#define VM_WAIT() asm volatile("s_waitcnt vmcnt(0)" ::: "memory")
__device__ __forceinline__ unsigned f2bf(float f) { unsigned u = __builtin_bit_cast(unsigned, f); return (u + 0x7fffu + ((u >> 16) & 1u)) >> 16; }
__device__ __forceinline__ unsigned pk2(float lo, float hi) { return f2bf(lo) | (f2bf(hi) << 16); }
__device__ __forceinline__ float bflo(unsigned w) { return __uint_as_float(w << 16); }
__device__ __forceinline__ float bfhi(unsigned w) { return __uint_as_float(w & 0xffff0000u); }
__device__ __forceinline__ float bf1(bf16 h) { return __uint_as_float((unsigned)h << 16); }
__device__ __forceinline__ unsigned pkh(float lo, float hi) { h16x2 v; v.x = (_Float16)lo; v.y = (_Float16)hi; return __builtin_bit_cast(unsigned, v); }
__device__ __forceinline__ float hlo(unsigned w) { return (float)__builtin_bit_cast(h16x2, w).x; }
__device__ __forceinline__ float hhi(unsigned w) { return (float)__builtin_bit_cast(h16x2, w).y; }
__device__ __forceinline__ float wave_sum(float v) {
#pragma unroll
    for (int o = 1; o < 64; o <<= 1) v += __shfl_xor(v, o);
    return v;
}
using pg8::gelu_tanh; using pg8::sigmoidf; using pg8::pack8;

#define XB_TMO      128
#define XB_XCNT(j)  (256  + 64 * (j))
#define XB_XSUB(j)  (1280 + 64 * (j))
#define XB_XGEN(j)  (2304 + 64 * (j))
#define XB_TOP      3328
#define XB_TOPGEN   3392
#define XCD_BAR_WORDS 3456
#define XB_SPIN_CAP (1u << 18)

__device__ __forceinline__ unsigned xb_ld(unsigned* p)              { return __hip_atomic_load(p, __ATOMIC_RELAXED, __HIP_MEMORY_SCOPE_AGENT); }
__device__ __forceinline__ unsigned xb_add(unsigned* p, unsigned v) { return __hip_atomic_fetch_add(p, v, __ATOMIC_RELAXED, __HIP_MEMORY_SCOPE_AGENT); }
__device__ __forceinline__ unsigned xb_xcc_id() { return (unsigned)__builtin_amdgcn_s_getreg((3 << 11) | 20) & 0xFu; }
#define XB_SPIN(cond, bar) do { unsigned _sp = 0; while (cond) { __builtin_amdgcn_s_sleep(1); \
    if ((++_sp & 255u) == 0u) { if (xb_ld(&(bar)[XB_TMO])) break; if (_sp > XB_SPIN_CAP) { atomicAdd(&(bar)[XB_TMO], 1u); break; } } } } while (0)

struct XcdBarrier {
    unsigned* bar; unsigned x;
    volatile LAS unsigned* st;
};

__device__ __forceinline__ XcdBarrier xcd_barrier_post(unsigned* bar, volatile LAS unsigned* st) {
    XcdBarrier b; b.bar = bar; b.x = xb_xcc_id(); b.st = st;
    if (threadIdx.x == 0) (void)xb_add(&bar[XB_XCNT(b.x)], 1u);
    return b;
}
__device__ __forceinline__ void xcd_barrier_complete(unsigned* bar, unsigned x, unsigned& nloc, unsigned& nx) {
    const unsigned G = gridDim.x * gridDim.y * gridDim.z;
    unsigned sum, cnt, mine, sp = 0u;
    for (;;) {
        sum = 0u; cnt = 0u; mine = 0u;
#pragma unroll
        for (unsigned j = 0; j < 16; ++j) { const unsigned c = xb_ld(&bar[XB_XCNT(j)]); sum += c; cnt += (c > 0u) ? 1u : 0u; mine = (j == x) ? c : mine; }
        if (sum == G) break;
        __builtin_amdgcn_s_sleep(1);
        if ((++sp & 255u) == 0u) { if (xb_ld(&bar[XB_TMO])) break; if (sp > XB_SPIN_CAP) { atomicAdd(&bar[XB_TMO], 1u); break; } }
    }
    nloc = mine > 0u ? mine : 1u; nx = cnt > 0u ? cnt : 1u;
}

__device__ __forceinline__ void xcd_barrier(const XcdBarrier& b) {
    asm volatile("s_waitcnt vmcnt(0)" ::: "memory");
    __syncthreads();
    if (threadIdx.x == 0) {
        unsigned* bar = b.bar;
        __builtin_amdgcn_s_waitcnt(0);
        unsigned nloc = b.st[0], nx = b.st[1];
        if (nloc == 0u) { xcd_barrier_complete(bar, b.x, nloc, nx); b.st[0] = nloc; b.st[1] = nx; }
        const unsigned old = xb_add(&bar[XB_XSUB(b.x)], 1u);
        const unsigned gen = old / nloc;
        if (old + 1u == (gen + 1u) * nloc) {
            __builtin_amdgcn_fence(__ATOMIC_RELEASE, "agent");
            asm volatile("s_waitcnt vmcnt(0)" ::: "memory");
            const unsigned og = xb_add(&bar[XB_TOP], 1u);
            const unsigned tg = og / nx;
            if (og + 1u == (tg + 1u) * nx) xb_add(&bar[XB_TOPGEN], 1u);
            else XB_SPIN(xb_ld(&bar[XB_TOPGEN]) == tg, bar);
            __builtin_amdgcn_fence(__ATOMIC_ACQUIRE, "agent");
            xb_add(&bar[XB_XGEN(b.x)], 1u);
            asm volatile("s_waitcnt vmcnt(0)" ::: "memory");
        } else {
            XB_SPIN(xb_ld(&bar[XB_XGEN(b.x)]) == gen, bar);
            __builtin_amdgcn_fence(__ATOMIC_ACQUIRE, "agent");
            asm volatile("s_waitcnt vmcnt(0)" ::: "memory");
        }
    }
    __syncthreads();
}

struct Args { const float* in[33]; float* out; unsigned char* ws; int ph_lo, ph_hi, li, dup; };
struct Frame {
    LAS unsigned char* lds;
    volatile LAS unsigned* MISC;
    gu32* ctl;
    int tid, lane, wave, bid, G;
};
enum { I_X = 0, I_WIN, I_LAMRE, I_LAMIM, I_LOGSTEP, I_BRE, I_BIM, I_CRE, I_CIM, I_SD, I_WGLU, I_BGLU, I_MU, I_W0, I_WUP, I_A0, I_AUP, I_GUP, I_KK, I_KA, I_RK, I_GNG, I_GNB,
       I_WOUT, I_LN1G, I_LN1B, I_WQ, I_KEYS1, I_KEYS2, I_PU, I_PV, I_LN2G, I_LN2B };

__device__ __forceinline__ void p0_transpose_item(const float* W, int K, int N, bf16* WT, int row_off, LAS float* scr, int item, int lane) {
    const int nblk = N / 32, kb = item / nblk, nb = item % nblk, k0 = 64 * kb, n0 = 32 * nb;
#pragma unroll 8
    for (int i = 0; i < 32; ++i) { const int kk = 2 * i + (lane >> 5); scr[kk * 33 + (lane & 31)] = W[(size_t)(k0 + kk) * N + n0 + (lane & 31)]; }
    LDS_WAIT(); asm volatile("" ::: "memory");
    const int c = lane & 7;
#pragma unroll
    for (int j = 0; j < 4; ++j) { const int n = (lane >> 3) + 8 * j; const LAS float* s = scr + (8 * c) * 33 + n;
        v4u o; o.x = pk2(s[0 * 33], s[1 * 33]); o.y = pk2(s[2 * 33], s[3 * 33]); o.z = pk2(s[4 * 33], s[5 * 33]); o.w = pk2(s[6 * 33], s[7 * 33]);
        *(GAS v4u*)(WT + (size_t)(row_off + n0 + n) * K + k0 + 8 * c) = o; }
    LDS_WAIT(); asm volatile("" ::: "memory");
}
__device__ __forceinline__ void cvt_stream(const float* src, bf16* dst, size_t n8, size_t gtid, size_t nt) {
    for (size_t i = gtid; i < n8; i += nt) { const f32x4 a = ((const f32x4*)src)[2 * i], b = ((const f32x4*)src)[2 * i + 1]; ((v4u*)dst)[i] = pack8(a, b); }
}

__device__ __forceinline__ void peer_tables(Frame& F, const Args& A, int gw, int NGW) {
    if (gw < 0) return;
    const int lane = F.lane;
    unsigned char* U8 = A.ws + WS_UTAB; unsigned char* V8 = A.ws + WS_VTAB; float* SU = (float*)(A.ws + WS_SU);
    for (int e = gw; e < 16384; e += NGW) {
        const f32x4* ur = (const f32x4*)(A.in[I_PU] + (size_t)e * D) + lane; const f32x4* vr = (const f32x4*)(A.in[I_PV] + (size_t)e * D) + lane; f32x4 x[8], y[8]; float am = 0.f;
#pragma unroll
        for (int i = 0; i < 8; ++i) { x[i] = ur[64 * i]; y[i] = vr[64 * i]; }
#pragma unroll
        for (int i = 0; i < 8; ++i) am = fmaxf(am, fmaxf(fmaxf(fabsf(x[i].x), fabsf(x[i].y)), fmaxf(fabsf(x[i].z), fabsf(x[i].w))));
#pragma unroll
        for (int o = 1; o < 64; o <<= 1) am = fmaxf(am, __shfl_xor(am, o));
        const float sc = (am > 0.f) ? am * (1.f / 127.f) : 1.f, inv = 1.f / sc;
        if (lane == 0) SU[e] = sc;
        unsigned* ud = (unsigned*)(U8 + (size_t)e * D) + lane; unsigned* vd = (unsigned*)(V8 + (size_t)e * D) + lane;
#pragma unroll
        for (int i = 0; i < 8; ++i) { const int a = (int)rintf(x[i].x * inv), b = (int)rintf(x[i].y * inv), c = (int)rintf(x[i].z * inv), d = (int)rintf(x[i].w * inv);
            ud[64 * i] = (unsigned)(a & 255) | ((unsigned)(b & 255) << 8) | ((unsigned)(c & 255) << 16) | ((unsigned)(d & 255) << 24);
            int w = 0; w = __builtin_amdgcn_cvt_pk_fp8_f32(y[i].x, y[i].y, w, false); w = __builtin_amdgcn_cvt_pk_fp8_f32(y[i].z, y[i].w, w, true); vd[64 * i] = (unsigned)w; }
    }
}

__device__ __forceinline__ void s5_params(Frame& F, const Args& A, int first_blk) {
    unsigned char* ws = A.ws;
    if (F.bid >= first_blk && F.bid < first_blk + 64) {
        const int g = F.bid - first_blk, tid = F.tid;
        LAS f32x2* AP = (LAS f32x2*)(F.lds);
        LAS f32x2* BB = (LAS f32x2*)(F.lds + 16896);
        LAS float* KJ = (LAS float*)(F.lds + 16896 + 8192);
        const float* lam_re = A.in[I_LAMRE] + g * 64; const float* lam_im = A.in[I_LAMIM] + g * 64;
        const float step = __expf(A.in[I_LOGSTEP][g]);
        for (int idx = tid; idx < 33 * 64; idx += 512) { const int j = idx >> 6, p = idx & 63; const float lr = lam_re[p], li = lam_im[p];
            const float mag = __expf(lr * step * (float)j); float rev = (li * step * 0.15915494309f) * (float)j; rev -= floorf(rev);
            AP[idx] = (f32x2){mag * __builtin_amdgcn_cosf(rev), mag * __builtin_amdgcn_sinf(rev)}; }
        LDS_WAIT(); __syncthreads();
        for (int idx = tid; idx < 64 * 16; idx += 512) { const int p = idx >> 4, h = idx & 15; const float lr = lam_re[p], li = lam_im[p]; const f32x2 a = AP[64 + p];
            const float den = lr * lr + li * li, fr = ((a.x - 1.f) * lr + a.y * li) / den, fi = (a.y * lr - (a.x - 1.f) * li) / den;
            const float br = A.in[I_BRE][(g * 64 + p) * 16 + h], bi = A.in[I_BIM][(g * 64 + p) * 16 + h];
            BB[idx] = (f32x2){fr * br - fi * bi, fr * bi + fi * br}; }
        if (tid < 64) { const f32x2 a = AP[32 * 64 + tid]; float* a32 = (float*)(ws + WS_A32); a32[(g * 64 + tid) * 2] = a.x; a32[(g * 64 + tid) * 2 + 1] = a.y; }
        LDS_WAIT(); __syncthreads();
        const float* cre = A.in[I_CRE] + (size_t)g * 16 * 64; const float* cim = A.in[I_CIM] + (size_t)g * 16 * 64;
        for (int idx = tid; idx < 32 * 256; idx += 512) { const int j = idx >> 8, h = (idx >> 4) & 15, hp = idx & 15; float s = 0.f;
            for (int p = 0; p < 64; ++p) { const f32x2 a = AP[j * 64 + p], bb = BB[p * 16 + hp]; const float wr = a.x * bb.x - a.y * bb.y, wi = a.x * bb.y + a.y * bb.x;
                s += cre[h * 64 + p] * wr - cim[h * 64 + p] * wi; }
            KJ[idx] = s; }
        LDS_WAIT(); __syncthreads();
        bf16* Gt = (bf16*)(ws + WS_G); bf16* MT = (bf16*)(ws + WS_MT);
        for (int it = tid; it < 8192; it += 512) { const int row = it >> 6, cb = (it & 63) * 8, s = cb >> 4, h0 = cb & 15, p = row & 63, im = row >> 6; const f32x2 a = AP[(31 - s) * 64 + p];
            float v[8];
#pragma unroll
            for (int e = 0; e < 8; ++e) { const f32x2 bb = BB[p * 16 + h0 + e]; v[e] = im ? (a.x * bb.y + a.y * bb.x) : (a.x * bb.x - a.y * bb.y); }
            v4u o; o.x = pk2(v[0], v[1]); o.y = pk2(v[2], v[3]); o.z = pk2(v[4], v[5]); o.w = pk2(v[6], v[7]);
            *(v4u*)(Gt + (size_t)(g * 128 + row) * 512 + cb) = o; }
        const float* dsk = A.in[I_SD] + g * 16;
        for (int it = tid; it < 40960; it += 512) { const int n = it / 80, kb = (it % 80) * 8, t = n >> 4, h = n & 15; float v[8];
            if (kb < 512) { const int s = kb >> 4, h0 = kb & 15;
#pragma unroll
                for (int e = 0; e < 8; ++e) { const int hp = h0 + e; float x = 0.f; if (s <= t) { x = KJ[(t - s) * 256 + h * 16 + hp]; if (s == t && hp == h) x += dsk[h]; } v[e] = x; } }
            else { const int p0 = (kb < 576) ? (kb - 512) : (kb - 576);
#pragma unroll
                for (int e = 0; e < 8; ++e) { const int p = p0 + e; const f32x2 a = AP[(t + 1) * 64 + p]; const float cr = cre[h * 64 + p], ci = cim[h * 64 + p];
                    v[e] = (kb < 576) ? (cr * a.x - ci * a.y) : -(cr * a.y + ci * a.x); } }
            v4u o; o.x = pk2(v[0], v[1]); o.y = pk2(v[2], v[3]); o.z = pk2(v[4], v[5]); o.w = pk2(v[6], v[7]);
            *(v4u*)(MT + (size_t)(g * 512 + n) * 640 + kb) = o; }
        LDS_WAIT(); __syncthreads();
    }
}

__device__ __forceinline__ void p0_prologue(Frame& F, const Args& A) {
    unsigned char* ws = A.ws;
    const size_t gtid = (size_t)F.bid * 512 + F.tid, NT = (size_t)F.G * 512;
    const int gw = F.bid * NWAVES + F.wave, NGW = F.G * NWAVES;
    cvt_stream(A.in[I_X], (bf16*)(ws + WS_XB), (size_t)M * D / 8, gtid, NT);
    {
        LAS float* scr = (LAS float*)(F.lds + RING_OFF + F.wave * 16384);
        constexpr int I_IN = (2048 / 64) * (INC / 32), I_GL = (1024 / 64) * (1024 / 32);
        for (int it = gw; it < I_IN + I_GL; it += NGW) { int r = it;
            if (r < I_IN) { p0_transpose_item(A.in[I_WIN], 2048, INC, (bf16*)(ws + WS_WIN), 0, scr, r, F.lane); continue; } r -= I_IN;
            p0_transpose_item(A.in[I_WGLU], 1024, 1024, (bf16*)(ws + WS_WGLU), 0, scr, r, F.lane); }
        v4u* z = (v4u*)((bf16*)(ws + WS_WIN) + (size_t)INC * 2048);
        for (size_t i = gtid; i < (size_t)(INP - INC) * 2048 / 8; i += NT) z[i] = (v4u){0u, 0u, 0u, 0u};
    }
    {
        bf16* WL = (bf16*)(ws + WS_WLORA);
        for (size_t i = gtid; i < (size_t)3072 * 384; i += NT) { const int n = (int)(i / 384), k = (int)(i % 384); float v = 0.f;
            if (n < 1024) { if (k < 64) v = A.in[I_WUP][k * 1024 + n]; }
            else if (n < 2048) { if (k >= 64 && k < 128) v = A.in[I_AUP][(k - 64) * 1024 + (n - 1024)]; }
            else { if (k >= 128 && k < 288) v = A.in[I_GUP][(k - 128) * 1024 + (n - 2048)]; }
            WL[i] = (bf16)f2bf(v); }
    }
}

__device__ __forceinline__ void wout_transpose(Frame& F, const Args& A, int gw, int NGW, LAS float* scr) {
    if (gw < 0) return;
    constexpr int I_OU = (2048 / 64) * (2048 / 32);
    for (int it = gw; it < I_OU; it += NGW) p0_transpose_item(A.in[I_WOUT], 2048, 2048, (bf16*)(A.ws + WS_WOUT), 0, scr, it, F.lane);
}
__device__ __forceinline__ void wqk_units(Frame& F, const Args& A, int rb, int nblk, int unit_lo, int unit_hi) {
    if (rb < 0) return;
    unsigned char* ws = A.ws;
    {
        LAS float* Ks = (LAS float*)(F.lds); LAS float* Ws = (LAS float*)(F.lds + 128 * 129 * 4);
        bf16* WQK = (bf16*)(ws + WS_WQK); const int tid = F.tid;
        for (int unit = unit_lo + rb; unit < unit_hi; unit += nblk) { const int hj = unit >> 5, dblk = unit & 31, h = hj >> 1, j = hj & 1;
            const float* keys = (j ? A.in[I_KEYS2] : A.in[I_KEYS1]) + (size_t)h * 128 * 128;
            for (int idx = tid; idx < 16384; idx += 512) Ks[(idx >> 7) * 129 + (idx & 127)] = keys[idx];
            for (int idx = tid; idx < 8192; idx += 512) Ws[(idx >> 7) * 129 + (idx & 127)] = A.in[I_WQ][(size_t)(dblk * 64 + (idx >> 7)) * 2048 + hj * 128 + (idx & 127)];
            LDS_WAIT(); __syncthreads();
            const int key = tid & 127, dq = tid >> 7; float acc[16];
#pragma unroll
            for (int i = 0; i < 16; ++i) acc[i] = 0.f;
            for (int c = 0; c < 128; ++c) { const float a = Ks[key * 129 + c];
#pragma unroll
                for (int i = 0; i < 16; ++i) acc[i] += a * Ws[(dq * 16 + i) * 129 + c]; }
            v4u o0, o1; o0.x = pk2(acc[0], acc[1]); o0.y = pk2(acc[2], acc[3]); o0.z = pk2(acc[4], acc[5]); o0.w = pk2(acc[6], acc[7]);
            o1.x = pk2(acc[8], acc[9]); o1.y = pk2(acc[10], acc[11]); o1.z = pk2(acc[12], acc[13]); o1.w = pk2(acc[14], acc[15]);
            v4u* dst = (v4u*)(WQK + (size_t)(hj * 128 + key) * 2048 + dblk * 64 + dq * 16); dst[0] = o0; dst[1] = o1;
            LDS_WAIT(); __syncthreads(); }
    }
}

__device__ __forceinline__ void r1_lora_in(Frame& F, const Args& A) {
    const bf16* PRW = (const bf16*)(A.ws + WS_PRW); bf16* AL = (bf16*)(A.ws + WS_ALORA); const float* mu = A.in[I_MU];
    const int gw = F.bid * NWAVES + F.wave, NGW = F.G * NWAVES;
    for (int m = gw; m < M; m += NGW) { const int t = m & (SEQ - 1);
#pragma unroll
        for (int q = 0; q < 6; ++q) { const int idx = q * 64 + F.lane; float val = 0.f;
            if (idx < 288) { const int col = 3072 + idx; const float cur = bf1(PRW[(size_t)m * 3584 + col]); const float prev = (t > 0) ? bf1(PRW[(size_t)(m - 1) * 3584 + col]) : 0.f;
                const float s = cur + mu[col] * (prev - cur);
                val = (idx < 64) ? (1.f - 2.f / (1.f + __expf(2.f * s))) : ((idx < 128) ? s : sigmoidf(s)); }
            AL[(size_t)m * 384 + idx] = (bf16)f2bf(val); } }
}

__device__ __forceinline__ void r3_prep(Frame& F, const Args& A) {
    const bf16* PRW = (const bf16*)(A.ws + WS_PRW); const bf16* LO = (const bf16*)(A.ws + WS_LORA); unsigned char* SC = A.ws + WS_SCAN;
    const float* mu = A.in[I_MU]; const int lane = F.lane, head = lane >> 2, j0 = (lane & 3) * 16, ch = lane * 16;
    const int gw = F.bid * NWAVES + F.wave, NGW = F.G * NWAVES;
    for (int m = gw; m < M; m += NGW) { const int t = m & (SEQ - 1), b = m >> 11;
        float rs[16], ks[16], vs[16];
#pragma unroll
        for (int part = 0; part < 3; ++part) { const int col = part * 1024 + ch; const v4u c0 = *(const v4u*)(PRW + (size_t)m * 3584 + col), c1 = *(const v4u*)(PRW + (size_t)m * 3584 + col + 8);
            v4u p0 = (v4u){0u, 0u, 0u, 0u}, p1 = p0; if (t > 0) { p0 = *(const v4u*)(PRW + (size_t)(m - 1) * 3584 + col); p1 = *(const v4u*)(PRW + (size_t)(m - 1) * 3584 + col + 8); }
            float cu[16], pr[16];
#pragma unroll
            for (int e = 0; e < 4; ++e) { cu[2 * e] = bflo(c0[e]); cu[2 * e + 1] = bfhi(c0[e]); cu[8 + 2 * e] = bflo(c1[e]); cu[8 + 2 * e + 1] = bfhi(c1[e]);
                pr[2 * e] = bflo(p0[e]); pr[2 * e + 1] = bfhi(p0[e]); pr[8 + 2 * e] = bflo(p1[e]); pr[8 + 2 * e + 1] = bfhi(p1[e]); }
#pragma unroll
            for (int e = 0; e < 16; ++e) { const float s = cu[e] + mu[col + e] * (pr[e] - cu[e]); if (part == 0) rs[e] = s; else if (part == 1) ks[e] = s; else vs[e] = s; } }
        const v4u wl0 = *(const v4u*)(LO + (size_t)m * 3072 + ch), wl1 = *(const v4u*)(LO + (size_t)m * 3072 + ch + 8);
        const v4u al0 = *(const v4u*)(LO + (size_t)m * 3072 + 1024 + ch), al1 = *(const v4u*)(LO + (size_t)m * 3072 + 1024 + ch + 8);
        float wl[16], al[16];
#pragma unroll
        for (int e = 0; e < 4; ++e) { wl[2 * e] = bflo(wl0[e]); wl[2 * e + 1] = bfhi(wl0[e]); wl[8 + 2 * e] = bflo(wl1[e]); wl[8 + 2 * e + 1] = bfhi(wl1[e]);
            al[2 * e] = bflo(al0[e]); al[2 * e + 1] = bfhi(al0[e]); al[8 + 2 * e] = bflo(al1[e]); al[8 + 2 * e + 1] = bfhi(al1[e]); }
        float dec[16], kp[16], kk[16], aa[16]; float n2 = 0.f;
#pragma unroll
        for (int e = 0; e < 16; ++e) { const float x = A.in[I_W0][ch + e] + wl[e]; const float y = -x; const float sp = fmaxf(y, 0.f) + __logf(1.f + __expf(-fabsf(y)));
            const float w = -sp - 0.5f; dec[e] = -__expf(w);
            const float a = sigmoidf(A.in[I_A0][ch + e] + al[e]); aa[e] = a;
            kk[e] = ks[e] * A.in[I_KK][ch + e]; n2 += kk[e] * kk[e];
            kp[e] = ks[e] * (1.f + (a - 1.f) * A.in[I_KA][ch + e]); }
        n2 += __shfl_xor(n2, 1); n2 += __shfl_xor(n2, 2);
        const float inv = 1.f / fmaxf(sqrtf(n2), 1e-12f);
        unsigned char* rec = SC + ((size_t)(b * 16 + head) * SEQ + t) * SCAN_REC;
        float kap[16], bet[16];
#pragma unroll
        for (int e = 0; e < 16; ++e) { kap[e] = kk[e] * inv; bet[e] = kap[e] * aa[e]; }
#define R3_ST(off, arr) do { v4u a_, b_; a_.x = pkh(arr[0], arr[1]); a_.y = pkh(arr[2], arr[3]); a_.z = pkh(arr[4], arr[5]); a_.w = pkh(arr[6], arr[7]); \
        b_.x = pkh(arr[8], arr[9]); b_.y = pkh(arr[10], arr[11]); b_.z = pkh(arr[12], arr[13]); b_.w = pkh(arr[14], arr[15]); *(v4u*)(rec + (off) + j0 * 2) = a_; *(v4u*)(rec + (off) + j0 * 2 + 16) = b_; } while (0)
        R3_ST(0, rs); R3_ST(128, kp); R3_ST(256, kap); R3_ST(384, bet); R3_ST(512, vs);
#undef R3_ST
#pragma unroll
        for (int q = 0; q < 4; ++q) *(f32x4*)(rec + 640 + (j0 + 4 * q) * 4) = (f32x4){dec[4 * q], dec[4 * q + 1], dec[4 * q + 2], dec[4 * q + 3]}; }
}

typedef short rwbf8 __attribute__((ext_vector_type(8)));
constexpr int RW_WLDS = 17408 + 14336, RL_RAW = 17408;
constexpr int RL_A1 = 0, RL_A43 = 1024, RL_QT = 0, RL_RT = 2304, RL_BK = 4608, RL_XV = 4608, RL_WJ = 4608, RL_A2 = 8704, RL_GM = 9216, RL_WI = 13312;
static_assert(4 * RW_WLDS <= LDSCTL_OFF && RL_WI + 4096 <= RL_RAW, "RWKV chunk LDS map");
__device__ __forceinline__ unsigned long long pk4bf(const f32x4 v) { return (unsigned long long)pk2(v[0], v[1]) | ((unsigned long long)pk2(v[2], v[3]) << 32); }
__device__ __forceinline__ f32x4 up4bf(unsigned long long w) { const unsigned lo = (unsigned)w, hi = (unsigned)(w >> 32); return (f32x4){bflo(lo), bfhi(lo), bflo(hi), bfhi(hi)}; }
__device__ __forceinline__ float pair_swap(float v) { return __builtin_bit_cast(float, __builtin_amdgcn_update_dpp(0, __builtin_bit_cast(int, v), 0xB1, 0xf, 0xf, false)); }
__device__ __forceinline__ void rw_chunk_pre(Frame& F, const Args& A) {
    const int lane = F.lane, c = lane & 15, q = lane >> 4; const bool odd = (lane & 1) != 0;
    LAS unsigned char* wl = F.lds + F.wave * RW_WLDS;
    const unsigned char* SC = A.ws + WS_SCAN; unsigned char* PHI = A.ws + WS_PHI; unsigned char* PSI = A.ws + WS_PSI; unsigned char* OM = A.ws + WS_OM; unsigned char* O0 = A.ws + WS_O0; float* G15 = (float*)(A.ws + WS_G15);
    if (F.wave >= 4) return;
    const int gw = F.bid * 4 + F.wave, NGW = F.G * 4;
    const f32x4 zero4 = (f32x4){0.f, 0.f, 0.f, 0.f}; const v4u z4 = (v4u){0u, 0u, 0u, 0u};
#define RW_STAGE(i_) do { const unsigned char* g_ = SC + (size_t)(i_) * 16 * SCAN_REC + lane * 16; _Pragma("unroll") for (int k_ = 0; k_ < 14; ++k_) \
        __builtin_amdgcn_global_load_lds((const unsigned*)(g_ + k_ * 1024), (LAS unsigned*)(wl + RL_RAW + k_ * 1024), 16, 0, 0); } while (0)
    if (gw < 64 * RW_NC) RW_STAGE(gw);
    for (int inst = gw; inst < 64 * RW_NC; inst += NGW) {
        asm volatile("s_waitcnt vmcnt(0)" ::: "memory");
        const LAS unsigned char* raw = wl + RL_RAW + (lane & ~1) * 2; const int hsel = (lane & 1) * 16;
        *(LAS v4u*)(wl + RL_WI + lane * 64 + 32) = z4; *(LAS v4u*)(wl + RL_WI + lane * 64 + 48) = z4;
        float Qt[16], Kt[16], Bt[16], vv[16]; float cum = 0.f;
#pragma unroll
        for (int t = 0; t < 16; ++t) { const LAS unsigned char* rec = raw + t * SCAN_REC;
#define RW_H(off) ((float)__builtin_bit_cast(_Float16, (unsigned short)(*(const LAS unsigned*)(rec + (off)) >> hsel)))
            const float r = RW_H(0), kp = RW_H(128), ka = RW_H(256), be = RW_H(384);
            vv[t] = RW_H(512); const float ld = *(const LAS float*)(wl + RL_RAW + t * SCAN_REC + 640 + lane * 4);
#undef RW_H
            const float gm1 = __expf(cum); cum += ld; const float g = __expf(cum), inv = __expf(-cum);
            Qt[t] = ka * gm1; const float Rt = r * g; Kt[t] = kp * inv; Bt[t] = be * inv;
            { const float qp = pair_swap(Qt[t]), rp = pair_swap(Rt), bp = pair_swap(Bt[t]), kq = pair_swap(Kt[t]); const int le = lane & ~1;
              *(LAS unsigned*)(wl + (odd ? RL_RT : RL_QT) + t * 144 + le * 2) = odd ? pk2(rp, Rt) : pk2(Qt[t], qp);
              *(LAS unsigned*)(wl + RL_BK + (odd ? 16 + t : t) * 144 + le * 2) = odd ? pk2(kq, Kt[t]) : pk2(Bt[t], bp); } }
        const float gl = __expf(cum); G15[(size_t)inst * 64 + lane] = gl;
        { v4u g0, g1, g2, g3, w0, w1;
#pragma unroll
          for (int e = 0; e < 4; ++e) { g0[e] = pk2(Kt[2 * e] * gl, Kt[2 * e + 1] * gl); g1[e] = pk2(Kt[8 + 2 * e] * gl, Kt[8 + 2 * e + 1] * gl);
              g2[e] = pk2(-Bt[2 * e] * gl, -Bt[2 * e + 1] * gl); g3[e] = pk2(-Bt[8 + 2 * e] * gl, -Bt[8 + 2 * e + 1] * gl); w0[e] = pk2(vv[2 * e], vv[2 * e + 1]); w1[e] = pk2(vv[8 + 2 * e], vv[8 + 2 * e + 1]); }
          LAS v4u* gp = (LAS v4u*)(wl + RL_GM + lane * 64); gp[0] = g0; gp[1] = g1; gp[2] = g2; gp[3] = g3;
          LAS v4u* wp = (LAS v4u*)(wl + RL_WI + lane * 64); wp[0] = w0; wp[1] = w1; }
        LDS_WAIT(); asm volatile("" ::: "memory");
        if (inst + NGW < 64 * RW_NC) RW_STAGE(inst + NGW);
        { f32x4 acc[2][2];
#pragma unroll
          for (int mi = 0; mi < 2; ++mi)
#pragma unroll
              for (int ni = 0; ni < 2; ++ni) acc[mi][ni] = zero4;
#pragma unroll
          for (int ks = 0; ks < 2; ++ks) { rwbf8 af[2], bfv[2];
#pragma unroll
              for (int mi = 0; mi < 2; ++mi) { af[mi] = *(const LAS rwbf8*)(wl + RL_QT + (16 * mi + c) * 144 + (32 * ks + 8 * q) * 2); bfv[mi] = *(const LAS rwbf8*)(wl + RL_BK + (16 * mi + c) * 144 + (32 * ks + 8 * q) * 2); }
#pragma unroll
              for (int mi = 0; mi < 2; ++mi)
#pragma unroll
                  for (int ni = 0; ni < 2; ++ni) acc[mi][ni] = __builtin_amdgcn_mfma_f32_16x16x32_bf16(af[mi], bfv[ni], acc[mi][ni], 0, 0, 0); }
          LDS_WAIT(); asm volatile("" ::: "memory");
#pragma unroll
          for (int r = 0; r < 4; ++r) { const int t = 4 * q + r;
              *(LAS float*)(wl + RL_A1 + (t * 16 + c) * 4) = (c < t) ? acc[0][0][r] : 0.f;
              const float a2 = (c < t) ? acc[0][1][r] : 0.f, a4 = (c <= t) ? acc[1][1][r] : 0.f, a3n = (c <= t) ? -acc[1][0][r] : 0.f;
              const float a2p = pair_swap(a2), a4p = pair_swap(a4), a3p = pair_swap(a3n); const int ce = c & ~1;
              if (!odd) { *(LAS unsigned*)(wl + RL_A2 + t * 32 + ce * 2) = pk2(a2, a2p); *(LAS unsigned*)(wl + RL_A43 + t * 64 + ce * 2) = pk2(a4, a4p); }
              else *(LAS unsigned*)(wl + RL_A43 + t * 64 + (16 + ce) * 2) = pk2(a3p, a3n); } }
        LDS_WAIT(); asm volatile("" ::: "memory");
        { const rwbf8 a2f = *(const LAS rwbf8*)(wl + RL_A2 + c * 32 + q * 16);
#pragma unroll
          for (int ni = 0; ni < 4; ++ni) { const rwbf8 bv = *(const LAS rwbf8*)(wl + RL_WI + (16 * ni + c) * 64 + q * 16); const f32x4 d = __builtin_amdgcn_mfma_f32_16x16x32_bf16(a2f, bv, zero4, 0, 0, 0);
#pragma unroll
              for (int r = 0; r < 4; ++r) *(LAS float*)(wl + RL_XV + ((4 * q + r) * 64 + 16 * ni + c) * 4) = d[r]; } }
        LDS_WAIT(); asm volatile("" ::: "memory");
        float y[16];
#pragma unroll
        for (int t = 0; t < 16; ++t) y[t] = *(const LAS float*)(wl + RL_XV + (t * 64 + lane) * 4);
#pragma unroll
        for (int t = 1; t < 16; ++t) {
#pragma unroll
            for (int s4 = 0; s4 <= (t - 1) / 4; ++s4) { const f32x4 a = *(const LAS f32x4*)(wl + RL_A1 + (t * 16 + 4 * s4) * 4);
#pragma unroll
                for (int e = 0; e < 4; ++e) if (4 * s4 + e < t) { Qt[t] -= a[e] * Qt[4 * s4 + e]; y[t] -= a[e] * y[4 * s4 + e]; } } }
        LDS_WAIT(); asm volatile("" ::: "memory");
        { v4u u0, u1, p0, p1;
#pragma unroll
          for (int e = 0; e < 4; ++e) { u0[e] = pk2(y[2 * e], y[2 * e + 1]); u1[e] = pk2(y[8 + 2 * e], y[8 + 2 * e + 1]); p0[e] = pk2(Qt[2 * e], Qt[2 * e + 1]); p1[e] = pk2(Qt[8 + 2 * e], Qt[8 + 2 * e + 1]); }
          LAS v4u* wp = (LAS v4u*)(wl + RL_WI + lane * 64); wp[2] = u0; wp[3] = u1;
          LAS v4u* jp = (LAS v4u*)(wl + RL_WJ + lane * 64); jp[0] = z4; jp[1] = z4; jp[2] = p0; jp[3] = p1; }
        LDS_WAIT(); asm volatile("" ::: "memory");
        { rwbf8 gmf[4], wif[4], wjf[4];
#pragma unroll
          for (int i = 0; i < 4; ++i) { gmf[i] = *(const LAS rwbf8*)(wl + RL_GM + (16 * i + c) * 64 + q * 16); wif[i] = *(const LAS rwbf8*)(wl + RL_WI + (16 * i + c) * 64 + q * 16); wjf[i] = *(const LAS rwbf8*)(wl + RL_WJ + (16 * i + c) * 64 + q * 16); }
          const rwbf8 a43f = *(const LAS rwbf8*)(wl + RL_A43 + c * 64 + q * 16);
#pragma unroll
          for (int mi = 0; mi < 4; ++mi)
#pragma unroll
              for (int ni = 0; ni < 4; ++ni) { const f32x4 d = __builtin_amdgcn_mfma_f32_16x16x32_bf16(gmf[mi], wif[ni], zero4, 0, 0, 0);
                  *(unsigned long long*)(PSI + ((size_t)inst * 16 + mi * 4 + ni) * 512 + lane * 8) = pk4bf(d); }
#pragma unroll
          for (int nj = 0; nj < 4; ++nj) { const int pos = (nj >> 1) * 32 + q * 8 + (nj & 1) * 4;
#pragma unroll
              for (int mj = 0; mj < 4; ++mj) { const f32x4 d = __builtin_amdgcn_mfma_f32_16x16x32_bf16(wjf[nj], gmf[mj], zero4, 0, 0, 0);
                  *(unsigned long long*)(PHI + (size_t)inst * 8192 + ((16 * mj + c) * 64 + pos) * 2) = pk4bf(d); } }
#pragma unroll
          for (int ni = 0; ni < 4; ++ni) { const f32x4 d = __builtin_amdgcn_mfma_f32_16x16x32_bf16(a43f, wif[ni], zero4, 0, 0, 0);
              *(unsigned long long*)(O0 + ((size_t)inst * 4 + ni) * 512 + lane * 8) = pk4bf(d); }
#pragma unroll
          for (int nj = 0; nj < 4; ++nj) { const int pos = (nj >> 1) * 32 + q * 8 + (nj & 1) * 4;
              f32x4 d = __builtin_amdgcn_mfma_f32_16x16x32_bf16(wjf[nj], a43f, zero4, 0, 0, 0);
              const f32x4 rr = up4bf(*(const LAS unsigned long long*)(wl + RL_RT + c * 144 + (16 * nj + 4 * q) * 2)); d = d + rr;
              *(unsigned long long*)(OM + (size_t)inst * 2048 + (c * 64 + pos) * 2) = pk4bf(d); } }
        LDS_WAIT(); asm volatile("" ::: "memory");
    }
#undef RW_STAGE
}
constexpr int RB_GS = 2, RB_NB = 5, RB_STEP = 13056, RB_PIECES = RB_STEP / 16, RB_BUF = RB_GS * RB_STEP, RB_NG = RW_NC / RB_GS;
static_assert(RB_NB * RB_BUF + 4096 <= LDSCTL_OFF, "recurrence LDS map");
__device__ __forceinline__ const unsigned char* rb_src(const unsigned char* ws, int inst, int w, int p) {
    if (p < 512) { const int L = p >> 6, l = p & 63, mi = L >> 1, ks = L & 1; return ws + WS_PHI + (size_t)inst * 8192 + ((16 * mi + (l & 15)) * 64 + ks * 32 + (l >> 4) * 8) * 2; }
    if (p < 640) { const int pp = p - 512; return ws + WS_PSI + ((size_t)inst * 16 + (pp >> 5) * 4 + w) * 512 + (pp & 31) * 16; }
    if (p < 768) { const int pp = p - 640, ks = pp >> 6, l = pp & 63; return ws + WS_OM + (size_t)inst * 2048 + ((l & 15) * 64 + ks * 32 + (l >> 4) * 8) * 2; }
    if (p < 800) return ws + WS_O0 + ((size_t)inst * 4 + w) * 512 + (p - 768) * 16;
    return ws + WS_G15 + (size_t)inst * 256 + (p - 800) * 16;
}
__device__ __forceinline__ void rw_recur(Frame& F, const Args& A) {
    if (F.bid >= 256) return;
    constexpr int XH_OFF = RB_NB * RB_BUF;
    const int bh = (F.bid & 7) * 8 + (F.bid >> 5), w = (F.bid >> 3) & 3, lane = F.lane, c = lane & 15, q = lane >> 4, tid = F.tid, mi = F.wave;
    float* O = (float*)(A.ws + WS_ORW) + (size_t)(bh >> 4) * SEQ * 1024 + (bh & 15) * 64 + 16 * w + c;
    f32x4 H = (f32x4){0.f, 0.f, 0.f, 0.f};
#define RB_DMA(grp) do { LAS unsigned char* db_ = F.lds + ((grp) % RB_NB) * RB_BUF; _Pragma("unroll") for (int k_ = 0; k_ < 7; ++k_) { const int ci_ = ((F.wave - 4) + 4 * k_) % 26, st_ = ci_ / 13, pc_ = ci_ % 13, p_ = pc_ * 64 + lane; \
        if (p_ < RB_PIECES) __builtin_amdgcn_global_load_lds((const unsigned*)rb_src(A.ws, bh * RW_NC + (grp) * RB_GS + st_, w, p_), (LAS unsigned*)(db_ + st_ * RB_STEP + pc_ * 1024), 16, 0, 0); } } while (0)
    for (int it = tid; it < RB_GS * RB_PIECES; it += NWAVES * 64) { const int st = it / RB_PIECES, p = it % RB_PIECES;
        *(LAS v4u*)(F.lds + st * RB_STEP + p * 16) = *(const v4u*)rb_src(A.ws, bh * RW_NC + st, w, p); }
    if (tid < 128) *(LAS v4u*)(F.lds + XH_OFF + tid * 16) = (v4u){0u, 0u, 0u, 0u};
    LDS_WAIT(); __syncthreads();
    if (F.wave >= 4) { RB_DMA(1); RB_DMA(2); }
    for (int g = 0; g < RB_NG; ++g) {
        if (F.wave >= 4 && g + 3 < RB_NG) RB_DMA(g + 3);
        const LAS unsigned char* gb = F.lds + (g % RB_NB) * RB_BUF;
#pragma unroll
        for (int st = 0; st < RB_GS; ++st) { const LAS unsigned char* sb = gb + st * RB_STEP; const int ch = g * RB_GS + st, par = ch & 1;
            if (F.wave < 4) {
                const rwbf8 hb0 = *(const LAS rwbf8*)(F.lds + XH_OFF + par * 2048 + lane * 16), hb1 = *(const LAS rwbf8*)(F.lds + XH_OFF + par * 2048 + 1024 + lane * 16);
                if (mi == 0) { f32x4 o = up4bf(*(const LAS unsigned long long*)(sb + 12288 + lane * 8));
                    o = __builtin_amdgcn_mfma_f32_16x16x32_bf16(*(const LAS rwbf8*)(sb + 10240 + lane * 16), hb0, o, 0, 0, 0);
                    o = __builtin_amdgcn_mfma_f32_16x16x32_bf16(*(const LAS rwbf8*)(sb + 10240 + 1024 + lane * 16), hb1, o, 0, 0, 0);
#pragma unroll
                    for (int r = 0; r < 4; ++r) O[(size_t)(ch * 16 + 4 * q + r) * 1024] = o[r]; }
                f32x4 hn = H * *(const LAS f32x4*)(sb + 12800 + (16 * mi + 4 * q) * 4) + up4bf(*(const LAS unsigned long long*)(sb + 8192 + mi * 512 + lane * 8));
                hn = __builtin_amdgcn_mfma_f32_16x16x32_bf16(*(const LAS rwbf8*)(sb + (mi * 2) * 1024 + lane * 16), hb0, hn, 0, 0, 0);
                hn = __builtin_amdgcn_mfma_f32_16x16x32_bf16(*(const LAS rwbf8*)(sb + (mi * 2 + 1) * 1024 + lane * 16), hb1, hn, 0, 0, 0); H = hn;
                *(LAS unsigned long long*)(F.lds + XH_OFF + (par ^ 1) * 2048 + (mi >> 1) * 1024 + lane * 16 + (mi & 1) * 8) = pk4bf(hn);
            } else if (st == RB_GS - 1) {
                if (g + 3 < RB_NG) asm volatile("s_waitcnt vmcnt(14)" ::: "memory"); else if (g + 2 < RB_NG) asm volatile("s_waitcnt vmcnt(7)" ::: "memory"); else asm volatile("s_waitcnt vmcnt(0)" ::: "memory"); }
            asm volatile("s_waitcnt lgkmcnt(0)" ::: "memory"); __builtin_amdgcn_s_barrier(); asm volatile("" ::: "memory");
        }
    }
#undef RB_DMA
    asm volatile("s_waitcnt vmcnt(0)" ::: "memory");
}

__device__ __forceinline__ void r5_post(Frame& F, const Args& A) {
    const float* ORW = (const float*)(A.ws + WS_ORW); const bf16* LO = (const bf16*)(A.ws + WS_LORA); const unsigned char* SC = A.ws + WS_SCAN; bf16* CAT = (bf16*)(A.ws + WS_CAT);
    const int lane = F.lane, head = lane >> 2, j0 = (lane & 3) * 16, ch = lane * 16;
    const int gw = F.bid * NWAVES + F.wave, NGW = F.G * NWAVES;
    for (int m = gw; m < M; m += NGW) { const int t = m & (SEQ - 1), b = m >> 11;
        float o[16];
#pragma unroll
        for (int q = 0; q < 4; ++q) { const f32x4 x = *(const f32x4*)(ORW + (size_t)m * 1024 + ch + 4 * q); o[4 * q] = x[0]; o[4 * q + 1] = x[1]; o[4 * q + 2] = x[2]; o[4 * q + 3] = x[3]; }
        float s = 0.f;
#pragma unroll
        for (int e = 0; e < 16; ++e) s += o[e];
        s += __shfl_xor(s, 1); s += __shfl_xor(s, 2); const float mean = s * (1.f / 64.f); float q2 = 0.f;
#pragma unroll
        for (int e = 0; e < 16; ++e) { const float d = o[e] - mean; q2 += d * d; }
        q2 += __shfl_xor(q2, 1); q2 += __shfl_xor(q2, 2); const float rstd = 1.f / sqrtf(q2 * (1.f / 64.f) + GN_EPS);
        const unsigned char* rec = SC + ((size_t)(b * 16 + head) * SEQ + t) * SCAN_REC; float dp = 0.f;
#pragma unroll
        for (int q = 0; q < 2; ++q) { const v4u rr = *(const v4u*)(rec + j0 * 2 + 16 * q), kq = *(const v4u*)(rec + 128 + j0 * 2 + 16 * q); const float* rkp = A.in[I_RK] + head * 64 + j0 + 8 * q;
#pragma unroll
            for (int e = 0; e < 4; ++e) dp += hlo(rr[e]) * hlo(kq[e]) * rkp[2 * e] + hhi(rr[e]) * hhi(kq[e]) * rkp[2 * e + 1]; }
        dp += __shfl_xor(dp, 1); dp += __shfl_xor(dp, 2);
        const v4u v0 = *(const v4u*)(rec + 512 + j0 * 2), v1 = *(const v4u*)(rec + 512 + j0 * 2 + 16);
        const v4u g0 = *(const v4u*)(LO + (size_t)m * 3072 + 2048 + ch), g1 = *(const v4u*)(LO + (size_t)m * 3072 + 2048 + ch + 8);
        float vv[16], gg[16];
#pragma unroll
        for (int e = 0; e < 4; ++e) { vv[2 * e] = hlo(v0[e]); vv[2 * e + 1] = hhi(v0[e]); vv[8 + 2 * e] = hlo(v1[e]); vv[8 + 2 * e + 1] = hhi(v1[e]);
            gg[2 * e] = bflo(g0[e]); gg[2 * e + 1] = bfhi(g0[e]); gg[8 + 2 * e] = bflo(g1[e]); gg[8 + 2 * e + 1] = bfhi(g1[e]); }
        float r[16];
#pragma unroll
        for (int e = 0; e < 16; ++e) r[e] = ((o[e] - mean) * rstd * A.in[I_GNG][ch + e] + A.in[I_GNB][ch + e] + dp * vv[e]) * gg[e];
        v4u w0, w1; w0.x = pk2(r[0], r[1]); w0.y = pk2(r[2], r[3]); w0.z = pk2(r[4], r[5]); w0.w = pk2(r[6], r[7]); w1.x = pk2(r[8], r[9]); w1.y = pk2(r[10], r[11]); w1.z = pk2(r[12], r[13]); w1.w = pk2(r[14], r[15]);
        *(v4u*)(CAT + (size_t)m * 2048 + 1024 + ch) = w0; *(v4u*)(CAT + (size_t)m * 2048 + 1024 + ch + 8) = w1; }
}

__device__ __forceinline__ void ln1_rows(Frame& F, const Args& A) {
    const float* Z = (const float*)(A.ws + WS_Z); float* H1 = (float*)(A.ws + WS_H1); bf16* H1B = (bf16*)(A.ws + WS_H1B);
    const int gw = F.bid * NWAVES + F.wave, NGW = F.G * NWAVES, lane = F.lane;
    for (int m = gw; m < M; m += NGW) { const f32x4* zr = (const f32x4*)(Z + (size_t)m * D) + lane; f32x4 v[8]; float s = 0.f;
#pragma unroll
        for (int j = 0; j < 8; ++j) { v[j] = zr[64 * j]; s += (v[j].x + v[j].y) + (v[j].z + v[j].w); }
        const float mean = wave_sum(s) * (1.f / D); float s2 = 0.f;
#pragma unroll
        for (int j = 0; j < 8; ++j) { v[j] = v[j] - mean; s2 += (v[j].x * v[j].x + v[j].y * v[j].y) + (v[j].z * v[j].z + v[j].w * v[j].w); }
        const float rstd = 1.f / sqrtf(wave_sum(s2) * (1.f / D) + LN_EPS);
#pragma unroll
        for (int j = 0; j < 8; ++j) { const f32x4 g = ((const f32x4*)A.in[I_LN1G])[64 * j + lane], bb = ((const f32x4*)A.in[I_LN1B])[64 * j + lane]; const f32x4 y = v[j] * rstd * g + bb;
            ((f32x4*)(H1 + (size_t)m * D))[64 * j + lane] = y;
            unsigned long long pk = (unsigned long long)pk2(y.x, y.y) | ((unsigned long long)pk2(y.z, y.w) << 32); ((unsigned long long*)(H1B + (size_t)m * D))[64 * j + lane] = pk; } }
}

__device__ __forceinline__ void ins16(float (&tv)[16], float x) {
#pragma unroll
    for (int k = 15; k >= 1; --k) tv[k] = __builtin_amdgcn_fmed3f(tv[k - 1], tv[k], x);
    tv[0] = fmaxf(tv[0], x);
}
__device__ __forceinline__ void topk_phase(Frame& F, const Args& A) {
    const float* SCp = (const float*)(A.ws + WS_SC); int* IDX = (int*)(A.ws + WS_IDX); float* GATE = (float*)(A.ws + WS_GATE);
    LAS float* scr = (LAS float*)(F.lds + F.wave * 8448); LAS unsigned* scu = (LAS unsigned*)scr;
    const int gw = F.bid * NWAVES + F.wave, NGW = F.G * NWAVES, lane = F.lane;
    for (int grp = gw; grp < M / 4; grp += NGW) { const float* base = SCp + (size_t)grp * 4 * 2048;
        float tv[16];
#pragma unroll
        for (int k = 0; k < 16; ++k) tv[k] = -INFINITY;
        for (int q = 0; q < 4; ++q) {
#pragma unroll
            for (int k = 0; k < 8; ++k) { const int rowl = k * 8 + (lane >> 3), c4 = (lane & 7) * 4; const f32x4 x = *(const f32x4*)(base + rowl * 128 + q * 32 + c4);
                scr[rowl * 33 + c4] = x[0]; scr[rowl * 33 + c4 + 1] = x[1]; scr[rowl * 33 + c4 + 2] = x[2]; scr[rowl * 33 + c4 + 3] = x[3]; }
            LDS_WAIT(); asm volatile("" ::: "memory");
#pragma unroll
            for (int i = 0; i < 32; ++i) { const unsigned key = (scu[lane * 33 + i] & ~127u) | (unsigned)(q * 32 + i); ins16(tv, __uint_as_float(key)); }
            LDS_WAIT(); asm volatile("" ::: "memory");
        }
        const int jb = lane & 1; float Av[16], Bv[16];
#pragma unroll
        for (int k = 0; k < 16; ++k) { const float ot = __shfl_xor(tv[k], 1); Av[k] = jb ? ot : tv[k]; Bv[k] = jb ? tv[k] : ot; }
#pragma unroll
        for (int k = 0; k < 16; ++k) { scu[lane * 33 + k] = __float_as_uint(Av[k]) & 127u; scu[lane * 33 + 16 + k] = __float_as_uint(Bv[k]) & 127u; }
        float tw[16];
#pragma unroll
        for (int k = 0; k < 16; ++k) tw[k] = -INFINITY;
#define CROW(i, n) _Pragma("unroll") for (int jj = 0; jj < (n); ++jj) { const float c = Av[i] + Bv[jj]; ins16(tw, __uint_as_float((__float_as_uint(c) & ~255u) | (unsigned)((i) * 16 + jj))); }
        CROW(0, 16) CROW(1, 8) CROW(2, 5) CROW(3, 4) CROW(4, 3) CROW(5, 2) CROW(6, 2) CROW(7, 2) CROW(8, 1) CROW(9, 1) CROW(10, 1) CROW(11, 1) CROW(12, 1) CROW(13, 1) CROW(14, 1) CROW(15, 1)
#undef CROW
        LDS_WAIT(); asm volatile("" ::: "memory");
        float ex[16]; float sum = 0.f;
#pragma unroll
        for (int k = 0; k < 16; ++k) { ex[k] = __expf(tw[k] - tw[0]); sum += ex[k]; }
        const float rs = 1.f / sum; int eid[16];
#pragma unroll
        for (int k = 0; k < 16; ++k) { const unsigned pos = __float_as_uint(tw[k]) & 255u; const unsigned ia = scu[lane * 33 + (pos >> 4)], ib = scu[lane * 33 + 16 + (pos & 15u)]; eid[k] = (int)(ia * 128u + ib); }
        const int token = grp * 4 + (lane >> 4), head = (lane >> 1) & 7; const size_t ob = (size_t)token * 128 + head * 16;
        if (jb == 0) {
#pragma unroll
            for (int k = 0; k < 16; k += 4) { *(int4*)(IDX + ob + k) = make_int4(eid[k], eid[k + 1], eid[k + 2], eid[k + 3]); *(f32x4*)(GATE + ob + k) = (f32x4){ex[k] * rs, ex[k + 1] * rs, ex[k + 2] * rs, ex[k + 3] * rs}; } }
        LDS_WAIT(); asm volatile("" ::: "memory");
    }
}

constexpr int PNT = 4, PNP = PNT * 128, PR = 3, PNPAD = PNP + 4, PEER_WAVE_LDS = 17408;
static_assert(NWAVES * PEER_WAVE_LDS <= LDSCTL_OFF && PR * 4096 + PNPAD * 8 + 512 <= PEER_WAVE_LDS, "PEER LDS map");
__device__ __forceinline__ int dpp_i(int v, const int sel) {
    switch (sel) { case 0: return __builtin_amdgcn_update_dpp(0, v, 0x111, 0xf, 0xf, true);
                   case 1: return __builtin_amdgcn_update_dpp(0, v, 0x112, 0xf, 0xf, true);
                   case 2: return __builtin_amdgcn_update_dpp(0, v, 0x114, 0xf, 0xf, true);
                   case 3: return __builtin_amdgcn_update_dpp(0, v, 0x118, 0xf, 0xf, true);
                   case 4: return __builtin_amdgcn_update_dpp(0, v, 0x142, 0xa, 0xf, false);
                   default: return __builtin_amdgcn_update_dpp(0, v, 0x143, 0xc, 0xf, false); }
}
__device__ __forceinline__ int wave_total_i32(int v) {
    v += dpp_i(v, 0); v += dpp_i(v, 1); v += dpp_i(v, 2); v += dpp_i(v, 3); v += dpp_i(v, 4); v += dpp_i(v, 5);
    return __builtin_amdgcn_readlane(v, 63);
}
template <bool DUMMY> __device__ __forceinline__ void peer_phase(Frame& F, const Args& A) {
    const float* H1 = (const float*)(A.ws + WS_H1); const unsigned char* U8 = A.ws + WS_UTAB; const unsigned char* V8 = A.ws + WS_VTAB; const float* SU = (const float*)(A.ws + WS_SU);
    const int* IDX = (const int*)(A.ws + WS_IDX); const float* GATE = (const float*)(A.ws + WS_GATE);
    const int gw = F.bid * NWAVES + F.wave, NGW = F.G * NWAVES;
    LAS unsigned char* wl = F.lds + F.wave * PEER_WAVE_LDS;
    LAS unsigned char* ring = wl;
    LAS unsigned* list = (LAS unsigned*)(wl + PR * 4096);
    LAS unsigned* cnt = (LAS unsigned*)(wl + PR * 4096 + PNPAD * 8);
    for (int grp = gw; grp < M / PNT; grp += NGW) { const int tok0 = grp * PNT; int lane = (int)__builtin_amdgcn_mbcnt_hi(~0u, __builtin_amdgcn_mbcnt_lo(~0u, 0u)); asm volatile("" : "+v"(lane));
        cnt[lane] = 0u; cnt[64 + lane] = 0u;
        int ev[2 * PNT]; float gv[2 * PNT], sv[2 * PNT];
#pragma unroll
        for (int q = 0; q < 2 * PNT; ++q) { ev[q] = IDX[(size_t)(tok0 + (q >> 1)) * 128 + (q & 1) * 64 + lane]; gv[q] = GATE[(size_t)(tok0 + (q >> 1)) * 128 + (q & 1) * 64 + lane]; }
#pragma unroll
        for (int q = 0; q < 2 * PNT; ++q) sv[q] = SU[ev[q]];
        LDS_WAIT(); asm volatile("" ::: "memory");
#pragma unroll
        for (int q = 0; q < 2 * PNT; ++q) __hip_atomic_fetch_add(cnt + (ev[q] >> 7), 1u, __ATOMIC_RELAXED, __HIP_MEMORY_SCOPE_WORKGROUP);
        LDS_WAIT(); asm volatile("" ::: "memory");
        { const unsigned a = cnt[2 * lane], b = cnt[2 * lane + 1]; int inc = (int)(a + b);
          inc += dpp_i(inc, 0); inc += dpp_i(inc, 1); inc += dpp_i(inc, 2); inc += dpp_i(inc, 3); inc += dpp_i(inc, 4); inc += dpp_i(inc, 5);
          const unsigned ex = (unsigned)inc - (a + b); cnt[2 * lane] = ex; cnt[2 * lane + 1] = ex + a; }
        LDS_WAIT(); asm volatile("" ::: "memory");
#pragma unroll
        for (int q = 0; q < 2 * PNT; ++q) { const unsigned pos = __hip_atomic_fetch_add(cnt + (ev[q] >> 7), 1u, __ATOMIC_RELAXED, __HIP_MEMORY_SCOPE_WORKGROUP);
            const unsigned short gh = __builtin_bit_cast(unsigned short, (_Float16)gv[q]);
            list[2 * pos] = (unsigned)ev[q] | ((unsigned)(q >> 1) << 14) | ((unsigned)gh << 16); list[2 * pos + 1] = __float_as_uint(sv[q]); }
        if (lane < PNPAD - PNP) { unsigned z_ = 0u; asm volatile("" : "+v"(z_)); list[2 * (PNP + lane)] = z_; list[2 * (PNP + lane) + 1] = z_; }
        LDS_WAIT(); asm volatile("" ::: "memory");
        unsigned xq[PNT][8]; float sx[PNT];
#pragma unroll
        for (int k = 0; k < PNT; ++k) { const float* hr = H1 + (size_t)(tok0 + k) * D + lane * 16; f32x4 x[8]; float am = 0.f;
#pragma unroll
            for (int i = 0; i < 8; ++i) { x[i] = *(const f32x4*)(hr + (i >> 2) * 1024 + (i & 3) * 4); am = fmaxf(am, fmaxf(fmaxf(fabsf(x[i].x), fabsf(x[i].y)), fmaxf(fabsf(x[i].z), fabsf(x[i].w)))); }
#pragma unroll
            for (int o = 1; o < 64; o <<= 1) am = fmaxf(am, __shfl_xor(am, o));
            const float sc = (am > 0.f) ? am * (1.f / 127.f) : 1.f, inv = 1.f / sc; sx[k] = __builtin_bit_cast(float, __builtin_amdgcn_readfirstlane(__builtin_bit_cast(int, sc)));
#pragma unroll
            for (int i = 0; i < 8; ++i) { const int a = (int)rintf(x[i].x * inv), b = (int)rintf(x[i].y * inv), c = (int)rintf(x[i].z * inv), d = (int)rintf(x[i].w * inv);
                xq[k][i] = (unsigned)(a & 255) | ((unsigned)(b & 255) << 8) | ((unsigned)(c & 255) << 16) | ((unsigned)(d & 255) << 24); }
            asm volatile("" ::: "memory"); }
        float acc[PNT][32];
#pragma unroll
        for (int k = 0; k < PNT; ++k)
#pragma unroll
            for (int i = 0; i < 32; ++i) acc[k][i] = 0.f;
#define PEER_ISSUE(n) do { const unsigned e_ = (unsigned)__builtin_amdgcn_readfirstlane((int)list[2 * (n)]) & (DUMMY ? 0xffu : 0x3fffu); LAS unsigned char* sl_ = ring + ((n) % PR) * 4096; \
        const unsigned char* up_ = U8 + (size_t)e_ * D + lane * 16; const unsigned char* vp_ = V8 + (size_t)e_ * D + lane * 16; \
        __builtin_amdgcn_global_load_lds((const unsigned*)up_, (LAS unsigned*)sl_, 16, 0, 0); __builtin_amdgcn_global_load_lds((const unsigned*)(up_ + 1024), (LAS unsigned*)(sl_ + 1024), 16, 0, 0); \
        __builtin_amdgcn_global_load_lds((const unsigned*)vp_, (LAS unsigned*)(sl_ + 2048), 16, 0, 0); __builtin_amdgcn_global_load_lds((const unsigned*)(vp_ + 1024), (LAS unsigned*)(sl_ + 3072), 16, 0, 0); } while (0)
#define PEER_CORE(k) do { int d_ = 0; \
        d_ = __builtin_amdgcn_sdot4((int)u0.x, (int)xq[k][0], d_, false); d_ = __builtin_amdgcn_sdot4((int)u0.y, (int)xq[k][1], d_, false); d_ = __builtin_amdgcn_sdot4((int)u0.z, (int)xq[k][2], d_, false); d_ = __builtin_amdgcn_sdot4((int)u0.w, (int)xq[k][3], d_, false); \
        d_ = __builtin_amdgcn_sdot4((int)u1.x, (int)xq[k][4], d_, false); d_ = __builtin_amdgcn_sdot4((int)u1.y, (int)xq[k][5], d_, false); d_ = __builtin_amdgcn_sdot4((int)u1.z, (int)xq[k][6], d_, false); d_ = __builtin_amdgcn_sdot4((int)u1.w, (int)xq[k][7], d_, false); \
        d_ = wave_total_i32(d_); const float z_ = (float)d_ * su * sx[k]; const float s_ = gate * gelu_tanh(z_); \
        v4u v0 = *(const LAS v4u*)(sl + 2048 + lane * 16), v1 = *(const LAS v4u*)(sl + 3072 + lane * 16); asm volatile("s_waitcnt lgkmcnt(0)" : "+v"(v0), "+v"(v1) :: "memory");     \
        _Pragma("unroll") for (int i = 0; i < 4; ++i) { const f32x2 a_ = __builtin_amdgcn_cvt_pk_f32_fp8((int)v0[i], false), b_ = __builtin_amdgcn_cvt_pk_f32_fp8((int)v0[i], true); \
            acc[k][4 * i] += s_ * a_.x; acc[k][4 * i + 1] += s_ * a_.y; acc[k][4 * i + 2] += s_ * b_.x; acc[k][4 * i + 3] += s_ * b_.y; } \
        _Pragma("unroll") for (int i = 0; i < 4; ++i) { const f32x2 a_ = __builtin_amdgcn_cvt_pk_f32_fp8((int)v1[i], false), b_ = __builtin_amdgcn_cvt_pk_f32_fp8((int)v1[i], true); \
            acc[k][16 + 4 * i] += s_ * a_.x; acc[k][16 + 4 * i + 1] += s_ * a_.y; acc[k][16 + 4 * i + 2] += s_ * b_.x; acc[k][16 + 4 * i + 3] += s_ * b_.y; } } while (0)
        PEER_ISSUE(0); PEER_ISSUE(1);
        for (int n = 0; n < PNP; ++n) {
            asm volatile("s_waitcnt vmcnt(4)" ::: "memory");
            const LAS unsigned char* sl = ring + (n % PR) * 4096;
            const v4u u0 = *(const LAS v4u*)(sl + lane * 16), u1 = *(const LAS v4u*)(sl + 1024 + lane * 16);
            const unsigned ent = (unsigned)__builtin_amdgcn_readfirstlane((int)list[2 * n]); const float su = __builtin_bit_cast(float, __builtin_amdgcn_readfirstlane((int)list[2 * n + 1]));
            const int tk = (int)((ent >> 14) & 3u); const float gate = (float)__builtin_bit_cast(_Float16, (unsigned short)(ent >> 16));
            if (tk == 0) PEER_CORE(0); else if (tk == 1) PEER_CORE(1); else if (tk == 2) PEER_CORE(2); else PEER_CORE(3);
            PEER_ISSUE(n + 2);
        }
        asm volatile("s_waitcnt vmcnt(0)" ::: "memory");
#undef PEER_ISSUE
#undef PEER_CORE
        asm volatile("" : "+v"(lane));
#pragma unroll
        for (int k = 0; k < PNT; ++k) { const size_t ro = (size_t)(tok0 + k) * D + lane * 16; float y[32]; float s1 = 0.f;
#pragma unroll
            for (int i = 0; i < 8; ++i) { const f32x4 h = *(const f32x4*)(H1 + ro + (i >> 2) * 1024 + (i & 3) * 4);
#pragma unroll
                for (int c = 0; c < 4; ++c) { y[4 * i + c] = ALPHA * h[c] + acc[k][4 * i + c]; s1 += y[4 * i + c]; } }
            const float mean = wave_sum(s1) * (1.f / D); float s2 = 0.f;
#pragma unroll
            for (int i = 0; i < 32; ++i) { y[i] -= mean; s2 += y[i] * y[i]; }
            const float rstd = 1.f / sqrtf(wave_sum(s2) * (1.f / D) + LN_EPS);
#pragma unroll
            for (int i = 0; i < 8; ++i) { const int co = lane * 16 + (i >> 2) * 1024 + (i & 3) * 4; const f32x4 g = *(const f32x4*)(A.in[I_LN2G] + co), bb = *(const f32x4*)(A.in[I_LN2B] + co); f32x4 r;
#pragma unroll
                for (int c = 0; c < 4; ++c) r[c] = y[4 * i + c] * rstd * g[c] + bb[c];
                if (!DUMMY) *(f32x4*)(A.out + (size_t)(tok0 + k) * D + co) = r; else asm volatile("" :: "v"(r)); }
            asm volatile("" ::: "memory"); }
        asm volatile("s_waitcnt vmcnt(0) lgkmcnt(0)" ::: "memory");
    }
}

__global__ void __launch_bounds__(NWAVES * 64, 2) fwd_kernel(Args args) {
    extern __shared__ __attribute__((aligned(16))) unsigned char lds[];
    Frame F;
    F.lds = (LAS unsigned char*)lds;
    F.MISC = (volatile LAS unsigned*)(F.lds + MISC_OFF);
    F.tid = threadIdx.x; F.lane = F.tid & 63; F.wave = __builtin_amdgcn_readfirstlane(F.tid >> 6);
    F.G = gridDim.x; F.bid = blockIdx.x;
    unsigned char* ws = args.ws;
    F.ctl = (gu32*)(ws + WS_CTL);
    for (int u = F.tid; u < (LDS_BYTES - LDSCTL_OFF) / 4; u += NWAVES * 64) ((LAS unsigned*)(F.lds + LDSCTL_OFF))[u] = 0u;
    __syncthreads();
    XcdBarrier bar; bar.bar = (unsigned*)(F.ctl + CW_BAR); bar.x = 0; bar.st = nullptr;
    if (!MK_PER_PHASE) bar = xcd_barrier_post((unsigned*)(F.ctl + CW_BAR), F.MISC + 8);
    const int lo = args.ph_lo, hi = args.ph_hi;
#ifndef PHMASK
#define PHMASK 0xFFFF
#endif
#define IN(k) (((PHMASK >> (k)) & 1) && lo <= (k) && (k) < hi)
#define SEAM(k) do { if (IN(k) && IN((k) + 1)) xcd_barrier(bar); } while (0)
#define REP(k) for (int rep_ = 0; rep_ < ((PROBE_DUP == (k)) ? 2 : 1); ++rep_, ((PROBE_DUP == (k) && rep_ == 1) ? xcd_barrier(bar) : (void)0))
    typedef pg8::bf16_t pb;
    pb* XB = (pb*)(ws + WS_XB); pb* WIN = (pb*)(ws + WS_WIN); pb* U = (pb*)(ws + WS_U); pb* Gt = (pb*)(ws + WS_G); pb* MT = (pb*)(ws + WS_MT);
    pb* PRW = (pb*)(ws + WS_PRW); pb* YS = (pb*)(ws + WS_YS); pb* CAT = (pb*)(ws + WS_CAT); pb* AL = (pb*)(ws + WS_ALORA); pb* LO = (pb*)(ws + WS_LORA);
    pb* WGLU = (pb*)(ws + WS_WGLU); pb* WOUT = (pb*)(ws + WS_WOUT); pb* WQK = (pb*)(ws + WS_WQK); pb* WL = (pb*)(ws + WS_WLORA); pb* H1B = (pb*)(ws + WS_H1B);

    if (IN(0)) REP(0) { p0_prologue(F, args); } SEAM(0);
    if (IN(1)) REP(1) {
        pg8::Gemm g{XB, WIN, 2048, 2048, 2048}; pg8::StaticOrder S; S.init(M, INP, F.G, F.bid); pg8::EpiProj E{U, PRW};
        pg8::gemm_phase<pg8::EpiProj, pg8::StaticOrder, true, true>(F.lds + RING_OFF, g, S, E);
        s5_params(F, args, 64); wqk_units(F, args, F.bid >= 128 ? F.bid - 128 : -1, F.G - 128, 0, 256); } SEAM(1);
    if (IN(2)) REP(2) {
        pg8::Gemm g{U, Gt, 512, 640, 512}; pg8::OneUnit S{F.bid < 64 ? F.bid : -1, F.bid >> 1}; pg8::EpiSa E{U, (const float*)(ws + WS_A32)};
        pg8::gemm_phase<pg8::EpiSa, pg8::OneUnit, false, true>(F.lds + RING_OFF, g, S, E);
        r1_lora_in(F, args); wqk_units(F, args, F.bid >= 64 ? F.bid - 64 : -1, F.G - 64, 256, 512); } SEAM(2);
    if (IN(3)) REP(3) {
        { pg8::Gemm g{U, MT, 640, 640, 640}; pg8::OneUnit S{F.bid < 128 ? (F.bid >> 1) : -1, F.bid}; pg8::EpiY E{YS};
          pg8::gemm_phase<pg8::EpiY, pg8::OneUnit, false, true>(F.lds + RING_OFF, g, S, E); }
        { pg8::Gemm g{AL, WL, 384, 384, 384}; pg8::ListOrder S{F.bid < 128 ? 256 + F.bid : F.bid - 128, F.bid < 128 ? -1 : F.bid, 32}; pg8::EpiStoreBf16 E{LO, 3072};
          pg8::gemm_phase<pg8::EpiStoreBf16, pg8::ListOrder, true, true>(F.lds + RING_OFF, g, S, E); } } SEAM(3);
    if (IN(4)) REP(4) {
        { const int L = F.bid - 128; pg8::Gemm g{YS, WGLU, 1024, 1024, 1024}; pg8::OneUnit S{L >= 0 ? (L & 31) : -1, L >> 5}; pg8::EpiGLU E{YS, args.in[I_BGLU], CAT};
          pg8::gemm_phase<pg8::EpiGLU, pg8::OneUnit, false, true>(F.lds + RING_OFF, g, S, E); }
        wout_transpose(F, args, F.bid * NWAVES + F.wave, F.G * NWAVES, (LAS float*)(F.lds + F.wave * 16384)); r3_prep(F, args); } SEAM(4);
    if (IN(5)) REP(5) {
        if (F.wave < 4) rw_chunk_pre(F, args);
        else { const int g4 = F.bid * 4 + F.wave - 4, n4 = F.G * 4; peer_tables(F, args, g4, n4); }
        xcd_barrier(bar);
        rw_recur(F, args);
        if (PROBE_DUP == 51) { xcd_barrier(bar); rw_recur(F, args); }
        if (PROBE_DUP == 52) { xcd_barrier(bar); if (F.wave < 4) rw_chunk_pre(F, args); } } SEAM(5);
    if (IN(6)) REP(6) { r5_post(F, args); } SEAM(6);
    if (IN(7)) REP(7) {
        pg8::Gemm g{CAT, WOUT, 2048, 2048, 2048}; pg8::StaticOrder S; S.init(M, D, F.G, F.bid); pg8::EpiF32 E{(float*)(ws + WS_Z), args.in[I_X], D, ALPHA};
        pg8::gemm_phase<pg8::EpiF32, pg8::StaticOrder, true, true>(F.lds + RING_OFF, g, S, E); } SEAM(7);
    if (IN(8)) REP(8) { ln1_rows(F, args); } SEAM(8);
    if (IN(9)) REP(9) {
        pg8::Gemm g{H1B, WQK, 2048, 2048, 2048}; pg8::StaticOrder S; S.init(M, D, F.G, F.bid); pg8::EpiF32 E{(float*)(ws + WS_SC), nullptr, D, 0.f};
        pg8::gemm_phase<pg8::EpiF32, pg8::StaticOrder, true, true>(F.lds + RING_OFF, g, S, E); } SEAM(9);
    if (IN(10)) REP(10) { topk_phase(F, args); } SEAM(10);
    if (IN(11)) REP(11) { peer_phase<false>(F, args); }
#undef IN
#undef SEAM
}

extern "C" void kernel_launch(void* const* d_in, const int* in_sizes, int n_in, void* d_out, int out_size, void* d_ws, size_t ws_size, hipStream_t stream) {
    static int grid = 0;
    if (grid == 0) {
        if (n_in != 33 || in_sizes[0] != M * D || out_size != M * D || ws_size < WS_END) { fprintf(stderr, "kernel_launch: unexpected shapes (n_in %d, in0 %d, out %d, ws %zu)\n", n_in, n_in > 0 ? in_sizes[0] : -1, out_size, ws_size); grid = -1; return; }
        int dev = 0, cus = 0, per_cu = 0;
        if (hipGetDevice(&dev) != hipSuccess || hipDeviceGetAttribute(&cus, hipDeviceAttributeMultiprocessorCount, dev) != hipSuccess) { grid = -1; return; }
        if (hipFuncSetAttribute((const void*)fwd_kernel, hipFuncAttributeMaxDynamicSharedMemorySize, LDS_BYTES) != hipSuccess) { fprintf(stderr, "kernel_launch: hipFuncSetAttribute failed\n"); grid = -1; return; }
        if (hipOccupancyMaxActiveBlocksPerMultiprocessor(&per_cu, (const void*)fwd_kernel, NWAVES * 64, LDS_BYTES) != hipSuccess || per_cu < 1) { fprintf(stderr, "kernel_launch: occupancy query says %d blocks per CU\n", per_cu); per_cu = 1; }
        (void)hipGetLastError();
        grid = cus;
        if (grid != 256) fprintf(stderr, "kernel_launch: %d CUs (built for 256)\n", grid);
    }
    if (grid < 0) return;
    (void)hipMemsetAsync((char*)d_ws + WS_CTL, 0, CTL_ZERO_BYTES, stream);
    Args a{};
    for (int i = 0; i < 33; ++i) a.in[i] = (const float*)d_in[i];
    a.out = (float*)d_out; a.ws = (unsigned char*)d_ws; a.dup = PROBE_DUP;
#if MK_PER_PHASE
    for (int li = 0; li < NPHASE; ++li) { a.ph_lo = li; a.ph_hi = li + 1; a.li = li; hipLaunchKernelGGL(fwd_kernel, dim3(grid), dim3(NWAVES * 64), LDS_BYTES, stream, a); }
#else
    a.ph_lo = 0; a.ph_hi = NPHASE; a.li = 0;
    void* kargs[] = {(void*)&a};
    hipError_t e = hipLaunchCooperativeKernel((const void*)fwd_kernel, dim3(grid), dim3(NWAVES * 64), kargs, LDS_BYTES, stream);
    if (e != hipSuccess) fprintf(stderr, "kernel_launch: cooperative launch failed: %s\n", hipGetErrorString(e));
#endif
}
```
